# Optimizing an MI355X kernel written in HIP

```python
import math
import jax, jax.numpy as jnp
from jax import lax
import numpy as np

D_MODEL = 1024
BATCH = 8
SEQ = 2048
DEPTH = 4

CTX_LEN = 256
GRID_W = 64

W_LRU = D_MODEL // 2
W_POOL = D_MODEL // 4
W_CONF = D_MODEL // 4
W_MIX = W_LRU + W_POOL + W_CONF

LRU_HEADS = 8
LRU_HD = W_LRU // LRU_HEADS
LRU_CONV = 4
LRU_C = 8.0

POOL_WINDOWS = (2, 4, 8, 16)
POOL_GROUPS = len(POOL_WINDOWS)
POOL_GD = W_POOL // POOL_GROUPS

CONF_K = 31

IN_WIDTHS = (W_LRU, W_LRU, W_POOL, W_POOL, W_CONF, W_CONF, W_CONF)
N_IN = sum(IN_WIDTHS)
IN_SPLITS = tuple(int(v) for v in np.cumsum(IN_WIDTHS)[:-1])

EPS = 1e-6
LN_EPS = 1e-5

kernel_name = "hybrid_lru_pool_conformer_dit"


def rmsnorm(x, g):
    x32 = x.astype(jnp.float32)
    y = x32 * lax.rsqrt(jnp.mean(x32 * x32, axis=-1, keepdims=True) + EPS)
    return (y * g.astype(jnp.float32)).astype(x.dtype)


def pos_embed_2d(n):
    ROWS = n // GRID_W
    row = jnp.repeat(jnp.arange(ROWS, dtype=jnp.float32), GRID_W)
    col = jnp.tile(jnp.arange(GRID_W, dtype=jnp.float32), ROWS)
    q = D_MODEL // 4
    omega = 1.0 / (10000.0 ** (jnp.arange(q, dtype=jnp.float32) / q))
    def enc(p):
        ang = p[:, None] * omega[None, :]
        return jnp.concatenate([jnp.sin(ang), jnp.cos(ang)], axis=-1)
    return jnp.concatenate([enc(row), enc(col)], axis=-1)


def modulation(cond, w_mod, b_mod):
    m = jnp.dot(jax.nn.silu(cond), w_mod) + b_mod
    return jnp.split(m, 3, axis=-1)


def dwconv(x, w, b, pad_l, pad_r):
    C = x.shape[-1]
    y = lax.conv_general_dilated(
        x, w[:, None, :].astype(x.dtype), window_strides=(1,), padding=[(pad_l, pad_r)],
        dimension_numbers=('NWC', 'WIO', 'NWC'), feature_group_count=C)
    return y + b


def lru_coeffs(xc, wa, ba, wx, bx, lam):
    B_, N, _ = xc.shape
    xh = xc.reshape(B_, N, LRU_HEADS, LRU_HD)
    r = jax.nn.sigmoid(jnp.einsum('bnhi,hij->bnhj', xh, wa).reshape(B_, N, W_LRU) + ba)
    i = jax.nn.sigmoid(jnp.einsum('bnhi,hij->bnhj', xh, wx).reshape(B_, N, W_LRU) + bx)
    log_a = (-LRU_C * r.astype(jnp.float32)) * jax.nn.softplus(-lam.astype(jnp.float32))
    a = jnp.exp(log_a)
    mult = jnp.sqrt(-jnp.expm1(2.0 * log_a))
    b = mult * (i * xc).astype(jnp.float32)
    return a, b


def _combine(left, right):
    a_l, b_l = left
    a_r, b_r = right
    return a_l * a_r, a_r * b_l + b_r


def linear_scan(a, b, h0, reverse):
    if h0 is not None:
        idx = -1 if reverse else 0
        b = b.at[:, idx].add(a[:, idx] * h0)
    _, h = lax.associative_scan(_combine, (a, b), reverse=reverse, axis=1)
    return h


def lru_branch(vx, vc, conv_w, conv_b, wa, ba, wx, bx, lam):
    pl = LRU_CONV // 2
    pr = LRU_CONV - 1 - pl
    xc = dwconv(vx, conv_w, conv_b, pl, pr)
    cc = dwconv(vc, conv_w, conv_b, pl, pr)
    y_x = jnp.zeros(vx.shape, jnp.float32)
    y_c = jnp.zeros(vc.shape, jnp.float32)
    for d, rev in enumerate((False, True)):
        a_c, b_c = lru_coeffs(cc, wa[d], ba[d], wx[d], bx[d], lam[d])
        h_c = linear_scan(a_c, b_c, None, rev)
        h0 = h_c[:, 0] if rev else h_c[:, -1]
        a_x, b_x = lru_coeffs(xc, wa[d], ba[d], wx[d], bx[d], lam[d])
        h_x = linear_scan(a_x, b_x, h0, rev)
        y_x = y_x + h_x
        y_c = y_c + h_c
    return y_x.astype(vx.dtype), y_c.astype(vc.dtype)


def pool_mixer(v, pool_w, pool_scale):
    B_, N, _ = v.shape
    v32 = v.astype(jnp.float32)
    cs = jnp.concatenate([jnp.zeros((B_, 1, W_POOL), jnp.float32), jnp.cumsum(v32, axis=1)], axis=1)
    t = jnp.arange(N)
    outs = []
    for gi, w in enumerate(POOL_WINDOWS):
        lo = jnp.clip(t - w // 2, 0, N)
        hi = jnp.clip(t + w // 2, 0, N)
        sl = cs[..., gi * POOL_GD:(gi + 1) * POOL_GD]
        mean = (jnp.take(sl, hi, axis=1) - jnp.take(sl, lo, axis=1)) / (hi - lo).astype(jnp.float32)[:, None]
        outs.append(mean - v32[..., gi * POOL_GD:(gi + 1) * POOL_GD])
    d = jnp.stack(outs, axis=2).astype(v.dtype)
    y = jnp.einsum('bngi,gij->bngj', d, pool_w).reshape(B_, N, W_POOL)
    return y * pool_scale


def conformer_conv(v, gg, dw, dw_b, ln_g, ln_b, pw):
    z = v * jax.nn.sigmoid(gg)
    z = dwconv(z, dw, dw_b, CONF_K // 2, CONF_K // 2)
    z32 = z.astype(jnp.float32)
    mu = jnp.mean(z32, axis=-1, keepdims=True)
    var = jnp.mean(jnp.square(z32 - mu), axis=-1, keepdims=True)
    z = ((z32 - mu) * lax.rsqrt(var + LN_EPS) * ln_g.astype(jnp.float32) + ln_b.astype(jnp.float32)).astype(v.dtype)
    z = jax.nn.silu(z)
    return jnp.einsum('bnc,ce->bne', z, pw)


def merge_out(y_lru, g_lru, y_pool, g_pool, y_conf, g_conf, w_out):
    z = jnp.concatenate([y_lru * jax.nn.silu(g_lru), y_pool * jax.nn.silu(g_pool),
                         y_conf * jax.nn.silu(g_conf)], axis=-1)
    return jnp.einsum('bnm,md->bnd', z, w_out)


def setup_inputs(seed: int = 0) -> dict:
    key = jax.random.key(seed)
    ks = jax.random.split(key, 24)
    f32 = jnp.float32
    def nrm(k, shape, s):
        return jax.random.normal(k, shape, f32) * s
    L = DEPTH
    x = nrm(ks[0], (BATCH, SEQ, D_MODEL), 1.0)
    c = nrm(ks[1], (BATCH, D_MODEL), 1.0)
    ctx = nrm(ks[2], (BATCH, CTX_LEN, D_MODEL), 1.0)
    c_ctx = nrm(ks[3], (D_MODEL,), 1.0)
    w_mod = nrm(ks[4], (L, D_MODEL, 3 * D_MODEL), 0.5 * D_MODEL ** -0.5)
    b_mod = nrm(ks[5], (L, 3 * D_MODEL), 0.02)
    g_pre = 1.0 + nrm(ks[6], (L, D_MODEL), 0.05)
    w_in = nrm(ks[7], (L, D_MODEL, N_IN), D_MODEL ** -0.5)
    lru_conv_w = nrm(ks[8], (L, LRU_CONV, W_LRU), LRU_CONV ** -0.5)
    lru_conv_b = nrm(ks[9], (L, W_LRU), 0.02)
    lru_wa = nrm(ks[10], (L, 2, LRU_HEADS, LRU_HD, LRU_HD), LRU_HD ** -0.5)
    lru_ba = nrm(ks[11], (L, 2, W_LRU), 0.02)
    lru_wx = nrm(ks[12], (L, 2, LRU_HEADS, LRU_HD, LRU_HD), LRU_HD ** -0.5)
    lru_bx = nrm(ks[13], (L, 2, W_LRU), 0.02)
    a_pow = jax.random.uniform(ks[14], (L, 2, W_LRU), f32, 0.9, 0.999)
    s = a_pow ** (1.0 / LRU_C)
    lru_lambda = jnp.log(s) - jnp.log1p(-s)
    pool_w = nrm(ks[15], (L, POOL_GROUPS, POOL_GD, POOL_GD), POOL_GD ** -0.5)
    pool_scale = 1.0 + nrm(ks[16], (L, W_POOL), 0.1)
    conf_dw = nrm(ks[17], (L, CONF_K, W_CONF), CONF_K ** -0.5)
    conf_dw_b = nrm(ks[18], (L, W_CONF), 0.02)
    conf_ln_g = 1.0 + nrm(ks[19], (L, W_CONF), 0.05)
    conf_ln_b = nrm(ks[20], (L, W_CONF), 0.02)
    conf_pw = nrm(ks[21], (L, W_CONF, W_CONF), W_CONF ** -0.5)
    w_out = nrm(ks[22], (L, W_MIX, D_MODEL), W_MIX ** -0.5)
    g_post = 1.0 + nrm(ks[23], (L, D_MODEL), 0.05)
    return {"x": x, "c": c, "ctx": ctx, "c_ctx": c_ctx, "w_mod": w_mod, "b_mod": b_mod,
            "g_pre": g_pre, "w_in": w_in, "lru_conv_w": lru_conv_w, "lru_conv_b": lru_conv_b,
            "lru_wa": lru_wa, "lru_ba": lru_ba, "lru_wx": lru_wx, "lru_bx": lru_bx,
            "lru_lambda": lru_lambda, "pool_w": pool_w, "pool_scale": pool_scale,
            "conf_dw": conf_dw, "conf_dw_b": conf_dw_b, "conf_ln_g": conf_ln_g, "conf_ln_b": conf_ln_b,
            "conf_pw": conf_pw, "w_out": w_out, "g_post": g_post}


def reference(x, c, ctx, c_ctx, w_mod, b_mod, g_pre, w_in, lru_conv_w, lru_conv_b, lru_wa, lru_ba,
              lru_wx, lru_bx, lru_lambda, pool_w, pool_scale, conf_dw, conf_dw_b, conf_ln_g, conf_ln_b,
              conf_pw, w_out, g_post):
    n = x.shape[1]
    x = x + pos_embed_2d(n).astype(x.dtype)[None]
    for l in range(DEPTH):
        need_ctx = l < DEPTH - 1
        sh_x, sc_x, gt_x = modulation(c, w_mod[l], b_mod[l])
        sh_c, sc_c, gt_c = modulation(c_ctx, w_mod[l], b_mod[l])
        hx = rmsnorm(x, g_pre[l]) * (1 + sc_x[:, None, :]) + sh_x[:, None, :]
        hc = rmsnorm(ctx, g_pre[l]) * (1 + sc_c) + sh_c
        ux = jnp.einsum('bnd,de->bne', hx, w_in[l])
        vx_lru, gx_lru, vx_pool, gx_pool, vx_conf, ggx_conf, gx_conf = jnp.split(ux, IN_SPLITS, axis=-1)
        if need_ctx:
            uc = jnp.einsum('bnd,de->bne', hc, w_in[l])
            vc_lru, gc_lru, vc_pool, gc_pool, vc_conf, ggc_conf, gc_conf = jnp.split(uc, IN_SPLITS, axis=-1)
        else:
            vc_lru = jnp.einsum('bnd,de->bne', hc, w_in[l][:, :W_LRU])

        y_lru_x, y_lru_c = lru_branch(vx_lru, vc_lru, lru_conv_w[l], lru_conv_b[l], lru_wa[l], lru_ba[l],
                                      lru_wx[l], lru_bx[l], lru_lambda[l])
        y_pool_x = pool_mixer(vx_pool, pool_w[l], pool_scale[l])
        y_conf_x = conformer_conv(vx_conf, ggx_conf, conf_dw[l], conf_dw_b[l], conf_ln_g[l], conf_ln_b[l], conf_pw[l])
        o_x = merge_out(y_lru_x, gx_lru, y_pool_x, gx_pool, y_conf_x, gx_conf, w_out[l])

        if need_ctx:
            y_pool_c = pool_mixer(vc_pool, pool_w[l], pool_scale[l])
            y_conf_c = conformer_conv(vc_conf, ggc_conf, conf_dw[l], conf_dw_b[l], conf_ln_g[l], conf_ln_b[l], conf_pw[l])
            o_c = merge_out(y_lru_c, gc_lru, y_pool_c, gc_pool, y_conf_c, gc_conf, w_out[l])
            ctx = ctx + gt_c * rmsnorm(o_c, g_post[l])

        x = x + gt_x[:, None, :] * rmsnorm(o_x, g_post[l])
    return x
```

```cpp
#include <hip/hip_runtime.h>
#include <cstdio>
#include <cstdint>
namespace pg8 {
#define PG8_LAS __attribute__((address_space(3)))
typedef unsigned short bf16_t;
typedef short bf16x8 __attribute__((ext_vector_type(8)));
typedef float f32x4 __attribute__((ext_vector_type(4)));
typedef unsigned u32x4 __attribute__((ext_vector_type(4)));
constexpr int BM = 256, BK = 64, HALF = 128, HTB = HALF * BK * 2  , STAGE_BYTES = 8 * HTB, NXCD = 8, WGM = 8;

__host__ __device__ __forceinline__ int lds_byte(int r, int c) { const int st = (r >> 4) * 2 + (c >> 5), rr = r & 15, cc = c & 31, ob = rr * 64 + cc * 2; return st * 1024 + (ob ^ (((ob >> 9) & 1) << 5)); }
__host__ __device__ __forceinline__ void stage_rc(int b, int& R, int& C) { const int st = b / 1024, sb = b % 1024, swz = sb ^ (((sb >> 9) & 1) << 5); R = (st >> 1) * 16 + swz / 64; C = (st & 1) * 32 + (swz % 64) / 2; }
__host__ __device__ __forceinline__ int perm32(int rho) { const int n = rho >> 4, i = rho & 15; return 8 * (i >> 2) + 4 * n + (i & 3); }

struct Unit { int pm, pn; };
struct Gemm { const bf16_t* A; const bf16_t* Bt; int M, N, K; };

struct StaticOrder {
    int nM, nN, nwg, G, c;
    __host__ __device__ void init(int M, int N, int G_, int c_) { nM = M / BM; nN = N / BM; nwg = nM * nN; G = G_; c = c_; }
    __host__ __device__ bool next(int i, Unit& u) const {
        const long L = (long)i * G + c; if (L >= nwg) return false;
        int wgid = (int)L; { const int q = nwg / NXCD, r = nwg % NXCD, xcd = wgid % NXCD, off = wgid / NXCD; wgid = (xcd < r ? xcd * (q + 1) : r * (q + 1) + (xcd - r) * q) + off; }
        const int nig = WGM * nN, gid = wgid / nig, fm = gid * WGM, gsz = (nM - fm) < WGM ? (nM - fm) : WGM;
        u.pm = fm + ((wgid % nig) % gsz); u.pn = (wgid % nig) / gsz; return true;
    }
    __device__ __forceinline__ void a_ready(const Unit&) const {}
    __device__ __forceinline__ void done(const Unit&) const {}
};

__device__ __forceinline__ unsigned cvt_pk_bf16(float lo, float hi) { unsigned r; asm volatile("v_cvt_pk_bf16_f32 %0, %1, %2" : "=v"(r) : "v"(lo), "v"(hi)); return r; }
typedef float f32x2 __attribute__((ext_vector_type(2)));
__device__ __forceinline__ f32x2 gelu_pk(f32x2 v) {
    const f32x2 av = __builtin_elementwise_abs(v), d = av * 0.2316418882f + 1.0f;
    f32x2 t; t.x = __builtin_amdgcn_rcpf(d.x); t.y = __builtin_amdgcn_rcpf(d.y);
    f32x2 q = t * 0.5307027145f + (-0.7265760135f); q = q * t + 0.7107068705f; q = q * t + (-0.142248368f); q = q * t + 0.127414796f; q = q * t;
    const f32x2 s = (v * v) * (-0.72134752044f);
    f32x2 e; e.x = __builtin_amdgcn_exp2f(s.x); e.y = __builtin_amdgcn_exp2f(s.y);
    const f32x2 m = v * (q * e), r = v - m;
    f32x2 o; o.x = v.x < 0.f ? m.x : r.x; o.y = v.y < 0.f ? m.y : r.y; return o;
}

template <int ACT  > struct EpiBf16 {
    static constexpr bool PERM = true, AFTER_DRAIN = false; static_assert(ACT == 0 || ACT == 1, "EpiBf16: ACT is 0 (none) or 1 (gelu_pk)");
    bf16_t* O; int ldc; const float* bias; int split_cols; size_t split_stride; float scale0;
    __device__ __forceinline__ void operator()(const f32x4 (&acc)[2][2][4][2], const Unit& u, int wr, int wc, int fr, int fq) const {
        const int row0 = u.pm * BM + wr * 64 + fr; int colt = u.pn * BM; bf16_t* base = O;
        float sc = 1.f; if (split_cols) { const int t = colt / split_cols; base += (size_t)t * split_stride; colt -= t * split_cols; if (t == 0) sc = scale0; }
        const int col0 = colt + wc * 32 + 8 * fq, bcol0 = u.pn * BM + wc * 32 + 8 * fq;
        f32x4 bv[2][2];
#pragma unroll
        for (int bj = 0; bj < 2; ++bj)
#pragma unroll
            for (int n = 0; n < 2; ++n) bv[bj][n] = bias ? *(const f32x4*)(bias + bcol0 + bj * HALF + 4 * n) : (f32x4){0.f, 0.f, 0.f, 0.f};
#pragma unroll
        for (int ai = 0; ai < 2; ++ai)
#pragma unroll
            for (int m = 0; m < 4; ++m) { bf16_t* rowp = base + (size_t)(row0 + ai * HALF + m * 16) * ldc + col0;
#pragma unroll
                for (int bj = 0; bj < 2; ++bj) { f32x4 v0 = acc[ai][bj][m][0] + bv[bj][0], v1 = acc[ai][bj][m][1] + bv[bj][1];
                    if (ACT == 1) { f32x2 a = gelu_pk((f32x2){v0[0], v0[1]}), b = gelu_pk((f32x2){v0[2], v0[3]}), c = gelu_pk((f32x2){v1[0], v1[1]}), d = gelu_pk((f32x2){v1[2], v1[3]});
                        v0 = (f32x4){a.x, a.y, b.x, b.y}; v1 = (f32x4){c.x, c.y, d.x, d.y}; }
                    v0 = v0 * sc; v1 = v1 * sc; u32x4 w; w.x = cvt_pk_bf16(v0[0], v0[1]); w.y = cvt_pk_bf16(v0[2], v0[3]); w.z = cvt_pk_bf16(v1[0], v1[1]); w.w = cvt_pk_bf16(v1[2], v1[3]);
                    *(u32x4*)(rowp + bj * HALF) = w; } }
    }
};

struct PanelStats {
    unsigned* xbuf;
    unsigned* cnt;
    unsigned* tmo;
    int ntn; float eps;
    unsigned code;
    __device__ __forceinline__ bool run(const f32x4 (&v)[2][2][4][2], const Unit& u, int wr, int wc, int fr, int fq, PG8_LAS unsigned char* lds, int wid, int lane) const {
        typedef float f32x2v __attribute__((ext_vector_type(2)));
        PG8_LAS f32x2v* P = (PG8_LAS f32x2v*)lds;
        PG8_LAS f32x2v* S = (PG8_LAS f32x2v*)(lds + 8192);
        PG8_LAS unsigned* flag = (PG8_LAS unsigned*)(lds + 8192 + 2048);
#pragma unroll
        for (int ai = 0; ai < 2; ++ai)
#pragma unroll
            for (int m = 0; m < 4; ++m) {
                float s = 0.f;
#pragma unroll
                for (int bj = 0; bj < 2; ++bj)
#pragma unroll
                    for (int n = 0; n < 2; ++n) { const f32x4 x = v[ai][bj][m][n]; s += (x[0] + x[1]) + (x[2] + x[3]); }
                s += __shfl_xor(s, 16); s += __shfl_xor(s, 32);
                const float mw = s * (1.0f / 64.0f); float q = 0.f;
#pragma unroll
                for (int bj = 0; bj < 2; ++bj)
#pragma unroll
                    for (int n = 0; n < 2; ++n) { const f32x4 d = v[ai][bj][m][n] - mw; q += (d[0] * d[0] + d[1] * d[1]) + (d[2] * d[2] + d[3] * d[3]); }
                q += __shfl_xor(q, 16); q += __shfl_xor(q, 32);
                if (fq == 0) P[(ai * HALF + wr * 64 + m * 16 + fr) * 4 + wc] = (f32x2v){mw, q};
            }
        asm volatile("s_waitcnt lgkmcnt(0)" ::: "memory"); __builtin_amdgcn_s_barrier(); asm volatile("" ::: "memory");
#if defined(BROKEN_EXCHANGE_NO_WAIT)
#warning BROKEN CONTROL BUILD: the row-statistics exchange does not wait; results are wrong by design
        if (blockIdx.x >= 64) { const long long t0_ = clock64(); while (clock64() - t0_ < 60000) __builtin_amdgcn_s_sleep(8); }
#endif
        const int row = wid * 32 + (lane & 31);
        if (lane < 32) {
            const f32x2v a = P[row * 4 + 0], b = P[row * 4 + 1], c = P[row * 4 + 2], d = P[row * 4 + 3];
            const float mt = (a.x + b.x + c.x + d.x) * 0.25f;
            const float da = a.x - mt, db = b.x - mt, dc = c.x - mt, dd = d.x - mt;
            const float m2 = (a.y + b.y) + (c.y + d.y) + 64.0f * ((da * da + db * db) + (dc * dc + dd * dd));
            unsigned long long* slot = (unsigned long long*)xbuf + ((size_t)(u.pm * BM + row) * 4 + u.pn);
            __hip_atomic_store(slot, ((unsigned long long)__float_as_uint(m2) << 32) | __float_as_uint(mt), __ATOMIC_RELAXED, __HIP_MEMORY_SCOPE_AGENT);
        }
        asm volatile("s_waitcnt vmcnt(0)" ::: "memory");
        if (lane == 0) __hip_atomic_fetch_add(cnt + 64 * u.pm, 1u, __ATOMIC_RELAXED, __HIP_MEMORY_SCOPE_AGENT);
        if (wid == 0) {
            bool dead = false; const unsigned long long t0 = __builtin_amdgcn_s_memrealtime(); const unsigned want = 8u * (unsigned)ntn;
            for (;;) {
#if defined(BROKEN_EXCHANGE_NO_WAIT)
                break;
#endif
                if ((unsigned)__builtin_amdgcn_readfirstlane(__hip_atomic_load(cnt + 64 * u.pm, __ATOMIC_RELAXED, __HIP_MEMORY_SCOPE_AGENT)) >= want) break;
                if (__builtin_amdgcn_s_memrealtime() - t0 > 2000000ull) {
                    if (lane == 0) { unsigned expect = 0u; __hip_atomic_compare_exchange_strong(tmo + 1, &expect, code | (unsigned)(u.pm & 0xff), __ATOMIC_RELAXED, __ATOMIC_RELAXED, __HIP_MEMORY_SCOPE_AGENT);
                                     __hip_atomic_store(tmo, 1u, __ATOMIC_RELAXED, __HIP_MEMORY_SCOPE_AGENT); }
                    dead = true; break; }
                __builtin_amdgcn_s_sleep(2);
            }
            __builtin_amdgcn_fence(__ATOMIC_ACQUIRE, "agent");
            if (lane == 0) flag[0] = dead ? 1u : 0u;
        }
        asm volatile("s_waitcnt vmcnt(0) lgkmcnt(0)" ::: "memory"); __builtin_amdgcn_s_barrier(); asm volatile("" ::: "memory");
        const bool bad = flag[0] != 0u;
        if (lane < 32) {
            const unsigned long long* slot = (const unsigned long long*)xbuf + (size_t)(u.pm * BM + row) * 4; float mt[4], m2[4]; float ms = 0.f;
#pragma unroll
            for (int t = 0; t < 4; ++t) { if (t < ntn) { const unsigned long long w = __hip_atomic_load(slot + t, __ATOMIC_RELAXED, __HIP_MEMORY_SCOPE_AGENT); mt[t] = __uint_as_float((unsigned)w); m2[t] = __uint_as_float((unsigned)(w >> 32)); } else { mt[t] = 0.f; m2[t] = 0.f; } ms += mt[t]; }
            const float mean = ms / (float)ntn; float q = 0.f;
#pragma unroll
            for (int t = 0; t < 4; ++t) if (t < ntn) { const float dm = mt[t] - mean; q += m2[t] + 256.0f * dm * dm; }
            S[row] = (f32x2v){mean, 1.0f / sqrtf(q / (256.0f * (float)ntn) + eps)};
        }
        asm volatile("s_waitcnt lgkmcnt(0)" ::: "memory"); __builtin_amdgcn_s_barrier(); asm volatile("" ::: "memory");
        return bad;
    }
};
struct EpiLnRes {
    static constexpr bool PERM = false, AFTER_DRAIN = true;
    const float* base; float* out; int ldc; const float* bias; PanelStats st; unsigned poison;
    __device__ __forceinline__ void fused(f32x4 (&acc)[2][2][4][2], const Unit& u, int wr, int wc, int fr, int fq, PG8_LAS unsigned char* lds, int wid, int lane) const {
        typedef float f32x2v __attribute__((ext_vector_type(2)));
        const PG8_LAS f32x2v* S = (const PG8_LAS f32x2v*)(lds + 8192);
        const int col0 = u.pn * BM + wc * 32 + 4 * fq;
#pragma unroll
        for (int bj = 0; bj < 2; ++bj)
#pragma unroll
            for (int n = 0; n < 2; ++n) { const f32x4 bv = bias ? *(const f32x4*)(bias + col0 + bj * HALF + n * 16) : (f32x4){0.f, 0.f, 0.f, 0.f};
#pragma unroll
                for (int ai = 0; ai < 2; ++ai)
#pragma unroll
                    for (int m = 0; m < 4; ++m) acc[ai][bj][m][n] += bv; }
        f32x4 pre[4][2][2];
#pragma unroll
        for (int m = 0; m < 4; ++m) { const size_t off = (size_t)(u.pm * BM + wr * 64 + m * 16 + fr) * ldc + col0;
#pragma unroll
            for (int bj = 0; bj < 2; ++bj)
#pragma unroll
                for (int n = 0; n < 2; ++n) pre[m][bj][n] = *(const f32x4*)(base + off + bj * HALF + n * 16); }
        const bool bad = st.run(acc, u, wr, wc, fr, fq, lds, wid, lane) || poison != 0u;
        const float qnan = __builtin_nanf("");
#pragma unroll
        for (int ai = 0; ai < 2; ++ai)
#pragma unroll
            for (int m = 0; m < 4; ++m) { const int r = ai * HALF + wr * 64 + m * 16 + fr; const f32x2v sr = S[r]; const size_t off = (size_t)(u.pm * BM + r) * ldc + col0;
#pragma unroll
                for (int bj = 0; bj < 2; ++bj)
#pragma unroll
                    for (int n = 0; n < 2; ++n) { const f32x4 bs = ai == 0 ? pre[m][bj][n] : *(const f32x4*)(base + off + bj * HALF + n * 16); f32x4 o = bs + (acc[ai][bj][m][n] - sr.x) * sr.y;
                        if (bad) o = (f32x4){qnan, qnan, qnan, qnan}; *(f32x4*)(out + off + bj * HALF + n * 16) = o; }
                if (m & 1) asm volatile("" ::: "memory"); }
    }
};
struct EpiLnResLn {
    static constexpr bool PERM = false, AFTER_DRAIN = true;
    const float* base; float* out; bf16_t* xn; int ldc; const float* bias; PanelStats st1, st2; unsigned poison;
    __device__ __forceinline__ void fused(f32x4 (&acc)[2][2][4][2], const Unit& u, int wr, int wc, int fr, int fq, PG8_LAS unsigned char* lds, int wid, int lane) const {
        typedef float f32x2v __attribute__((ext_vector_type(2))); typedef unsigned u32x2v __attribute__((ext_vector_type(2)));
        const PG8_LAS f32x2v* S = (const PG8_LAS f32x2v*)(lds + 8192);
        const int col0 = u.pn * BM + wc * 32 + 4 * fq;
#pragma unroll
        for (int bj = 0; bj < 2; ++bj)
#pragma unroll
            for (int n = 0; n < 2; ++n) { const f32x4 bv = bias ? *(const f32x4*)(bias + col0 + bj * HALF + n * 16) : (f32x4){0.f, 0.f, 0.f, 0.f};
#pragma unroll
                for (int ai = 0; ai < 2; ++ai)
#pragma unroll
                    for (int m = 0; m < 4; ++m) acc[ai][bj][m][n] += bv; }
        bool bad = st1.run(acc, u, wr, wc, fr, fq, lds, wid, lane) || poison != 0u;
        const float qnan = __builtin_nanf("");
#pragma unroll
        for (int ai = 0; ai < 2; ++ai)
#pragma unroll
            for (int m = 0; m < 4; ++m) { const int r = ai * HALF + wr * 64 + m * 16 + fr; const f32x2v sr = S[r]; const size_t off = (size_t)(u.pm * BM + r) * ldc + col0;
#pragma unroll
                for (int bj = 0; bj < 2; ++bj)
#pragma unroll
                    for (int n = 0; n < 2; ++n) { const f32x4 bs = *(const f32x4*)(base + off + bj * HALF + n * 16); acc[ai][bj][m][n] = bs + (acc[ai][bj][m][n] - sr.x) * sr.y; }
                asm volatile("" : "+v"(acc[ai][0][m][0]), "+v"(acc[ai][0][m][1]), "+v"(acc[ai][1][m][0]), "+v"(acc[ai][1][m][1]));
                if (m & 1) asm volatile("" ::: "memory"); }
        const bool bad1 = bad;
        bad = st2.run(acc, u, wr, wc, fr, fq, lds, wid, lane) || bad;
#pragma unroll
        for (int ai = 0; ai < 2; ++ai)
#pragma unroll
            for (int m = 0; m < 4; ++m) { const int r = ai * HALF + wr * 64 + m * 16 + fr; const f32x2v sr = S[r]; const size_t off = (size_t)(u.pm * BM + r) * ldc + col0;
#pragma unroll
                for (int bj = 0; bj < 2; ++bj)
#pragma unroll
                    for (int n = 0; n < 2; ++n) { const f32x4 x1 = acc[ai][bj][m][n]; *(f32x4*)(out + off + bj * HALF + n * 16) = bad1 ? (f32x4){qnan, qnan, qnan, qnan} : x1;
                        const f32x4 o = (x1 - sr.x) * sr.y; u32x2v w; w.x = cvt_pk_bf16(o[0], o[1]); w.y = cvt_pk_bf16(o[2], o[3]);
                        if (bad) { w.x = 0x7fc07fc0u; w.y = 0x7fc07fc0u; } *(u32x2v*)(xn + off + bj * HALF + n * 16) = w; }
                asm volatile("" ::: "memory"); }
    }
};

template <class Epi, class Sched, bool ALIGN_EPI = false, bool SP2 = false>
__device__ __forceinline__ void gemm_phase(PG8_LAS unsigned char* lds, const Gemm g, const Sched& S, const Epi& E) {
    const int tid = threadIdx.x, wid = __builtin_amdgcn_readfirstlane(tid >> 6), lane = tid & 63, wr = wid >> 2, wc = wid & 3, fr = lane & 15, fq = lane >> 4;
    const int K = g.K, nt = K / BK;
    unsigned voffA[2], voffB[2];
#pragma unroll
    for (int i = 0; i < 2; ++i) { int R, C; stage_rc(tid * 16 + i * 8192, R, C); const int Rb = Epi::PERM ? ((R & ~31) + perm32(R & 31)) : R;
        voffA[i] = (unsigned)(R * K + C) * 2u; voffB[i] = (unsigned)(Rb * K + C) * 2u; }
    const size_t kstep = (size_t)(BK * 2);
    const size_t hstep = (size_t)HALF * K * 2;
    const size_t tstep = 2 * hstep;
    const unsigned ldsw = (unsigned)wid * 1024u;
    const int aoff = lds_byte(wr * 64 + fr, fq * 8), boff = lds_byte(wc * 32 + fr, fq * 8);
#define PG8_SA(b, h) (((b) * 2 + (h)) * HTB)
#define PG8_SB(b, h) ((4 + (b) * 2 + (h)) * HTB)
#define PG8_STAGE(bufoff, gbase, voff) do { _Pragma("unroll") for (int _i = 0; _i < 2; ++_i) \
        __builtin_amdgcn_global_load_lds((const unsigned*)((const char*)(gbase) + (voff)[_i]), (PG8_LAS unsigned*)(lds + (bufoff) + ldsw + _i * 8192), 16, 0, 0); } while (0)
#define PG8_LDA(dst, b, h) do { _Pragma("unroll") for (int m = 0; m < 4; ++m) _Pragma("unroll") for (int k = 0; k < 2; ++k) dst[m][k] = *(const PG8_LAS bf16x8*)(lds + PG8_SA(b, h) + aoff + m * 2048 + k * 1024); } while (0)
#define PG8_LDB(dst, b, h) do { _Pragma("unroll") for (int n = 0; n < 2; ++n) _Pragma("unroll") for (int k = 0; k < 2; ++k) dst[n][k] = *(const PG8_LAS bf16x8*)(lds + PG8_SB(b, h) + boff + n * 2048 + k * 1024); } while (0)
#define PG8_MMA(ai, bj, At, Bt) do { __builtin_amdgcn_s_setprio(1); _Pragma("unroll") for (int m = 0; m < 4; ++m) _Pragma("unroll") for (int n = 0; n < 2; ++n) _Pragma("unroll") for (int k = 0; k < 2; ++k) \
        acc[ai][bj][m][n] = __builtin_amdgcn_mfma_f32_16x16x32_bf16(Bt[n][k], At[m][k], acc[ai][bj][m][n], 0, 0, 0); __builtin_amdgcn_s_setprio(0); } while (0)
#define PG8_WAIT_V(n) asm volatile("s_waitcnt vmcnt(" #n ")" ::: "memory")
#define PG8_WAIT_L(n) asm volatile("s_waitcnt lgkmcnt(" #n ")" ::: "memory")
#define PG8_BAR __builtin_amdgcn_s_barrier()
#define PG8_SCHED __builtin_amdgcn_sched_barrier(0)
    Unit cur, nxt; int ui = 0;
    if (!S.next(0, cur)) return;
    f32x4 acc[2][2][4][2];
#pragma unroll
    for (int a = 0; a < 2; ++a)
#pragma unroll
        for (int b = 0; b < 2; ++b)
#pragma unroll
            for (int m = 0; m < 4; ++m)
#pragma unroll
                for (int n = 0; n < 2; ++n) acc[a][b][m][n] = (f32x4){0.f, 0.f, 0.f, 0.f};
    bf16x8 At[4][2], B0[2][2], B1[2][2];
    const char* cA = (const char*)g.A + (size_t)cur.pm * tstep; const char* cB = (const char*)g.Bt + (size_t)cur.pn * tstep;
    S.a_ready(cur);
    if constexpr (SP2) {
        PG8_STAGE(PG8_SB(0, 0), cB, voffB); PG8_STAGE(PG8_SB(0, 1), cB + hstep, voffB); PG8_STAGE(PG8_SA(0, 0), cA, voffA); PG8_STAGE(PG8_SA(0, 1), cA + hstep, voffA);
        if (wr == 1) PG8_BAR;
        PG8_WAIT_V(2); PG8_BAR;
        PG8_STAGE(PG8_SB(1, 0), cB + kstep, voffB); PG8_STAGE(PG8_SA(1, 0), cA + kstep, voffA); PG8_STAGE(PG8_SB(1, 1), cB + hstep + kstep, voffB);
        PG8_WAIT_V(6); PG8_BAR;
    } else {
        PG8_STAGE(PG8_SB(0, 0), cB, voffB); PG8_STAGE(PG8_SA(0, 0), cA, voffA); PG8_STAGE(PG8_SB(0, 1), cB + hstep, voffB); PG8_STAGE(PG8_SA(0, 1), cA + hstep, voffA);
        if (wr == 1) PG8_BAR;
        PG8_WAIT_V(4); PG8_BAR;
        PG8_STAGE(PG8_SB(1, 0), cB + kstep, voffB); PG8_STAGE(PG8_SA(1, 0), cA + kstep, voffA); PG8_STAGE(PG8_SB(1, 1), cB + hstep + kstep, voffB);
        PG8_WAIT_V(6); PG8_BAR;
    }
    for (;;) {
        const bool has_next = S.next(ui + 1, nxt);
        const char* nA = has_next ? (const char*)g.A + (size_t)nxt.pm * tstep : cA; const char* nB = has_next ? (const char*)g.Bt + (size_t)nxt.pn * tstep : cB;
        for (int t = 0; t < nt; t += 2) {
            const bool last = (t == nt - 2);
            const char* a1 = cA + (size_t)(t + 1) * kstep;
            const char* a2 = last ? nA : cA + (size_t)(t + 2) * kstep; const char* b2 = last ? nB : cB + (size_t)(t + 2) * kstep;
            const char* a3 = a2 + kstep; const char* b3 = b2 + kstep;
            if (last && has_next) S.a_ready(nxt);
            if constexpr (SP2) {
            PG8_LDB(B0, 0, 0); PG8_LDB(B1, 0, 1); PG8_SCHED; PG8_LDA(At, 0, 0); PG8_STAGE(PG8_SA(1, 1), a1 + hstep, voffA);
            PG8_WAIT_V(8); PG8_WAIT_L(0); PG8_BAR; PG8_MMA(0, 0, At, B0); PG8_MMA(0, 1, At, B1); PG8_BAR; PG8_SCHED;
            PG8_LDA(At, 0, 1); PG8_STAGE(PG8_SB(0, 0), b2, voffB); PG8_STAGE(PG8_SB(0, 1), b2 + hstep, voffB); PG8_STAGE(PG8_SA(0, 0), a2, voffA);
            PG8_WAIT_V(8); PG8_WAIT_L(0); PG8_BAR; PG8_MMA(1, 0, At, B0); PG8_MMA(1, 1, At, B1); PG8_BAR; PG8_SCHED;
            PG8_LDB(B0, 1, 0); PG8_LDB(B1, 1, 1); PG8_SCHED; PG8_LDA(At, 1, 0); PG8_STAGE(PG8_SA(0, 1), a2 + hstep, voffA);
            PG8_WAIT_V(8); PG8_WAIT_L(0); PG8_BAR; PG8_MMA(0, 0, At, B0); PG8_MMA(0, 1, At, B1); PG8_BAR; PG8_SCHED;
            PG8_LDA(At, 1, 1); PG8_STAGE(PG8_SB(1, 0), b3, voffB); PG8_STAGE(PG8_SB(1, 1), b3 + hstep, voffB); PG8_STAGE(PG8_SA(1, 0), a3, voffA);
            PG8_WAIT_V(8); PG8_WAIT_L(0); PG8_BAR; PG8_MMA(1, 0, At, B0); PG8_MMA(1, 1, At, B1); PG8_BAR; PG8_SCHED;
            } else {
            PG8_LDB(B0, 0, 0); PG8_SCHED; PG8_LDA(At, 0, 0); PG8_STAGE(PG8_SA(1, 1), a1 + hstep, voffA);
            PG8_WAIT_L(8); PG8_BAR; PG8_WAIT_L(0); PG8_MMA(0, 0, At, B0); PG8_BAR; PG8_SCHED;
            PG8_LDB(B1, 0, 1); PG8_STAGE(PG8_SB(0, 0), b2, voffB);
            PG8_BAR; PG8_WAIT_L(0); PG8_MMA(0, 1, At, B1); PG8_BAR;
            PG8_LDA(At, 0, 1); PG8_STAGE(PG8_SA(0, 0), a2, voffA);
            PG8_BAR; PG8_WAIT_L(0); PG8_MMA(1, 0, At, B0); PG8_BAR; PG8_SCHED;
            PG8_STAGE(PG8_SB(0, 1), b2 + hstep, voffB);
            PG8_WAIT_V(6); PG8_BAR; PG8_MMA(1, 1, At, B1); PG8_BAR;
            PG8_LDB(B0, 1, 0); PG8_SCHED; PG8_LDA(At, 1, 0); PG8_STAGE(PG8_SA(0, 1), a2 + hstep, voffA);
            PG8_WAIT_L(8); PG8_BAR; PG8_WAIT_L(0); PG8_MMA(0, 0, At, B0); PG8_BAR; PG8_SCHED;
            PG8_LDB(B1, 1, 1); PG8_STAGE(PG8_SB(1, 0), b3, voffB);
            PG8_BAR; PG8_WAIT_L(0); PG8_MMA(0, 1, At, B1); PG8_BAR;
            PG8_LDA(At, 1, 1); PG8_STAGE(PG8_SA(1, 0), a3, voffA);
            PG8_BAR; PG8_WAIT_L(0); PG8_MMA(1, 0, At, B0); PG8_BAR; PG8_SCHED;
            PG8_STAGE(PG8_SB(1, 1), b3 + hstep, voffB);
            PG8_WAIT_V(6); PG8_BAR; PG8_MMA(1, 1, At, B1); PG8_BAR;
            }
        }
        if constexpr (ALIGN_EPI) { if (wr == 0) PG8_BAR; }
        if constexpr (!Epi::AFTER_DRAIN) { E(acc, cur, wr, wc, fr, fq); S.done(cur); }
        if (!has_next) break;
#pragma unroll
        for (int a = 0; a < 2; ++a)
#pragma unroll
            for (int b = 0; b < 2; ++b)
#pragma unroll
                for (int m = 0; m < 4; ++m)
#pragma unroll
                    for (int n = 0; n < 2; ++n) acc[a][b][m][n] = (f32x4){0.f, 0.f, 0.f, 0.f};
        cur = nxt; cA = nA; cB = nB; ++ui;
        if constexpr (ALIGN_EPI) { if (wr == 1) PG8_BAR; }
    }
    PG8_WAIT_V(0);
    if constexpr (!ALIGN_EPI) { if (wr == 0) PG8_BAR; }
    PG8_BAR;
    if constexpr (Epi::AFTER_DRAIN) { E.fused(acc, cur, wr, wc, fr, fq, lds, wid, lane); S.done(cur); }
#undef PG8_SA
#undef PG8_SB
#undef PG8_STAGE
#undef PG8_LDA
#undef PG8_LDB
#undef PG8_MMA
#undef PG8_WAIT_V
#undef PG8_WAIT_L
#undef PG8_BAR
#undef PG8_SCHED
}
}

constexpr int DM = 1024, NB = 8, SEQ = 2048, DEPTH = 4, CTXL = 256, NIN = 2304;
constexpr int MX = NB * SEQ, MC = NB * CTXL, MT = MX + MC;
constexpr int WL = 512, WP = 256, WC = 256;
constexpr int C_VL = 0, C_GL = 512, C_VP = 1024, C_GP = 1280, C_VC = 1536, C_GG = 1792, C_GC = 2048;
constexpr int NCHUNK = 36;
constexpr float EPS_RMS = 1e-6f, EPS_LN = 1e-5f;

constexpr size_t MiB = 1u << 20;
constexpr size_t WS_CTL = 0, CTL_ZERO_BYTES = 1 * MiB;
constexpr size_t WS_MOD = 1 * MiB;
constexpr size_t WS_GW = 2 * MiB;
constexpr size_t WS_PW = 3 * MiB;
constexpr size_t WS_CPW = 3 * MiB + 512 * 1024;
constexpr size_t WS_WIN = 4 * MiB;
constexpr size_t WS_WOUT = 22 * MiB;
constexpr size_t WS_HX = 30 * MiB;
constexpr size_t WS_UX = 66 * MiB;
constexpr size_t WS_R2 = 147 * MiB;
constexpr size_t WS_CTXR = 219 * MiB;
constexpr size_t WS_SUM = 227 * MiB;
constexpr size_t WS_END = 230 * MiB;

constexpr int LDS_BYTES = 147456;
constexpr int MISC_OFF = 131072 + 320;
constexpr int NT = 512;

#define GAS __attribute__((address_space(1)))
#define LAS __attribute__((address_space(3)))
typedef unsigned short bf16;
typedef unsigned v4u __attribute__((ext_vector_type(4)));
typedef float f32x4 __attribute__((ext_vector_type(4)));
#define LDS_WAIT() asm volatile("s_waitcnt lgkmcnt(0)" ::: "memory")
#define VM_WAIT() asm volatile("s_waitcnt vmcnt(0)" ::: "memory")

__device__ __forceinline__ unsigned f2bf(float f) { unsigned u = __builtin_bit_cast(unsigned, f); return (u + 0x7fffu + ((u >> 16) & 1u)) >> 16; }
__device__ __forceinline__ unsigned pk2(float lo, float hi) { return f2bf(lo) | (f2bf(hi) << 16); }
__device__ __forceinline__ float bf2f(bf16 v) { return __builtin_bit_cast(float, (unsigned)v << 16); }
__device__ __forceinline__ float sigmoidf_(float v) { return 1.0f / (1.0f + expf(-v)); }
__device__ __forceinline__ float siluf_(float v) { return v / (1.0f + expf(-v)); }
__device__ __forceinline__ float wave_sum(float v) {
#pragma unroll
    for (int o = 1; o < 64; o <<= 1) v += __shfl_xor(v, o);
    return v;
}

struct Ptrs {
    const float *x, *c, *ctx, *c_ctx, *w_mod, *b_mod, *g_pre, *w_in, *lru_conv_w, *lru_conv_b, *lru_wa, *lru_ba, *lru_wx, *lru_bx, *lru_lambda,
        *pool_w, *pool_scale, *conf_dw, *conf_dw_b, *conf_ln_g, *conf_ln_b, *conf_pw, *w_out, *g_post;
};
struct Args { Ptrs p; float* out; unsigned char* ws; int ph_lo, ph_hi; };

__device__ __forceinline__ void row_info(int r, int& b, int& t, int& n, int& base) {
    if (r < MX) { b = r >> 11; t = r & 2047; n = SEQ; base = b << 11; }
    else { const int rc = r - MX; b = rc >> 8; t = rc & 255; n = CTXL; base = MX + (b << 8); }
}
__device__ __forceinline__ int chunk_row0(int b, int ck) { return ck < 4 ? MX + b * CTXL + 64 * ck : b * SEQ + 64 * (ck - 4); }

__device__ __forceinline__ void transpose_item(const float* W, int K, int N, bf16* WT, LAS float* scr, int item, int lane) {
    const int nblk = N / 32, kb = item / nblk, nb = item % nblk, k0 = 64 * kb, n0 = 32 * nb;
#pragma unroll 8
    for (int i = 0; i < 32; ++i) { const int kk = 2 * i + (lane >> 5); scr[kk * 33 + (lane & 31)] = W[(size_t)(k0 + kk) * N + n0 + (lane & 31)]; }
    LDS_WAIT(); asm volatile("" ::: "memory");
    const int c = lane & 7;
#pragma unroll
    for (int j = 0; j < 4; ++j) { const int n = (lane >> 3) + 8 * j; const LAS float* s = scr + (8 * c) * 33 + n;
        v4u o; o.x = pk2(s[0 * 33], s[1 * 33]); o.y = pk2(s[2 * 33], s[3 * 33]); o.z = pk2(s[4 * 33], s[5 * 33]); o.w = pk2(s[6 * 33], s[7 * 33]);
        *(GAS v4u*)(WT + (size_t)(n0 + n) * K + k0 + 8 * c) = o; }
    LDS_WAIT(); asm volatile("" ::: "memory");
}

struct EpiF32 {
    static constexpr bool PERM = false, AFTER_DRAIN = false;
    float* O; int ldc;
    __device__ __forceinline__ void operator()(const pg8::f32x4 (&acc)[2][2][4][2], const pg8::Unit& u, int wr, int wc, int fr, int fq) const {
        const int row0 = u.pm * 256 + wr * 64 + fr, col0 = u.pn * 256 + wc * 32 + 4 * fq;
#pragma unroll
        for (int ai = 0; ai < 2; ++ai)
#pragma unroll
            for (int m = 0; m < 4; ++m) { float* rowp = O + (size_t)(row0 + ai * 128 + m * 16) * ldc + col0;
#pragma unroll
                for (int bj = 0; bj < 2; ++bj)
#pragma unroll
                    for (int n = 0; n < 2; ++n) *(pg8::f32x4*)(rowp + bj * 128 + n * 16) = acc[ai][bj][m][n]; }
    }
};

__device__ __forceinline__ void lru_ab(const Ptrs& P, int l, int d, const float* XC, int row, int c, float& a, float& bb) {
    const int h = c >> 6, j = c & 63;
    const float* wa = P.lru_wa + (size_t)((l * 2 + d) * 8 + h) * 4096 + j;
    const float* wx = P.lru_wx + (size_t)((l * 2 + d) * 8 + h) * 4096 + j;
    const float* xr = XC + (size_t)row * WL + h * 64;
    float rp = P.lru_ba[(l * 2 + d) * WL + c], ip = P.lru_bx[(l * 2 + d) * WL + c];
#pragma unroll 8
    for (int i = 0; i < 64; ++i) { const float xv = xr[i]; rp += xv * wa[i * 64]; ip += xv * wx[i * 64]; }
    const float r = sigmoidf_(rp), ig = sigmoidf_(ip);
    const float sp = log1pf(expf(-P.lru_lambda[(l * 2 + d) * WL + c]));
    const float la = -8.0f * r * sp;
    a = expf(la);
    bb = sqrtf(-expm1f(2.0f * la)) * (ig * xr[j]);
}

enum { K_PREP = 100, K_EMBED = 101 };
template <int KIND> __global__ void __launch_bounds__(NT, 2) fwd(Args args) {
    extern __shared__ __attribute__((aligned(16))) unsigned char lds_raw[];
    LAS unsigned char* lds = (LAS unsigned char*)lds_raw;
    const Ptrs& P = args.p;
    const int tid = threadIdx.x, lane = tid & 63, wave = __builtin_amdgcn_readfirstlane(tid >> 6);
    const int G = gridDim.x, bx = blockIdx.x;
    const int gtid = bx * NT + tid, NTH = G * NT;
    const int gw = bx * 8 + wave, NGW = G * 8;
    unsigned char* ws = args.ws;
    float* MOD = (float*)(ws + WS_MOD);
    bf16* GW = (bf16*)(ws + WS_GW); bf16* PW = (bf16*)(ws + WS_PW); bf16* CPW = (bf16*)(ws + WS_CPW);
    bf16* WIN = (bf16*)(ws + WS_WIN); bf16* WOUT = (bf16*)(ws + WS_WOUT);
    bf16* HX = (bf16*)(ws + WS_HX); bf16* Z = HX; bf16* UX = (bf16*)(ws + WS_UX);
    float* XC = (float*)(ws + WS_R2); float* Y = (float*)(ws + WS_R2 + 36 * MiB);
    float* Dp = (float*)(ws + WS_R2); float* ZC = (float*)(ws + WS_R2 + 18 * MiB); float* CL = (float*)(ws + WS_R2 + 36 * MiB);
    float* O = (float*)(ws + WS_R2);
    float* CTXR = (float*)(ws + WS_CTXR); float* SUM = (float*)(ws + WS_SUM);
    float* out = args.out;

    {
        if constexpr (KIND == K_PREP) {
            LAS float* scr = (LAS float*)(lds + wave * 16384);
            constexpr int I_IN = 16 * 72, I_OUT = 16 * 32, I_CPW = 4 * 8, I_S = 2;
            constexpr int N_IN = 4 * I_IN, N_OUT = 4 * I_OUT, N_CPW = 4 * I_CPW, N_PW = 16 * I_S, N_GW = 64 * I_S;
            constexpr int NITEMS = N_IN + N_OUT + N_CPW + N_PW + 2 * N_GW;
            for (int it = gw; it < NITEMS; it += NGW) {
                int r = it;
                if (r < N_IN) { const int l = r / I_IN; transpose_item(P.w_in + (size_t)l * DM * NIN, DM, NIN, WIN + (size_t)l * NIN * DM, scr, r % I_IN, lane); continue; } r -= N_IN;
                if (r < N_OUT) { const int l = r / I_OUT; transpose_item(P.w_out + (size_t)l * DM * DM, DM, DM, WOUT + (size_t)l * DM * DM, scr, r % I_OUT, lane); continue; } r -= N_OUT;
                if (r < N_CPW) { const int l = r / I_CPW; transpose_item(P.conf_pw + (size_t)l * 65536, 256, 256, CPW + (size_t)l * 65536, scr, r % I_CPW, lane); continue; } r -= N_CPW;
                if (r < N_PW) { const int m = r / I_S; transpose_item(P.pool_w + (size_t)m * 4096, 64, 64, PW + (size_t)m * 4096, scr, r % I_S, lane); continue; } r -= N_PW;
                if (r < N_GW) { const int m = r / I_S; const int ld = m >> 3, h = m & 7;
                    transpose_item(P.lru_wa + (size_t)m * 4096, 64, 64, GW + (size_t)((ld * 2 + 0) * 8 + h) * 4096, scr, r % I_S, lane); continue; } r -= N_GW;
                { const int m = r / I_S; const int ld = m >> 3, h = m & 7;
                    transpose_item(P.lru_wx + (size_t)m * 4096, 64, 64, GW + (size_t)((ld * 2 + 1) * 8 + h) * 4096, scr, r % I_S, lane); }
            }
            __syncthreads();
            LAS float* S = (LAS float*)lds;
            LAS float* RED = (LAS float*)(lds + 40960);
            for (int i = tid; i < 9 * 1024; i += NT) { const int r = i >> 10, k = i & 1023; const float v = r < 8 ? P.c[r * 1024 + k] : P.c_ctx[k]; S[i] = siluf_(v); }
            __syncthreads();
            for (int it = bx; it < 4 * 48; it += G) {
                const int l = it / 48, j0 = (it % 48) * 64, j = tid & 63, ks = tid >> 6;
                float acc[9];
#pragma unroll
                for (int r = 0; r < 9; ++r) acc[r] = 0.f;
                const float* wp = P.w_mod + (size_t)l * 1024 * 3072 + (size_t)(ks * 128) * 3072 + j0 + j;
#pragma unroll 4
                for (int k = 0; k < 128; ++k) { const float w = wp[(size_t)k * 3072];
#pragma unroll
                    for (int r = 0; r < 9; ++r) acc[r] += S[r * 1024 + ks * 128 + k] * w; }
#pragma unroll
                for (int r = 0; r < 9; ++r) RED[(ks * 9 + r) * 64 + j] = acc[r];
                __syncthreads();
                for (int i = tid; i < 9 * 64; i += NT) { const int r = i >> 6, jj = i & 63; float s = P.b_mod[l * 3072 + j0 + jj];
#pragma unroll
                    for (int q = 0; q < 8; ++q) s += RED[(q * 9 + r) * 64 + jj];
                    MOD[(size_t)(l * 9 + r) * 3072 + j0 + jj] = s; }
                __syncthreads();
            }
        } else if constexpr (KIND == K_EMBED) {
            for (int r = gw; r < MT; r += NGW) {
                int b, t, n, base; row_info(r, b, t, n, base);
                const bool isx = r < MX; const int mr = isx ? b : 8;
                const float* src = isx ? P.x + (size_t)r * DM : P.ctx + (size_t)(r - MX) * DM;
                float* dst = isx ? out + (size_t)r * DM : CTXR + (size_t)(r - MX) * DM;
                f32x4 v[4]; float ss = 0.f;
#pragma unroll
                for (int j = 0; j < 4; ++j) {
                    v[j] = *(const f32x4*)(src + 256 * j + 4 * lane);
                    if (isx) {
                        const float p = (j < 2) ? (float)(t >> 6) : (float)(t & 63);
#pragma unroll
                        for (int e = 0; e < 4; ++e) { const int i = 4 * lane + e; const float om = 1.0f / powf(10000.0f, (float)i / 256.0f); const float ang = p * om;
                            v[j][e] += (j & 1) ? cosf(ang) : sinf(ang); }
                    }
                    *(f32x4*)(dst + 256 * j + 4 * lane) = v[j];
                    ss += (v[j][0] * v[j][0] + v[j][1] * v[j][1]) + (v[j][2] * v[j][2] + v[j][3] * v[j][3]);
                }
                const float rstd = 1.0f / sqrtf(wave_sum(ss) * (1.0f / DM) + EPS_RMS);
                const float* sh = MOD + (size_t)(0 * 9 + mr) * 3072; const float* sc = sh + 1024;
#pragma unroll
                for (int j = 0; j < 4; ++j) { const int d0 = 256 * j + 4 * lane; float h[4];
#pragma unroll
                    for (int e = 0; e < 4; ++e) h[e] = v[j][e] * rstd * P.g_pre[d0 + e] * (1.0f + sc[d0 + e]) + sh[d0 + e];
                    uint2 w; w.x = pk2(h[0], h[1]); w.y = pk2(h[2], h[3]); *(uint2*)(HX + (size_t)r * DM + d0) = w; }
            }
        } else {
            const int l = args.ph_lo; constexpr int k = KIND;
            if constexpr (k == 0) {
                pg8::Gemm g{HX, WIN + (size_t)l * NIN * DM, MT, NIN, DM}; pg8::StaticOrder S; S.init(MT, NIN, G, bx);
                pg8::EpiBf16<0> E{UX, NIN, nullptr, 0, 0, 1.f};
                pg8::gemm_phase<pg8::EpiBf16<0>, pg8::StaticOrder, true, true>(lds, g, S, E);
            } else if constexpr (k == 1) {
                for (int i = gtid; i < MT * WL; i += NTH) { const int r = i >> 9, c = i & 511; int b, t, n, base; row_info(r, b, t, n, base);
                    float s = P.lru_conv_b[l * WL + c];
#pragma unroll
                    for (int kk = 0; kk < 4; ++kk) { const int tt = t + kk - 2; if (tt >= 0 && tt < n) s += bf2f(UX[(size_t)(base + tt) * NIN + C_VL + c]) * P.lru_conv_w[(l * 4 + kk) * WL + c]; }
                    XC[i] = s; }
            } else if constexpr (k == 2) {
                for (int i = gtid; i < NB * NCHUNK * 2 * WL; i += NTH) { const int c = i & 511, d = (i >> 9) & 1, bc = i >> 10, ck = bc % NCHUNK, b = bc / NCHUNK;
                    const int r0 = chunk_row0(b, ck); float A = 1.f, H = 0.f;
                    for (int s = 0; s < 64; ++s) { const int row = r0 + (d ? 63 - s : s); float a, bb; lru_ab(P, l, d, XC, row, c, a, bb); A *= a; H = a * H + bb; }
                    SUM[(size_t)i * 2] = A; SUM[(size_t)i * 2 + 1] = H; }
            } else if constexpr (k == 3) {
                for (int i = gtid; i < NB * NCHUNK * WL; i += NTH) { const int c = i & 511, bc = i >> 9, ck = bc % NCHUNK, b = bc / NCHUNK;
                    const int r0 = chunk_row0(b, ck);
                    const float* sb = SUM + (size_t)b * NCHUNK * 2 * WL * 2;
                    float h = 0.f;
                    for (int q = 0; q < ck; ++q) { const float* s = sb + ((size_t)(q * 2 + 0) * WL + c) * 2; h = s[0] * h + s[1]; }
                    for (int s = 0; s < 64; ++s) { const int row = r0 + s; float a, bb; lru_ab(P, l, 0, XC, row, c, a, bb); h = a * h + bb; Y[(size_t)row * WL + c] = h; }
                    h = 0.f;
                    if (ck < 4) { for (int q = 3; q > ck; --q) { const float* s = sb + ((size_t)(q * 2 + 1) * WL + c) * 2; h = s[0] * h + s[1]; } }
                    else { for (int q = 3; q >= 0; --q) { const float* s = sb + ((size_t)(q * 2 + 1) * WL + c) * 2; h = s[0] * h + s[1]; }
                           for (int q = NCHUNK - 1; q > ck; --q) { const float* s = sb + ((size_t)(q * 2 + 1) * WL + c) * 2; h = s[0] * h + s[1]; } }
                    for (int s = 63; s >= 0; --s) { const int row = r0 + s; float a, bb; lru_ab(P, l, 1, XC, row, c, a, bb); h = a * h + bb;
                        const float y = Y[(size_t)row * WL + c] + h; const float g = bf2f(UX[(size_t)row * NIN + C_GL + c]);
                        Z[(size_t)row * DM + c] = (bf16)f2bf(y * siluf_(g)); }
                }
            } else if constexpr (k == 4) {
                for (int i = gtid; i < MT * 256; i += NTH) { const int r = i >> 8, c = i & 255; int b, t, n, base; row_info(r, b, t, n, base);
                    const int w2 = 1 << (c >> 6);
                    int lo = t - w2; lo = lo < 0 ? 0 : lo; int hi = t + w2; hi = hi > n ? n : hi;
                    float s = 0.f; for (int tt = lo; tt < hi; ++tt) s += bf2f(UX[(size_t)(base + tt) * NIN + C_VP + c]);
                    Dp[i] = s / (float)(hi - lo) - bf2f(UX[(size_t)r * NIN + C_VP + c]);
                    ZC[i] = bf2f(UX[(size_t)r * NIN + C_VC + c]) * sigmoidf_(bf2f(UX[(size_t)r * NIN + C_GG + c])); }
            } else if constexpr (k == 5) {
                for (int i = gtid; i < MT * 256; i += NTH) { const int r = i >> 8, c = i & 255, g = c >> 6, j = c & 63;
                    const float* w = P.pool_w + (size_t)(l * 4 + g) * 4096 + j; const float* dr = Dp + (size_t)r * 256 + g * 64; float s = 0.f;
#pragma unroll 8
                    for (int ii = 0; ii < 64; ++ii) s += dr[ii] * w[ii * 64];
                    s *= P.pool_scale[l * 256 + c];
                    Z[(size_t)r * DM + 512 + c] = (bf16)f2bf(s * siluf_(bf2f(UX[(size_t)r * NIN + C_GP + c]))); }
                for (int r = gw; r < MT; r += NGW) { int b, t, n, base; row_info(r, b, t, n, base);
                    const int c0 = 4 * lane; f32x4 acc = *(const f32x4*)(P.conf_dw_b + l * 256 + c0);
                    for (int kk = 0; kk < 31; ++kk) { const int tt = t + kk - 15; if (tt >= 0 && tt < n) { const f32x4 zv = *(const f32x4*)(ZC + (size_t)(base + tt) * 256 + c0); const f32x4 wv = *(const f32x4*)(P.conf_dw + (size_t)(l * 31 + kk) * 256 + c0); acc += zv * wv; } }
                    const float mu = wave_sum((acc[0] + acc[1]) + (acc[2] + acc[3])) * (1.0f / 256.0f);
                    const f32x4 dv = acc - mu; const float var = wave_sum((dv[0] * dv[0] + dv[1] * dv[1]) + (dv[2] * dv[2] + dv[3] * dv[3])) * (1.0f / 256.0f);
                    const float rstd = 1.0f / sqrtf(var + EPS_LN); f32x4 o;
#pragma unroll
                    for (int e = 0; e < 4; ++e) o[e] = siluf_(dv[e] * rstd * P.conf_ln_g[l * 256 + c0 + e] + P.conf_ln_b[l * 256 + c0 + e]);
                    *(f32x4*)(CL + (size_t)r * 256 + c0) = o; }
            } else if constexpr (k == 6) {
                for (int i = gtid; i < MT * 256; i += NTH) { const int r = i >> 8, e = i & 255;
                    const float* w = P.conf_pw + (size_t)l * 65536 + e; const float* cr = CL + (size_t)r * 256; float s = 0.f;
#pragma unroll 8
                    for (int cc = 0; cc < 256; ++cc) s += cr[cc] * w[cc * 256];
                    Z[(size_t)r * DM + 768 + e] = (bf16)f2bf(s * siluf_(bf2f(UX[(size_t)r * NIN + C_GC + e]))); }
            } else if constexpr (k == 7) {
                pg8::Gemm g{Z, WOUT + (size_t)l * DM * DM, MT, DM, DM}; pg8::StaticOrder S; S.init(MT, DM, G, bx);
                EpiF32 E{O, DM};
                pg8::gemm_phase<EpiF32, pg8::StaticOrder, true, true>(lds, g, S, E);
            } else {
                for (int r = gw; r < MT; r += NGW) {
                    const bool isx = r < MX; if (!isx && l == DEPTH - 1) continue;
                    const int b = isx ? (r >> 11) : ((r - MX) >> 8); const int mr = isx ? b : 8;
                    float* xr = isx ? out + (size_t)r * DM : CTXR + (size_t)(r - MX) * DM;
                    const float* orow = O + (size_t)r * DM; const float* gt = MOD + (size_t)(l * 9 + mr) * 3072 + 2048;
                    f32x4 o[4]; float ss = 0.f;
#pragma unroll
                    for (int j = 0; j < 4; ++j) { o[j] = *(const f32x4*)(orow + 256 * j + 4 * lane); ss += (o[j][0] * o[j][0] + o[j][1] * o[j][1]) + (o[j][2] * o[j][2] + o[j][3] * o[j][3]); }
                    const float rstd = 1.0f / sqrtf(wave_sum(ss) * (1.0f / DM) + EPS_RMS);
                    f32x4 v[4]; float s2 = 0.f;
#pragma unroll
                    for (int j = 0; j < 4; ++j) { const int d0 = 256 * j + 4 * lane; v[j] = *(const f32x4*)(xr + d0);
#pragma unroll
                        for (int e = 0; e < 4; ++e) v[j][e] += gt[d0 + e] * (o[j][e] * rstd * P.g_post[l * DM + d0 + e]);
                        *(f32x4*)(xr + d0) = v[j];
                        s2 += (v[j][0] * v[j][0] + v[j][1] * v[j][1]) + (v[j][2] * v[j][2] + v[j][3] * v[j][3]); }
                    if (l < DEPTH - 1) {
                        const float rs2 = 1.0f / sqrtf(wave_sum(s2) * (1.0f / DM) + EPS_RMS);
                        const float* sh = MOD + (size_t)((l + 1) * 9 + mr) * 3072; const float* sc = sh + 1024;
#pragma unroll
                        for (int j = 0; j < 4; ++j) { const int d0 = 256 * j + 4 * lane; float h[4];
#pragma unroll
                            for (int e = 0; e < 4; ++e) h[e] = v[j][e] * rs2 * P.g_pre[(l + 1) * DM + d0 + e] * (1.0f + sc[d0 + e]) + sh[d0 + e];
                            uint2 w; w.x = pk2(h[0], h[1]); w.y = pk2(h[2], h[3]); *(uint2*)(HX + (size_t)r * DM + d0) = w; }
                    }
                }
            }
        }
    }
}

constexpr int N_PHASES = 2 + 9 * DEPTH;

extern "C" void kernel_launch(void* const* d_in, const int* in_sizes, int n_in, void* d_out, int out_size, void* d_ws, size_t ws_size, hipStream_t stream) {
    static int grid = 0;
    if (grid == 0) {
        if (n_in != 24 || in_sizes[0] != MX * DM || out_size != MX * DM || ws_size < WS_END) { fprintf(stderr, "kernel_launch: unexpected shapes (n_in %d, in0 %d, out %d, ws %zu)\n", n_in, n_in > 0 ? in_sizes[0] : -1, out_size, ws_size); grid = -1; return; }
        int dev = 0, cus = 0;
        if (hipGetDevice(&dev) != hipSuccess || hipDeviceGetAttribute(&cus, hipDeviceAttributeMultiprocessorCount, dev) != hipSuccess) { grid = -1; return; }
        bool ok = true;
#define SETA(K) ok = ok && (hipFuncSetAttribute((const void*)fwd<K>, hipFuncAttributeMaxDynamicSharedMemorySize, LDS_BYTES) == hipSuccess)
        SETA(K_PREP); SETA(K_EMBED); SETA(0); SETA(1); SETA(2); SETA(3); SETA(4); SETA(5); SETA(6); SETA(7); SETA(8);
        if (!ok) { fprintf(stderr, "kernel_launch: hipFuncSetAttribute failed\n"); grid = -1; return; }
        grid = cus;
    }
    if (grid < 0) return;
    (void)hipMemsetAsync((char*)d_ws + WS_CTL, 0, CTL_ZERO_BYTES, stream);
    Args a{};
    const float** pp = (const float**)&a.p;
    for (int i = 0; i < 24; ++i) pp[i] = (const float*)d_in[i];
    a.out = (float*)d_out; a.ws = (unsigned char*)d_ws;
#define LAUNCH(K) hipLaunchKernelGGL(fwd<K>, dim3(grid), dim3(NT), LDS_BYTES, stream, a)
    a.ph_lo = 0; a.ph_hi = 0;
    LAUNCH(K_PREP); LAUNCH(K_EMBED);
    for (int l = 0; l < DEPTH; ++l) { a.ph_lo = l; LAUNCH(0); LAUNCH(1); LAUNCH(2); LAUNCH(3); LAUNCH(4); LAUNCH(5); LAUNCH(6); LAUNCH(7); LAUNCH(8); }
}
```

```cpp
#include <hip/hip_runtime.h>
#include <cstdio>
#include <cstdint>
namespace pg8 {
#define PG8_LAS __attribute__((address_space(3)))
typedef unsigned short bf16_t;
typedef short bf16x8 __attribute__((ext_vector_type(8)));
typedef float f32x4 __attribute__((ext_vector_type(4)));
typedef unsigned u32x4 __attribute__((ext_vector_type(4)));
constexpr int BM = 256, BK = 64, HALF = 128, HTB = HALF * BK * 2  , STAGE_BYTES = 8 * HTB, NXCD = 8, WGM = 8;

__host__ __device__ __forceinline__ int lds_byte(int r, int c) { const int st = (r >> 4) * 2 + (c >> 5), rr = r & 15, cc = c & 31, ob = rr * 64 + cc * 2; return st * 1024 + (ob ^ (((ob >> 9) & 1) << 5)); }
__host__ __device__ __forceinline__ void stage_rc(int b, int& R, int& C) { const int st = b / 1024, sb = b % 1024, swz = sb ^ (((sb >> 9) & 1) << 5); R = (st >> 1) * 16 + swz / 64; C = (st & 1) * 32 + (swz % 64) / 2; }
__host__ __device__ __forceinline__ int perm32(int rho) { const int n = rho >> 4, i = rho & 15; return 8 * (i >> 2) + 4 * n + (i & 3); }

struct Unit { int pm, pn; };
struct Gemm { const bf16_t* A; const bf16_t* Bt; int M, N, K; };

struct StaticOrder {
    int nM, nN, nwg, G, c;
    __host__ __device__ void init(int M, int N, int G_, int c_) { nM = M / BM; nN = N / BM; nwg = nM * nN; G = G_; c = c_; }
    __host__ __device__ bool next(int i, Unit& u) const {
        const long L = (long)i * G + c; if (L >= nwg) return false;
        int wgid = (int)L; { const int q = nwg / NXCD, r = nwg % NXCD, xcd = wgid % NXCD, off = wgid / NXCD; wgid = (xcd < r ? xcd * (q + 1) : r * (q + 1) + (xcd - r) * q) + off; }
        const int nig = WGM * nN, gid = wgid / nig, fm = gid * WGM, gsz = (nM - fm) < WGM ? (nM - fm) : WGM;
        u.pm = fm + ((wgid % nig) % gsz); u.pn = (wgid % nig) / gsz; return true;
    }
    __device__ __forceinline__ void a_ready(const Unit&) const {}
    __device__ __forceinline__ void done(const Unit&) const {}
};

__device__ __forceinline__ unsigned cvt_pk_bf16(float lo, float hi) { unsigned r; asm volatile("v_cvt_pk_bf16_f32 %0, %1, %2" : "=v"(r) : "v"(lo), "v"(hi)); return r; }
typedef float f32x2 __attribute__((ext_vector_type(2)));
__device__ __forceinline__ f32x2 gelu_pk(f32x2 v) {
    const f32x2 av = __builtin_elementwise_abs(v), d = av * 0.2316418882f + 1.0f;
    f32x2 t; t.x = __builtin_amdgcn_rcpf(d.x); t.y = __builtin_amdgcn_rcpf(d.y);
    f32x2 q = t * 0.5307027145f + (-0.7265760135f); q = q * t + 0.7107068705f; q = q * t + (-0.142248368f); q = q * t + 0.127414796f; q = q * t;
    const f32x2 s = (v * v) * (-0.72134752044f);
    f32x2 e; e.x = __builtin_amdgcn_exp2f(s.x); e.y = __builtin_amdgcn_exp2f(s.y);
    const f32x2 m = v * (q * e), r = v - m;
    f32x2 o; o.x = v.x < 0.f ? m.x : r.x; o.y = v.y < 0.f ? m.y : r.y; return o;
}

template <int ACT  > struct EpiBf16 {
    static constexpr bool PERM = true, AFTER_DRAIN = false; static_assert(ACT == 0 || ACT == 1, "EpiBf16: ACT is 0 (none) or 1 (gelu_pk)");
    bf16_t* O; int ldc; const float* bias; int split_cols; size_t split_stride; float scale0;
    __device__ __forceinline__ void operator()(const f32x4 (&acc)[2][2][4][2], const Unit& u, int wr, int wc, int fr, int fq) const {
        const int row0 = u.pm * BM + wr * 64 + fr; int colt = u.pn * BM; bf16_t* base = O;
        float sc = 1.f; if (split_cols) { const int t = colt / split_cols; base += (size_t)t * split_stride; colt -= t * split_cols; if (t == 0) sc = scale0; }
        const int col0 = colt + wc * 32 + 8 * fq, bcol0 = u.pn * BM + wc * 32 + 8 * fq;
        f32x4 bv[2][2];
#pragma unroll
        for (int bj = 0; bj < 2; ++bj)
#pragma unroll
            for (int n = 0; n < 2; ++n) bv[bj][n] = bias ? *(const f32x4*)(bias + bcol0 + bj * HALF + 4 * n) : (f32x4){0.f, 0.f, 0.f, 0.f};
#pragma unroll
        for (int ai = 0; ai < 2; ++ai)
#pragma unroll
            for (int m = 0; m < 4; ++m) { bf16_t* rowp = base + (size_t)(row0 + ai * HALF + m * 16) * ldc + col0;
#pragma unroll
                for (int bj = 0; bj < 2; ++bj) { f32x4 v0 = acc[ai][bj][m][0] + bv[bj][0], v1 = acc[ai][bj][m][1] + bv[bj][1];
                    if (ACT == 1) { f32x2 a = gelu_pk((f32x2){v0[0], v0[1]}), b = gelu_pk((f32x2){v0[2], v0[3]}), c = gelu_pk((f32x2){v1[0], v1[1]}), d = gelu_pk((f32x2){v1[2], v1[3]});
                        v0 = (f32x4){a.x, a.y, b.x, b.y}; v1 = (f32x4){c.x, c.y, d.x, d.y}; }
                    v0 = v0 * sc; v1 = v1 * sc; u32x4 w; w.x = cvt_pk_bf16(v0[0], v0[1]); w.y = cvt_pk_bf16(v0[2], v0[3]); w.z = cvt_pk_bf16(v1[0], v1[1]); w.w = cvt_pk_bf16(v1[2], v1[3]);
                    *(u32x4*)(rowp + bj * HALF) = w; } }
    }
};

struct PanelStats {
    unsigned* xbuf;
    unsigned* cnt;
    unsigned* tmo;
    int ntn; float eps;
    unsigned code;
    __device__ __forceinline__ bool run(const f32x4 (&v)[2][2][4][2], const Unit& u, int wr, int wc, int fr, int fq, PG8_LAS unsigned char* lds, int wid, int lane) const {
        typedef float f32x2v __attribute__((ext_vector_type(2)));
        PG8_LAS f32x2v* P = (PG8_LAS f32x2v*)lds;
        PG8_LAS f32x2v* S = (PG8_LAS f32x2v*)(lds + 8192);
        PG8_LAS unsigned* flag = (PG8_LAS unsigned*)(lds + 8192 + 2048);
#pragma unroll
        for (int ai = 0; ai < 2; ++ai)
#pragma unroll
            for (int m = 0; m < 4; ++m) {
                float s = 0.f;
#pragma unroll
                for (int bj = 0; bj < 2; ++bj)
#pragma unroll
                    for (int n = 0; n < 2; ++n) { const f32x4 x = v[ai][bj][m][n]; s += (x[0] + x[1]) + (x[2] + x[3]); }
                s += __shfl_xor(s, 16); s += __shfl_xor(s, 32);
                const float mw = s * (1.0f / 64.0f); float q = 0.f;
#pragma unroll
                for (int bj = 0; bj < 2; ++bj)
#pragma unroll
                    for (int n = 0; n < 2; ++n) { const f32x4 d = v[ai][bj][m][n] - mw; q += (d[0] * d[0] + d[1] * d[1]) + (d[2] * d[2] + d[3] * d[3]); }
                q += __shfl_xor(q, 16); q += __shfl_xor(q, 32);
                if (fq == 0) P[(ai * HALF + wr * 64 + m * 16 + fr) * 4 + wc] = (f32x2v){mw, q};
            }
        asm volatile("s_waitcnt lgkmcnt(0)" ::: "memory"); __builtin_amdgcn_s_barrier(); asm volatile("" ::: "memory");
#if defined(BROKEN_EXCHANGE_NO_WAIT)
#warning BROKEN CONTROL BUILD: the row-statistics exchange does not wait; results are wrong by design
        if (blockIdx.x >= 64) { const long long t0_ = clock64(); while (clock64() - t0_ < 60000) __builtin_amdgcn_s_sleep(8); }
#endif
        const int row = wid * 32 + (lane & 31);
        if (lane < 32) {
            const f32x2v a = P[row * 4 + 0], b = P[row * 4 + 1], c = P[row * 4 + 2], d = P[row * 4 + 3];
            const float mt = (a.x + b.x + c.x + d.x) * 0.25f;
            const float da = a.x - mt, db = b.x - mt, dc = c.x - mt, dd = d.x - mt;
            const float m2 = (a.y + b.y) + (c.y + d.y) + 64.0f * ((da * da + db * db) + (dc * dc + dd * dd));
            unsigned long long* slot = (unsigned long long*)xbuf + ((size_t)(u.pm * BM + row) * 4 + u.pn);
            __hip_atomic_store(slot, ((unsigned long long)__float_as_uint(m2) << 32) | __float_as_uint(mt), __ATOMIC_RELAXED, __HIP_MEMORY_SCOPE_AGENT);
        }
        asm volatile("s_waitcnt vmcnt(0)" ::: "memory");
        if (lane == 0) __hip_atomic_fetch_add(cnt + 64 * u.pm, 1u, __ATOMIC_RELAXED, __HIP_MEMORY_SCOPE_AGENT);
        if (wid == 0) {
            bool dead = false; const unsigned long long t0 = __builtin_amdgcn_s_memrealtime(); const unsigned want = 8u * (unsigned)ntn;
            for (;;) {
#if defined(BROKEN_EXCHANGE_NO_WAIT)
                break;
#endif
                if ((unsigned)__builtin_amdgcn_readfirstlane(__hip_atomic_load(cnt + 64 * u.pm, __ATOMIC_RELAXED, __HIP_MEMORY_SCOPE_AGENT)) >= want) break;
                if (__builtin_amdgcn_s_memrealtime() - t0 > 2000000ull) {
                    if (lane == 0) { unsigned expect = 0u; __hip_atomic_compare_exchange_strong(tmo + 1, &expect, code | (unsigned)(u.pm & 0xff), __ATOMIC_RELAXED, __ATOMIC_RELAXED, __HIP_MEMORY_SCOPE_AGENT);
                                     __hip_atomic_store(tmo, 1u, __ATOMIC_RELAXED, __HIP_MEMORY_SCOPE_AGENT); }
                    dead = true; break; }
                __builtin_amdgcn_s_sleep(2);
            }
            __builtin_amdgcn_fence(__ATOMIC_ACQUIRE, "agent");
            if (lane == 0) flag[0] = dead ? 1u : 0u;
        }
        asm volatile("s_waitcnt vmcnt(0) lgkmcnt(0)" ::: "memory"); __builtin_amdgcn_s_barrier(); asm volatile("" ::: "memory");
        const bool bad = flag[0] != 0u;
        if (lane < 32) {
            const unsigned long long* slot = (const unsigned long long*)xbuf + (size_t)(u.pm * BM + row) * 4; float mt[4], m2[4]; float ms = 0.f;
#pragma unroll
            for (int t = 0; t < 4; ++t) { if (t < ntn) { const unsigned long long w = __hip_atomic_load(slot + t, __ATOMIC_RELAXED, __HIP_MEMORY_SCOPE_AGENT); mt[t] = __uint_as_float((unsigned)w); m2[t] = __uint_as_float((unsigned)(w >> 32)); } else { mt[t] = 0.f; m2[t] = 0.f; } ms += mt[t]; }
            const float mean = ms / (float)ntn; float q = 0.f;
#pragma unroll
            for (int t = 0; t < 4; ++t) if (t < ntn) { const float dm = mt[t] - mean; q += m2[t] + 256.0f * dm * dm; }
            S[row] = (f32x2v){mean, 1.0f / sqrtf(q / (256.0f * (float)ntn) + eps)};
        }
        asm volatile("s_waitcnt lgkmcnt(0)" ::: "memory"); __builtin_amdgcn_s_barrier(); asm volatile("" ::: "memory");
        return bad;
    }
};
struct EpiLnRes {
    static constexpr bool PERM = false, AFTER_DRAIN = true;
    const float* base; float* out; int ldc; const float* bias; PanelStats st; unsigned poison;
    __device__ __forceinline__ void fused(f32x4 (&acc)[2][2][4][2], const Unit& u, int wr, int wc, int fr, int fq, PG8_LAS unsigned char* lds, int wid, int lane) const {
        typedef float f32x2v __attribute__((ext_vector_type(2)));
        const PG8_LAS f32x2v* S = (const PG8_LAS f32x2v*)(lds + 8192);
        const int col0 = u.pn * BM + wc * 32 + 4 * fq;
#pragma unroll
        for (int bj = 0; bj < 2; ++bj)
#pragma unroll
            for (int n = 0; n < 2; ++n) { const f32x4 bv = bias ? *(const f32x4*)(bias + col0 + bj * HALF + n * 16) : (f32x4){0.f, 0.f, 0.f, 0.f};
#pragma unroll
                for (int ai = 0; ai < 2; ++ai)
#pragma unroll
                    for (int m = 0; m < 4; ++m) acc[ai][bj][m][n] += bv; }
        f32x4 pre[4][2][2];
#pragma unroll
        for (int m = 0; m < 4; ++m) { const size_t off = (size_t)(u.pm * BM + wr * 64 + m * 16 + fr) * ldc + col0;
#pragma unroll
            for (int bj = 0; bj < 2; ++bj)
#pragma unroll
                for (int n = 0; n < 2; ++n) pre[m][bj][n] = *(const f32x4*)(base + off + bj * HALF + n * 16); }
        const bool bad = st.run(acc, u, wr, wc, fr, fq, lds, wid, lane) || poison != 0u;
        const float qnan = __builtin_nanf("");
#pragma unroll
        for (int ai = 0; ai < 2; ++ai)
#pragma unroll
            for (int m = 0; m < 4; ++m) { const int r = ai * HALF + wr * 64 + m * 16 + fr; const f32x2v sr = S[r]; const size_t off = (size_t)(u.pm * BM + r) * ldc + col0;
#pragma unroll
                for (int bj = 0; bj < 2; ++bj)
#pragma unroll
                    for (int n = 0; n < 2; ++n) { const f32x4 bs = ai == 0 ? pre[m][bj][n] : *(const f32x4*)(base + off + bj * HALF + n * 16); f32x4 o = bs + (acc[ai][bj][m][n] - sr.x) * sr.y;
                        if (bad) o = (f32x4){qnan, qnan, qnan, qnan}; *(f32x4*)(out + off + bj * HALF + n * 16) = o; }
                if (m & 1) asm volatile("" ::: "memory"); }
    }
};
struct EpiLnResLn {
    static constexpr bool PERM = false, AFTER_DRAIN = true;
    const float* base; float* out; bf16_t* xn; int ldc; const float* bias; PanelStats st1, st2; unsigned poison;
    __device__ __forceinline__ void fused(f32x4 (&acc)[2][2][4][2], const Unit& u, int wr, int wc, int fr, int fq, PG8_LAS unsigned char* lds, int wid, int lane) const {
        typedef float f32x2v __attribute__((ext_vector_type(2))); typedef unsigned u32x2v __attribute__((ext_vector_type(2)));
        const PG8_LAS f32x2v* S = (const PG8_LAS f32x2v*)(lds + 8192);
        const int col0 = u.pn * BM + wc * 32 + 4 * fq;
#pragma unroll
        for (int bj = 0; bj < 2; ++bj)
#pragma unroll
            for (int n = 0; n < 2; ++n) { const f32x4 bv = bias ? *(const f32x4*)(bias + col0 + bj * HALF + n * 16) : (f32x4){0.f, 0.f, 0.f, 0.f};
#pragma unroll
                for (int ai = 0; ai < 2; ++ai)
#pragma unroll
                    for (int m = 0; m < 4; ++m) acc[ai][bj][m][n] += bv; }
        bool bad = st1.run(acc, u, wr, wc, fr, fq, lds, wid, lane) || poison != 0u;
        const float qnan = __builtin_nanf("");
#pragma unroll
        for (int ai = 0; ai < 2; ++ai)
#pragma unroll
            for (int m = 0; m < 4; ++m) { const int r = ai * HALF + wr * 64 + m * 16 + fr; const f32x2v sr = S[r]; const size_t off = (size_t)(u.pm * BM + r) * ldc + col0;
#pragma unroll
                for (int bj = 0; bj < 2; ++bj)
#pragma unroll
                    for (int n = 0; n < 2; ++n) { const f32x4 bs = *(const f32x4*)(base + off + bj * HALF + n * 16); acc[ai][bj][m][n] = bs + (acc[ai][bj][m][n] - sr.x) * sr.y; }
                asm volatile("" : "+v"(acc[ai][0][m][0]), "+v"(acc[ai][0][m][1]), "+v"(acc[ai][1][m][0]), "+v"(acc[ai][1][m][1]));
                if (m & 1) asm volatile("" ::: "memory"); }
        const bool bad1 = bad;
        bad = st2.run(acc, u, wr, wc, fr, fq, lds, wid, lane) || bad;
#pragma unroll
        for (int ai = 0; ai < 2; ++ai)
#pragma unroll
            for (int m = 0; m < 4; ++m) { const int r = ai * HALF + wr * 64 + m * 16 + fr; const f32x2v sr = S[r]; const size_t off = (size_t)(u.pm * BM + r) * ldc + col0;
#pragma unroll
                for (int bj = 0; bj < 2; ++bj)
#pragma unroll
                    for (int n = 0; n < 2; ++n) { const f32x4 x1 = acc[ai][bj][m][n]; *(f32x4*)(out + off + bj * HALF + n * 16) = bad1 ? (f32x4){qnan, qnan, qnan, qnan} : x1;
                        const f32x4 o = (x1 - sr.x) * sr.y; u32x2v w; w.x = cvt_pk_bf16(o[0], o[1]); w.y = cvt_pk_bf16(o[2], o[3]);
                        if (bad) { w.x = 0x7fc07fc0u; w.y = 0x7fc07fc0u; } *(u32x2v*)(xn + off + bj * HALF + n * 16) = w; }
                asm volatile("" ::: "memory"); }
    }
};

template <class Epi, class Sched, bool ALIGN_EPI = false, bool SP2 = false>
__device__ __forceinline__ void gemm_phase(PG8_LAS unsigned char* lds, const Gemm g, const Sched& S, const Epi& E) {
    const int tid = threadIdx.x, wid = __builtin_amdgcn_readfirstlane(tid >> 6), lane = tid & 63, wr = wid >> 2, wc = wid & 3, fr = lane & 15, fq = lane >> 4;
    const int K = g.K, nt = K / BK;
    unsigned voffA[2], voffB[2];
#pragma unroll
    for (int i = 0; i < 2; ++i) { int R, C; stage_rc(tid * 16 + i * 8192, R, C); const int Rb = Epi::PERM ? ((R & ~31) + perm32(R & 31)) : R;
        voffA[i] = (unsigned)(R * K + C) * 2u; voffB[i] = (unsigned)(Rb * K + C) * 2u; }
    const size_t kstep = (size_t)(BK * 2);
    const size_t hstep = (size_t)HALF * K * 2;
    const size_t tstep = 2 * hstep;
    const unsigned ldsw = (unsigned)wid * 1024u;
    const int aoff = lds_byte(wr * 64 + fr, fq * 8), boff = lds_byte(wc * 32 + fr, fq * 8);
#define PG8_SA(b, h) (((b) * 2 + (h)) * HTB)
#define PG8_SB(b, h) ((4 + (b) * 2 + (h)) * HTB)
#define PG8_STAGE(bufoff, gbase, voff) do { _Pragma("unroll") for (int _i = 0; _i < 2; ++_i) \
        __builtin_amdgcn_global_load_lds((const unsigned*)((const char*)(gbase) + (voff)[_i]), (PG8_LAS unsigned*)(lds + (bufoff) + ldsw + _i * 8192), 16, 0, 0); } while (0)
#define PG8_LDA(dst, b, h) do { _Pragma("unroll") for (int m = 0; m < 4; ++m) _Pragma("unroll") for (int k = 0; k < 2; ++k) dst[m][k] = *(const PG8_LAS bf16x8*)(lds + PG8_SA(b, h) + aoff + m * 2048 + k * 1024); } while (0)
#define PG8_LDB(dst, b, h) do { _Pragma("unroll") for (int n = 0; n < 2; ++n) _Pragma("unroll") for (int k = 0; k < 2; ++k) dst[n][k] = *(const PG8_LAS bf16x8*)(lds + PG8_SB(b, h) + boff + n * 2048 + k * 1024); } while (0)
#define PG8_MMA(ai, bj, At, Bt) do { __builtin_amdgcn_s_setprio(1); _Pragma("unroll") for (int m = 0; m < 4; ++m) _Pragma("unroll") for (int n = 0; n < 2; ++n) _Pragma("unroll") for (int k = 0; k < 2; ++k) \
        acc[ai][bj][m][n] = __builtin_amdgcn_mfma_f32_16x16x32_bf16(Bt[n][k], At[m][k], acc[ai][bj][m][n], 0, 0, 0); __builtin_amdgcn_s_setprio(0); } while (0)
#define PG8_WAIT_V(n) asm volatile("s_waitcnt vmcnt(" #n ")" ::: "memory")
#define PG8_WAIT_L(n) asm volatile("s_waitcnt lgkmcnt(" #n ")" ::: "memory")
#define PG8_BAR __builtin_amdgcn_s_barrier()
#define PG8_SCHED __builtin_amdgcn_sched_barrier(0)
    Unit cur, nxt; int ui = 0;
    if (!S.next(0, cur)) return;
    f32x4 acc[2][2][4][2];
#pragma unroll
    for (int a = 0; a < 2; ++a)
#pragma unroll
        for (int b = 0; b < 2; ++b)
#pragma unroll
            for (int m = 0; m < 4; ++m)
#pragma unroll
                for (int n = 0; n < 2; ++n) acc[a][b][m][n] = (f32x4){0.f, 0.f, 0.f, 0.f};
    bf16x8 At[4][2], B0[2][2], B1[2][2];
    const char* cA = (const char*)g.A + (size_t)cur.pm * tstep; const char* cB = (const char*)g.Bt + (size_t)cur.pn * tstep;
    S.a_ready(cur);
    if constexpr (SP2) {
        PG8_STAGE(PG8_SB(0, 0), cB, voffB); PG8_STAGE(PG8_SB(0, 1), cB + hstep, voffB); PG8_STAGE(PG8_SA(0, 0), cA, voffA); PG8_STAGE(PG8_SA(0, 1), cA + hstep, voffA);
        if (wr == 1) PG8_BAR;
        PG8_WAIT_V(2); PG8_BAR;
        PG8_STAGE(PG8_SB(1, 0), cB + kstep, voffB); PG8_STAGE(PG8_SA(1, 0), cA + kstep, voffA); PG8_STAGE(PG8_SB(1, 1), cB + hstep + kstep, voffB);
        PG8_WAIT_V(6); PG8_BAR;
    } else {
        PG8_STAGE(PG8_SB(0, 0), cB, voffB); PG8_STAGE(PG8_SA(0, 0), cA, voffA); PG8_STAGE(PG8_SB(0, 1), cB + hstep, voffB); PG8_STAGE(PG8_SA(0, 1), cA + hstep, voffA);
        if (wr == 1) PG8_BAR;
        PG8_WAIT_V(4); PG8_BAR;
        PG8_STAGE(PG8_SB(1, 0), cB + kstep, voffB); PG8_STAGE(PG8_SA(1, 0), cA + kstep, voffA); PG8_STAGE(PG8_SB(1, 1), cB + hstep + kstep, voffB);
        PG8_WAIT_V(6); PG8_BAR;
    }
    for (;;) {
        const bool has_next = S.next(ui + 1, nxt);
        const char* nA = has_next ? (const char*)g.A + (size_t)nxt.pm * tstep : cA; const char* nB = has_next ? (const char*)g.Bt + (size_t)nxt.pn * tstep : cB;
        for (int t = 0; t < nt; t += 2) {
            const bool last = (t == nt - 2);
            const char* a1 = cA + (size_t)(t + 1) * kstep;
            const char* a2 = last ? nA : cA + (size_t)(t + 2) * kstep; const char* b2 = last ? nB : cB + (size_t)(t + 2) * kstep;
            const char* a3 = a2 + kstep; const char* b3 = b2 + kstep;
            if (last && has_next) S.a_ready(nxt);
            if constexpr (SP2) {
            PG8_LDB(B0, 0, 0); PG8_LDB(B1, 0, 1); PG8_SCHED; PG8_LDA(At, 0, 0); PG8_STAGE(PG8_SA(1, 1), a1 + hstep, voffA);
            PG8_WAIT_V(8); PG8_WAIT_L(0); PG8_BAR; PG8_MMA(0, 0, At, B0); PG8_MMA(0, 1, At, B1); PG8_BAR; PG8_SCHED;
            PG8_LDA(At, 0, 1); PG8_STAGE(PG8_SB(0, 0), b2, voffB); PG8_STAGE(PG8_SB(0, 1), b2 + hstep, voffB); PG8_STAGE(PG8_SA(0, 0), a2, voffA);
            PG8_WAIT_V(8); PG8_WAIT_L(0); PG8_BAR; PG8_MMA(1, 0, At, B0); PG8_MMA(1, 1, At, B1); PG8_BAR; PG8_SCHED;
            PG8_LDB(B0, 1, 0); PG8_LDB(B1, 1, 1); PG8_SCHED; PG8_LDA(At, 1, 0); PG8_STAGE(PG8_SA(0, 1), a2 + hstep, voffA);
            PG8_WAIT_V(8); PG8_WAIT_L(0); PG8_BAR; PG8_MMA(0, 0, At, B0); PG8_MMA(0, 1, At, B1); PG8_BAR; PG8_SCHED;
            PG8_LDA(At, 1, 1); PG8_STAGE(PG8_SB(1, 0), b3, voffB); PG8_STAGE(PG8_SB(1, 1), b3 + hstep, voffB); PG8_STAGE(PG8_SA(1, 0), a3, voffA);
            PG8_WAIT_V(8); PG8_WAIT_L(0); PG8_BAR; PG8_MMA(1, 0, At, B0); PG8_MMA(1, 1, At, B1); PG8_BAR; PG8_SCHED;
            } else {
            PG8_LDB(B0, 0, 0); PG8_SCHED; PG8_LDA(At, 0, 0); PG8_STAGE(PG8_SA(1, 1), a1 + hstep, voffA);
            PG8_WAIT_L(8); PG8_BAR; PG8_WAIT_L(0); PG8_MMA(0, 0, At, B0); PG8_BAR; PG8_SCHED;
            PG8_LDB(B1, 0, 1); PG8_STAGE(PG8_SB(0, 0), b2, voffB);
            PG8_BAR; PG8_WAIT_L(0); PG8_MMA(0, 1, At, B1); PG8_BAR;
            PG8_LDA(At, 0, 1); PG8_STAGE(PG8_SA(0, 0), a2, voffA);
            PG8_BAR; PG8_WAIT_L(0); PG8_MMA(1, 0, At, B0); PG8_BAR; PG8_SCHED;
            PG8_STAGE(PG8_SB(0, 1), b2 + hstep, voffB);
            PG8_WAIT_V(6); PG8_BAR; PG8_MMA(1, 1, At, B1); PG8_BAR;
            PG8_LDB(B0, 1, 0); PG8_SCHED; PG8_LDA(At, 1, 0); PG8_STAGE(PG8_SA(0, 1), a2 + hstep, voffA);
            PG8_WAIT_L(8); PG8_BAR; PG8_WAIT_L(0); PG8_MMA(0, 0, At, B0); PG8_BAR; PG8_SCHED;
            PG8_LDB(B1, 1, 1); PG8_STAGE(PG8_SB(1, 0), b3, voffB);
            PG8_BAR; PG8_WAIT_L(0); PG8_MMA(0, 1, At, B1); PG8_BAR;
            PG8_LDA(At, 1, 1); PG8_STAGE(PG8_SA(1, 0), a3, voffA);
            PG8_BAR; PG8_WAIT_L(0); PG8_MMA(1, 0, At, B0); PG8_BAR; PG8_SCHED;
            PG8_STAGE(PG8_SB(1, 1), b3 + hstep, voffB);
            PG8_WAIT_V(6); PG8_BAR; PG8_MMA(1, 1, At, B1); PG8_BAR;
            }
        }
        if constexpr (ALIGN_EPI) { if (wr == 0) PG8_BAR; }
        if constexpr (!Epi::AFTER_DRAIN) { E(acc, cur, wr, wc, fr, fq); S.done(cur); }
        if (!has_next) break;
#pragma unroll
        for (int a = 0; a < 2; ++a)
#pragma unroll
            for (int b = 0; b < 2; ++b)
#pragma unroll
                for (int m = 0; m < 4; ++m)
#pragma unroll
                    for (int n = 0; n < 2; ++n) acc[a][b][m][n] = (f32x4){0.f, 0.f, 0.f, 0.f};
        cur = nxt; cA = nA; cB = nB; ++ui;
        if constexpr (ALIGN_EPI) { if (wr == 1) PG8_BAR; }
    }
    PG8_WAIT_V(0);
    if constexpr (!ALIGN_EPI) { if (wr == 0) PG8_BAR; }
    PG8_BAR;
    if constexpr (Epi::AFTER_DRAIN) { E.fused(acc, cur, wr, wc, fr, fq, lds, wid, lane); S.done(cur); }
#undef PG8_SA
#undef PG8_SB
#undef PG8_STAGE
#undef PG8_LDA
#undef PG8_LDB
#undef PG8_MMA
#undef PG8_WAIT_V
#undef PG8_WAIT_L
#undef PG8_BAR
#undef PG8_SCHED
}
}

constexpr int DM = 1024, NB = 8, SEQ = 2048, DEPTH = 4, CTXL = 256, NIN = 2304;
constexpr int MX = NB * SEQ, MC = NB * CTXL, MT = MX + MC;
constexpr int WL = 512, WP = 256, WC = 256;
constexpr int C_VL = 0, C_GL = 512, C_VP = 1024, C_GP = 1280, C_VC = 1536, C_GG = 1792, C_GC = 2048;
constexpr int NCHUNK = 36;
constexpr float EPS_RMS = 1e-6f, EPS_LN = 1e-5f;

constexpr size_t MiB = 1u << 20;
constexpr size_t WS_CTL = 0, CTL_ZERO_BYTES = 1 * MiB;
constexpr size_t WS_MOD = 1 * MiB;
constexpr size_t WS_GB = 1 * MiB + 512 * 1024;
constexpr size_t WS_KC = WS_GB + 32768;
constexpr float LOG2E = 1.4426950408889634f;
constexpr size_t WS_GW = 2 * MiB;
constexpr size_t WS_PW = 3 * MiB;
constexpr size_t WS_CPW = 3 * MiB + 512 * 1024;
constexpr size_t WS_WIN = 4 * MiB;
constexpr size_t WS_WOUT = 22 * MiB;
constexpr size_t WS_HX = 30 * MiB;
constexpr size_t WS_UX = 66 * MiB;
constexpr size_t WS_R2 = 147 * MiB;
constexpr size_t WS_CTXR = 219 * MiB;
constexpr size_t WS_SUM = 227 * MiB;
constexpr size_t WS_END = 230 * MiB;

constexpr int LDS_BYTES = 147456;
constexpr int MISC_OFF = LDS_BYTES - 256;
constexpr int NT = 512;

#define GAS __attribute__((address_space(1)))
#define LAS __attribute__((address_space(3)))
typedef unsigned short bf16;
typedef unsigned v4u __attribute__((ext_vector_type(4)));
typedef float f32x4 __attribute__((ext_vector_type(4)));
typedef unsigned v2u __attribute__((ext_vector_type(2)));
#define LDS_WAIT() asm volatile("s_waitcnt lgkmcnt(0)" ::: "memory")
#define VM_WAIT() asm volatile("s_waitcnt vmcnt(0)" ::: "memory")

__device__ __forceinline__ unsigned f2bf(float f) { unsigned u = __builtin_bit_cast(unsigned, f); return (u + 0x7fffu + ((u >> 16) & 1u)) >> 16; }
__device__ __forceinline__ unsigned pk2(float lo, float hi) { return f2bf(lo) | (f2bf(hi) << 16); }
__device__ __forceinline__ float bf2f(bf16 v) { return __builtin_bit_cast(float, (unsigned)v << 16); }
__device__ __forceinline__ float sigmoidf_(float v) { return 1.0f / (1.0f + expf(-v)); }
__device__ __forceinline__ float siluf_(float v) { return v / (1.0f + expf(-v)); }
__device__ __forceinline__ float wave_sum(float v) {
#pragma unroll
    for (int o = 1; o < 64; o <<= 1) v += __shfl_xor(v, o);
    return v;
}

struct Ptrs {
    const float *x, *c, *ctx, *c_ctx, *w_mod, *b_mod, *g_pre, *w_in, *lru_conv_w, *lru_conv_b, *lru_wa, *lru_ba, *lru_wx, *lru_bx, *lru_lambda,
        *pool_w, *pool_scale, *conf_dw, *conf_dw_b, *conf_ln_g, *conf_ln_b, *conf_pw, *w_out, *g_post;
};
struct Args { Ptrs p; float* out; unsigned char* ws; int ph_lo, ph_hi; };

__device__ __forceinline__ void row_info(int r, int& b, int& t, int& n, int& base) {
    if (r < MX) { b = r >> 11; t = r & 2047; n = SEQ; base = b << 11; }
    else { const int rc = r - MX; b = rc >> 8; t = rc & 255; n = CTXL; base = MX + (b << 8); }
}
__device__ __forceinline__ int chunk_row0(int b, int ck) { return ck < 4 ? MX + b * CTXL + 64 * ck : b * SEQ + 64 * (ck - 4); }

__device__ __forceinline__ void transpose_item(const float* W, int K, int N, bf16* WT, LAS float* scr, int item, int lane, float scale = 1.0f) {
    const int nblk = N / 32, kb = item / nblk, nb = item % nblk, k0 = 64 * kb, n0 = 32 * nb;
#pragma unroll 8
    for (int i = 0; i < 32; ++i) { const int kk = 2 * i + (lane >> 5); scr[kk * 33 + (lane & 31)] = W[(size_t)(k0 + kk) * N + n0 + (lane & 31)] * scale; }
    LDS_WAIT(); asm volatile("" ::: "memory");
    const int c = lane & 7;
#pragma unroll
    for (int j = 0; j < 4; ++j) { const int n = (lane >> 3) + 8 * j; const LAS float* s = scr + (8 * c) * 33 + n;
        v4u o; o.x = pk2(s[0 * 33], s[1 * 33]); o.y = pk2(s[2 * 33], s[3 * 33]); o.z = pk2(s[4 * 33], s[5 * 33]); o.w = pk2(s[6 * 33], s[7 * 33]);
        *(GAS v4u*)(WT + (size_t)(n0 + n) * K + k0 + 8 * c) = o; }
    LDS_WAIT(); asm volatile("" ::: "memory");
}

struct EpiF32 {
    static constexpr bool PERM = false, AFTER_DRAIN = false;
    float* O; int ldc;
    __device__ __forceinline__ void operator()(const pg8::f32x4 (&acc)[2][2][4][2], const pg8::Unit& u, int wr, int wc, int fr, int fq) const {
        const int row0 = u.pm * 256 + wr * 64 + fr, col0 = u.pn * 256 + wc * 32 + 4 * fq;
#pragma unroll
        for (int ai = 0; ai < 2; ++ai)
#pragma unroll
            for (int m = 0; m < 4; ++m) { float* rowp = O + (size_t)(row0 + ai * 128 + m * 16) * ldc + col0;
#pragma unroll
                for (int bj = 0; bj < 2; ++bj)
#pragma unroll
                    for (int n = 0; n < 2; ++n) *(pg8::f32x4*)(rowp + bj * 128 + n * 16) = acc[ai][bj][m][n]; }
    }
};

__device__ __forceinline__ void lru_ab(const Ptrs& P, int l, int d, const float* XC, int row, int c, float& a, float& bb) {
    const int h = c >> 6, j = c & 63;
    const float* wa = P.lru_wa + (size_t)((l * 2 + d) * 8 + h) * 4096 + j;
    const float* wx = P.lru_wx + (size_t)((l * 2 + d) * 8 + h) * 4096 + j;
    const float* xr = XC + (size_t)row * WL + h * 64;
    float rp = P.lru_ba[(l * 2 + d) * WL + c], ip = P.lru_bx[(l * 2 + d) * WL + c];
#pragma unroll 8
    for (int i = 0; i < 64; ++i) { const float xv = xr[i]; rp += xv * wa[i * 64]; ip += xv * wx[i * 64]; }
    const float r = sigmoidf_(rp), ig = sigmoidf_(ip);
    const float sp = log1pf(expf(-P.lru_lambda[(l * 2 + d) * WL + c]));
    const float la = -8.0f * r * sp;
    a = expf(la);
    bb = sqrtf(-expm1f(2.0f * la)) * (ig * xr[j]);
}


typedef short bf16x8 __attribute__((ext_vector_type(8)));
static_assert(133120 + 4096 <= MISC_OFF, "LDS map");
constexpr int XCT_STRIDE = 1040;
constexpr int L_XCT = 0, L_GZ = 66560, L_CIN = 133120;
__device__ __forceinline__ float bflo(unsigned u) { return __builtin_bit_cast(float, u << 16); }
__device__ __forceinline__ float bfhi(unsigned u) { return __builtin_bit_cast(float, u & 0xffff0000u); }

__device__ __forceinline__ void strip_conv(LAS unsigned char* lds, const Ptrs& P, int l, const bf16* UX, int r0, int tpos0, int n, int tid) {
    const int o = tid & 63, tg = tid >> 6, c0 = 8 * o;
    float w[4][8], bias[8];
#pragma unroll
    for (int k = 0; k < 4; ++k) { const f32x4 a = *(const f32x4*)(P.lru_conv_w + (l * 4 + k) * WL + c0), b = *(const f32x4*)(P.lru_conv_w + (l * 4 + k) * WL + c0 + 4);
#pragma unroll
        for (int q = 0; q < 4; ++q) { w[k][q] = a[q]; w[k][4 + q] = b[q]; } }
    { const f32x4 a = *(const f32x4*)(P.lru_conv_b + l * WL + c0), b = *(const f32x4*)(P.lru_conv_b + l * WL + c0 + 4);
#pragma unroll
      for (int q = 0; q < 4; ++q) { bias[q] = a[q]; bias[4 + q] = b[q]; } }
    v4u v[11];
#pragma unroll
    for (int i = 0; i < 11; ++i) { const int tp = tpos0 + 8 * tg + i - 2;
        v[i] = (tp >= 0 && tp < n) ? *(const v4u*)(UX + (size_t)(r0 + 8 * tg + i - 2) * NIN + C_VL + c0) : (v4u){0u, 0u, 0u, 0u}; }
#pragma unroll
    for (int e = 0; e < 8; ++e) {
        float acc[8];
#pragma unroll
        for (int q = 0; q < 8; ++q) acc[q] = bias[q];
#pragma unroll
        for (int k = 0; k < 4; ++k) { const v4u x = v[e + k];
            acc[0] += w[k][0] * bflo(x.x); acc[1] += w[k][1] * bfhi(x.x); acc[2] += w[k][2] * bflo(x.y); acc[3] += w[k][3] * bfhi(x.y);
            acc[4] += w[k][4] * bflo(x.z); acc[5] += w[k][5] * bfhi(x.z); acc[6] += w[k][6] * bflo(x.w); acc[7] += w[k][7] * bfhi(x.w); }
        v4u ov; ov.x = pk2(acc[0], acc[1]); ov.y = pk2(acc[2], acc[3]); ov.z = pk2(acc[4], acc[5]); ov.w = pk2(acc[6], acc[7]);
        *(LAS v4u*)(lds + L_XCT + (8 * tg + e) * XCT_STRIDE + o * 16) = ov;
    }
}

template <int MODE>
__device__ __forceinline__ void lru_core(LAS unsigned char* lds, int l, int h, int lane, const bf16* GWS, const float* GB, const float* KC, float* sum_out) {
    const int fr = lane & 15, fq = lane >> 4;
    bf16x8 A[4][2];
#pragma unroll
    for (int m = 0; m < 4; ++m)
#pragma unroll
        for (int ks = 0; ks < 2; ++ks) { const int tau = (fr >> 2) * 16 + m * 4 + (fr & 3);
            A[m][ks] = *(const LAS bf16x8*)(lds + L_XCT + tau * XCT_STRIDE + (h * 64 + ks * 32 + fq * 8) * 2); }
#pragma unroll 1
    for (int n = 0; n < 4; ++n) {
        const int c = h * 64 + 16 * n + fr;
        float xv[16], y[16];
#pragma unroll
        for (int e = 0; e < 16; ++e) { xv[e] = bf2f(*(const LAS bf16*)(lds + L_XCT + (fq * 16 + e) * XCT_STRIDE + c * 2)); y[e] = 0.f; }
#pragma unroll
        for (int d = 0; d < 2; ++d) {
            const float br = GB[((l * 2 + d) * 2 + 0) * WL + c], bi = GB[((l * 2 + d) * 2 + 1) * WL + c];
            f32x4 ar[4], ai[4];
#pragma unroll
            for (int m = 0; m < 4; ++m) { ar[m] = (f32x4){br, br, br, br}; ai[m] = (f32x4){bi, bi, bi, bi}; }
            const bf16* wr = GWS + ((size_t)(((l * 2 + d) * 2 + 0) * 8 + h) * 64 + 16 * n + fr) * 64 + fq * 8;
            const bf16* wi = GWS + ((size_t)(((l * 2 + d) * 2 + 1) * 8 + h) * 64 + 16 * n + fr) * 64 + fq * 8;
            bf16x8 Br[2], Bi[2];
#pragma unroll
            for (int ks = 0; ks < 2; ++ks) { Br[ks] = *(const bf16x8*)(wr + ks * 32); Bi[ks] = *(const bf16x8*)(wi + ks * 32); }
#pragma unroll
            for (int m = 0; m < 4; ++m)
#pragma unroll
                for (int ks = 0; ks < 2; ++ks) { ar[m] = __builtin_amdgcn_mfma_f32_16x16x32_bf16(A[m][ks], Br[ks], ar[m], 0, 0, 0); ai[m] = __builtin_amdgcn_mfma_f32_16x16x32_bf16(A[m][ks], Bi[ks], ai[m], 0, 0, 0); }
            const float kc = KC[(l * 2 + d) * WL + c];
            float av[16], bv[16];
#pragma unroll
            for (int e = 0; e < 16; ++e) {
                const float er = __builtin_amdgcn_exp2f(ar[e >> 2][e & 3]), ei = __builtin_amdgcn_exp2f(ai[e >> 2][e & 3]);
                const float r = __builtin_amdgcn_rcpf(1.0f + er), ig = __builtin_amdgcn_rcpf(1.0f + ei);
                const float a = __builtin_amdgcn_exp2f(kc * r);
                av[e] = a; bv[e] = __builtin_amdgcn_sqrtf(fmaxf(1.0f - a * a, 0.0f)) * (ig * xv[e]);
            }
            float Pq = 1.f, Hq = 0.f;
#pragma unroll
            for (int s = 0; s < 16; ++s) { const int e = d ? 15 - s : s; Hq = av[e] * Hq + bv[e]; Pq *= av[e]; bv[e] = Hq; av[e] = Pq; }
            float Pg[4], Hg[4];
#pragma unroll
            for (int q = 0; q < 4; ++q) { Pg[q] = __shfl(Pq, fr + 16 * q); Hg[q] = __shfl(Hq, fr + 16 * q); }
            if constexpr (MODE == 0) {
                float At = 1.f, Ht = 0.f;
#pragma unroll
                for (int s = 0; s < 4; ++s) { const int q = d ? 3 - s : s; Ht = Pg[q] * Ht + Hg[q]; At *= Pg[q]; }
                if (fq == 0) { float2 o2; o2.x = At; o2.y = Ht; *(float2*)(sum_out + ((size_t)d * WL + c) * 2) = o2; }
            } else {
                float cq = *(const LAS float*)(lds + L_CIN + (d * WL + c) * 4);
#pragma unroll
                for (int s = 0; s < 4; ++s) { const int q = d ? 3 - s : s; const bool before = d ? (q > fq) : (q < fq); if (before) cq = Pg[q] * cq + Hg[q]; }
#pragma unroll
                for (int e = 0; e < 16; ++e) y[e] += bv[e] + av[e] * cq;
            }
        }
        if constexpr (MODE == 1) {
#pragma unroll
            for (int e = 0; e < 16; ++e) { LAS bf16* gp = (LAS bf16*)(lds + L_GZ + (fq * 16 + e) * XCT_STRIDE + c * 2); const float g = bf2f(*gp);
                *gp = (bf16)f2bf(y[e] * g * __builtin_amdgcn_rcpf(1.0f + __builtin_amdgcn_exp2f(-LOG2E * g))); }
        }
    }
}

constexpr int T_STRIDE = 528;
constexpr int L_DT = 0, L_ZP = 33792;
constexpr int L_ZC = 0, L_CT = 48128, L_CLT = 0, L_ZS = 48128;
__device__ __forceinline__ float silu_fast(float g) { return g * __builtin_amdgcn_rcpf(1.0f + __builtin_amdgcn_exp2f(-LOG2E * g)); }
__device__ __forceinline__ float sigm_fast(float g) { return __builtin_amdgcn_rcpf(1.0f + __builtin_amdgcn_exp2f(-LOG2E * g)); }

template <int NCH> __device__ __forceinline__ void tile_out(LAS unsigned char* lds, int off, int stride, bf16* Zg, int r0, int col0, int tid) {
    constexpr int RPI = NT / NCH;
    const int ch = tid % NCH, rr = tid / NCH;
#pragma unroll
    for (int it = 0; it < 64 / RPI; ++it) { const int row = it * RPI + rr;
        *(v4u*)(Zg + (size_t)(r0 + row) * DM + col0 + ch * 8) = *(const LAS v4u*)(lds + off + row * stride + ch * 16); }
}

__device__ __forceinline__ void pool_part(LAS unsigned char* lds, const Ptrs& P, int l, const bf16* UX, const bf16* PWt, bf16* Zg, int r0, int tpos0, int n, int tid, int wave, int lane) {
    asm volatile("" : "+v"(tid)); lane = tid & 63; wave = __builtin_amdgcn_readfirstlane(tid >> 6);
    {
        const int o = tid & 31, g = o >> 3, w2 = 1 << g, c0 = 8 * o;
#pragma unroll 1
        for (int it = 0; it < 4; ++it) { const int tok = it * 16 + (tid >> 5), t = tpos0 + tok;
            int lo = t - w2; lo = lo < 0 ? 0 : lo; int hi = t + w2; hi = hi > n ? n : hi;
            float sum[8];
#pragma unroll
            for (int q = 0; q < 8; ++q) sum[q] = 0.f;
            const bf16* colp = UX + (size_t)(r0 - tpos0) * NIN + C_VP + c0;
#pragma unroll 4
            for (int tt = lo; tt < hi; ++tt) { const v4u x = *(const v4u*)(colp + (size_t)tt * NIN);
                sum[0] += bflo(x.x); sum[1] += bfhi(x.x); sum[2] += bflo(x.y); sum[3] += bfhi(x.y); sum[4] += bflo(x.z); sum[5] += bfhi(x.z); sum[6] += bflo(x.w); sum[7] += bfhi(x.w); }
            const v4u xc = *(const v4u*)(colp + (size_t)t * NIN); const float inv = 1.0f / (float)(hi - lo);
            v4u ov; ov.x = pk2(sum[0] * inv - bflo(xc.x), sum[1] * inv - bfhi(xc.x)); ov.y = pk2(sum[2] * inv - bflo(xc.y), sum[3] * inv - bfhi(xc.y));
            ov.z = pk2(sum[4] * inv - bflo(xc.z), sum[5] * inv - bfhi(xc.z)); ov.w = pk2(sum[6] * inv - bflo(xc.w), sum[7] * inv - bfhi(xc.w));
            *(LAS v4u*)(lds + L_DT + tok * T_STRIDE + o * 16) = ov; }
    }
    __syncthreads();
    {
        const int fr = lane & 15, fq = lane >> 4, g = wave >> 1, nh = wave & 1;
        bf16x8 A[4][2];
#pragma unroll
        for (int m = 0; m < 4; ++m)
#pragma unroll
            for (int ks = 0; ks < 2; ++ks) A[m][ks] = *(const LAS bf16x8*)(lds + L_DT + (16 * m + fr) * T_STRIDE + (g * 64 + ks * 32 + fq * 8) * 2);
#pragma unroll
        for (int ni = 0; ni < 2; ++ni) { const int nn = 2 * nh + ni, cc = g * 64 + 16 * nn + fr;
            const bf16* wp = PWt + ((size_t)((l * 4 + g) * 64 + 16 * nn + fr)) * 64 + fq * 8;
            const bf16x8 B0 = *(const bf16x8*)(wp), B1 = *(const bf16x8*)(wp + 32);
            const float ps = P.pool_scale[l * WP + cc];
#pragma unroll
            for (int m = 0; m < 4; ++m) { f32x4 acc = (f32x4){0.f, 0.f, 0.f, 0.f};
                acc = __builtin_amdgcn_mfma_f32_16x16x32_bf16(A[m][0], B0, acc, 0, 0, 0); acc = __builtin_amdgcn_mfma_f32_16x16x32_bf16(A[m][1], B1, acc, 0, 0, 0);
#pragma unroll
                for (int j = 0; j < 4; ++j) { const int tok = 16 * m + 4 * fq + j; const float gt = bf2f(UX[(size_t)(r0 + tok) * NIN + C_GP + cc]);
                    *(LAS bf16*)(lds + L_ZP + tok * T_STRIDE + cc * 2) = (bf16)f2bf(acc[j] * ps * silu_fast(gt)); } }
        }
    }
    __syncthreads();
    tile_out<32>(lds, L_ZP, T_STRIDE, Zg, r0, 512, tid);
    __syncthreads();
}

__device__ __forceinline__ void conf_part(LAS unsigned char* lds, const Ptrs& P, int l, const bf16* UX, const bf16* CPWt, bf16* Zg, int r0, int tpos0, int n, int tid, int wave, int lane) {
    asm volatile("" : "+v"(tid)); lane = tid & 63; wave = __builtin_amdgcn_readfirstlane(tid >> 6);
    {
        const int o = tid & 31, rg = tid >> 5, c0 = 8 * o;
#pragma unroll
        for (int it = 0; it < 6; ++it) { const int rho = it * 16 + rg; if (rho < 94) { const int tp = tpos0 + rho - 15; v4u ov = (v4u){0u, 0u, 0u, 0u};
            if (tp >= 0 && tp < n) { const bf16* rp = UX + (size_t)(r0 + rho - 15) * NIN; const v4u a = *(const v4u*)(rp + C_VC + c0), b = *(const v4u*)(rp + C_GG + c0);
                ov.x = pk2(bflo(a.x) * sigm_fast(bflo(b.x)), bfhi(a.x) * sigm_fast(bfhi(b.x))); ov.y = pk2(bflo(a.y) * sigm_fast(bflo(b.y)), bfhi(a.y) * sigm_fast(bfhi(b.y)));
                ov.z = pk2(bflo(a.z) * sigm_fast(bflo(b.z)), bfhi(a.z) * sigm_fast(bfhi(b.z))); ov.w = pk2(bflo(a.w) * sigm_fast(bflo(b.w)), bfhi(a.w) * sigm_fast(bfhi(b.w))); }
            *(LAS v4u*)(lds + L_ZC + rho * 512 + o * 16) = ov; } }
    }
    __syncthreads();
    {
        const int c = tid & 255, hf = tid >> 8;
        float w[31];
#pragma unroll
        for (int k = 0; k < 31; ++k) w[k] = P.conf_dw[(size_t)(l * 31 + k) * WC + c];
        const float bias = P.conf_dw_b[l * WC + c];
#pragma unroll 1
        for (int sh = 0; sh < 2; ++sh) { const int t0 = 32 * hf + 16 * sh; float acc[16];
#pragma unroll
            for (int oo = 0; oo < 16; ++oo) acc[oo] = bias;
#pragma unroll
            for (int rr = 0; rr < 46; ++rr) { const float val = bf2f(*(const LAS bf16*)(lds + L_ZC + (t0 + rr) * 512 + c * 2));
#pragma unroll
                for (int oo = 0; oo < 16; ++oo) { if (rr - oo >= 0 && rr - oo <= 30) acc[oo] += val * w[rr - oo]; } }
#pragma unroll
            for (int oo = 0; oo < 16; ++oo) *(LAS float*)(lds + L_CT + (t0 + oo) * 1024 + c * 4) = acc[oo]; }
    }
    __syncthreads();
    {
        const f32x4 lg = *(const f32x4*)(P.conf_ln_g + l * WC + 4 * lane), lb = *(const f32x4*)(P.conf_ln_b + l * WC + 4 * lane);
#pragma unroll
        for (int i = 0; i < 8; ++i) { const int tok = 8 * wave + i; const f32x4 v = *(const LAS f32x4*)(lds + L_CT + tok * 1024 + lane * 16);
            const float mu = wave_sum((v[0] + v[1]) + (v[2] + v[3])) * (1.0f / 256.0f); const f32x4 dv = v - mu;
            const float var = wave_sum((dv[0] * dv[0] + dv[1] * dv[1]) + (dv[2] * dv[2] + dv[3] * dv[3])) * (1.0f / 256.0f);
            const float rstd = 1.0f / sqrtf(var + EPS_LN); float o4[4];
#pragma unroll
            for (int e = 0; e < 4; ++e) o4[e] = silu_fast(dv[e] * rstd * lg[e] + lb[e]);
            v2u ov; ov.x = pk2(o4[0], o4[1]); ov.y = pk2(o4[2], o4[3]);
            *(LAS v2u*)(lds + L_CLT + tok * T_STRIDE + lane * 8) = ov; }
    }
    __syncthreads();
    {
        const int fr = lane & 15, fq = lane >> 4;
        f32x4 acc[4][2];
#pragma unroll
        for (int m = 0; m < 4; ++m) { acc[m][0] = (f32x4){0.f, 0.f, 0.f, 0.f}; acc[m][1] = (f32x4){0.f, 0.f, 0.f, 0.f}; }
        const bf16* wp0 = CPWt + ((size_t)(l * 256 + 16 * (2 * wave) + fr)) * 256 + fq * 8;
        const bf16* wp1 = wp0 + 16 * 256;
#pragma unroll
        for (int ks = 0; ks < 8; ++ks) { const bf16x8 B0 = *(const bf16x8*)(wp0 + ks * 32), B1 = *(const bf16x8*)(wp1 + ks * 32);
#pragma unroll
            for (int m = 0; m < 4; ++m) { const bf16x8 A = *(const LAS bf16x8*)(lds + L_CLT + (16 * m + fr) * T_STRIDE + (ks * 32 + fq * 8) * 2);
                acc[m][0] = __builtin_amdgcn_mfma_f32_16x16x32_bf16(A, B0, acc[m][0], 0, 0, 0); acc[m][1] = __builtin_amdgcn_mfma_f32_16x16x32_bf16(A, B1, acc[m][1], 0, 0, 0); } }
#pragma unroll
        for (int ni = 0; ni < 2; ++ni) { const int ee = 16 * (2 * wave + ni) + fr;
#pragma unroll
            for (int m = 0; m < 4; ++m)
#pragma unroll
                for (int j = 0; j < 4; ++j) { const int tok = 16 * m + 4 * fq + j; const float gt = bf2f(UX[(size_t)(r0 + tok) * NIN + C_GC + ee]);
                    *(LAS bf16*)(lds + L_ZS + tok * T_STRIDE + ee * 2) = (bf16)f2bf(acc[m][ni][j] * silu_fast(gt)); } }
    }
    __syncthreads();
    tile_out<32>(lds, L_ZS, T_STRIDE, Zg, r0, 768, tid);
    __syncthreads();
}

__device__ __forceinline__ void mixer_strip(LAS unsigned char* lds, const Ptrs& P, int l, int b, int ck, const bf16* UX, bf16* Zg, const bf16* GWS, const float* GB, const float* KC, const float* SUM,
                                            const bf16* PWt, const bf16* CPWt, int tid, int wave, int lane) {
    const int r0 = chunk_row0(b, ck), tpos0 = ck < 4 ? 64 * ck : 64 * (ck - 4), n = ck < 4 ? CTXL : SEQ;
    asm volatile("" : "+v"(tid)); lane = tid & 63; wave = __builtin_amdgcn_readfirstlane(tid >> 6);
    strip_conv(lds, P, l, UX, r0, tpos0, n, tid);
    {
        const int o = tid & 63, tg = tid >> 6;
#pragma unroll
        for (int i = 0; i < 8; ++i) { const int tok = 8 * tg + i; *(LAS v4u*)(lds + L_GZ + tok * XCT_STRIDE + o * 16) = *(const v4u*)(UX + (size_t)(r0 + tok) * NIN + C_GL + 8 * o); }
    }
    {
        const int c = tid; const float* sb = SUM + (size_t)b * NCHUNK * 2 * WL * 2;
        float h = 0.f;
        for (int q = 0; q < ck; ++q) { const float2 s2 = *(const float2*)(sb + ((size_t)(q * 2 + 0) * WL + c) * 2); h = s2.x * h + s2.y; }
        *(LAS float*)(lds + L_CIN + c * 4) = h;
        h = 0.f;
        if (ck < 4) { for (int q = 3; q > ck; --q) { const float2 s2 = *(const float2*)(sb + ((size_t)(q * 2 + 1) * WL + c) * 2); h = s2.x * h + s2.y; } }
        else { for (int q = 3; q >= 0; --q) { const float2 s2 = *(const float2*)(sb + ((size_t)(q * 2 + 1) * WL + c) * 2); h = s2.x * h + s2.y; }
               for (int q = NCHUNK - 1; q > ck; --q) { const float2 s2 = *(const float2*)(sb + ((size_t)(q * 2 + 1) * WL + c) * 2); h = s2.x * h + s2.y; } }
        *(LAS float*)(lds + L_CIN + (WL + c) * 4) = h;
    }
    __syncthreads();
    asm volatile("" : "+v"(tid)); lane = tid & 63; wave = __builtin_amdgcn_readfirstlane(tid >> 6);
#ifndef NO_LRU
    lru_core<1>(lds, l, wave, lane, GWS, GB, KC, nullptr);
#endif
    __syncthreads();
    tile_out<64>(lds, L_GZ, XCT_STRIDE, Zg, r0, 0, tid);
    __syncthreads();
#ifndef NO_POOL
    pool_part(lds, P, l, UX, PWt, Zg, r0, tpos0, n, tid, wave, lane);
#endif
#ifndef NO_CONF
    conf_part(lds, P, l, UX, CPWt, Zg, r0, tpos0, n, tid, wave, lane);
#endif
}

enum { K_PREP = 100, K_EMBED = 101 };
typedef const __attribute__((address_space(4))) Args* KArgs;
template <int KIND> __device__ __forceinline__ void run_phase(KArgs ap_in, LAS unsigned char* lds, const int l) {
    KArgs ap = ap_in; asm volatile("" : "+s"(ap));
    const Args args = *(const Args*)ap;
    const Ptrs& P = args.p;
    int tid_ = threadIdx.x; asm volatile("" : "+v"(tid_));
    const int tid = tid_, lane = tid & 63, wave = __builtin_amdgcn_readfirstlane(tid >> 6);
    const int G = gridDim.x, bx = blockIdx.x;
    const int gtid = bx * NT + tid, NTH = G * NT;
    const int gw = bx * 8 + wave, NGW = G * 8;
    unsigned char* ws = args.ws;
    float* MOD = (float*)(ws + WS_MOD);
    bf16* GW = (bf16*)(ws + WS_GW); bf16* PW = (bf16*)(ws + WS_PW); bf16* CPW = (bf16*)(ws + WS_CPW);
    bf16* WIN = (bf16*)(ws + WS_WIN); bf16* WOUT = (bf16*)(ws + WS_WOUT);
    bf16* HX = (bf16*)(ws + WS_HX); bf16* Z = HX; bf16* UX = (bf16*)(ws + WS_UX);
    float* XC = (float*)(ws + WS_R2); float* Y = (float*)(ws + WS_R2 + 36 * MiB);
    float* Dp = (float*)(ws + WS_R2); float* ZC = (float*)(ws + WS_R2 + 18 * MiB); float* CL = (float*)(ws + WS_R2 + 36 * MiB);
    float* O = (float*)(ws + WS_R2);
    float* CTXR = (float*)(ws + WS_CTXR); float* SUM = (float*)(ws + WS_SUM);
    float* out = args.out;

    {
        if constexpr (KIND == K_PREP) {
            LAS float* scr = (LAS float*)(lds + wave * 16384);
            constexpr int I_IN = 16 * 72, I_OUT = 16 * 32, I_CPW = 4 * 8, I_S = 2;
            constexpr int N_IN = 4 * I_IN, N_OUT = 4 * I_OUT, N_CPW = 4 * I_CPW, N_PW = 16 * I_S, N_GW = 64 * I_S;
            constexpr int NITEMS = N_IN + N_OUT + N_CPW + N_PW + 2 * N_GW;
            for (int it = gw; it < NITEMS; it += NGW) {
                int r = it;
                if (r < N_IN) { const int l = r / I_IN; transpose_item(P.w_in + (size_t)l * DM * NIN, DM, NIN, WIN + (size_t)l * NIN * DM, scr, r % I_IN, lane); continue; } r -= N_IN;
                if (r < N_OUT) { const int l = r / I_OUT; transpose_item(P.w_out + (size_t)l * DM * DM, DM, DM, WOUT + (size_t)l * DM * DM, scr, r % I_OUT, lane); continue; } r -= N_OUT;
                if (r < N_CPW) { const int l = r / I_CPW; transpose_item(P.conf_pw + (size_t)l * 65536, 256, 256, CPW + (size_t)l * 65536, scr, r % I_CPW, lane); continue; } r -= N_CPW;
                if (r < N_PW) { const int m = r / I_S; transpose_item(P.pool_w + (size_t)m * 4096, 64, 64, PW + (size_t)m * 4096, scr, r % I_S, lane); continue; } r -= N_PW;
                if (r < N_GW) { const int m = r / I_S; const int ld = m >> 3, h = m & 7;
                    transpose_item(P.lru_wa + (size_t)m * 4096, 64, 64, GW + (size_t)((ld * 2 + 0) * 8 + h) * 4096, scr, r % I_S, lane, -LOG2E); continue; } r -= N_GW;
                { const int m = r / I_S; const int ld = m >> 3, h = m & 7;
                    transpose_item(P.lru_wx + (size_t)m * 4096, 64, 64, GW + (size_t)((ld * 2 + 1) * 8 + h) * 4096, scr, r % I_S, lane, -LOG2E); }
            }
            for (int i = gtid; i < 4 * 2 * 2 * WL; i += NTH) { const int c = i & 511, gate = (i >> 9) & 1, ld = i >> 10;
                ((float*)(ws + WS_GB))[i] = -LOG2E * (gate ? P.lru_bx[ld * WL + c] : P.lru_ba[ld * WL + c]); }
            for (int i = gtid; i < 4 * 2 * WL; i += NTH) ((float*)(ws + WS_KC))[i] = -8.0f * LOG2E * log1pf(expf(-P.lru_lambda[i]));
            __syncthreads();
            LAS float* S = (LAS float*)lds;
            LAS float* RED = (LAS float*)(lds + 40960);
            for (int i = tid; i < 9 * 1024; i += NT) { const int r = i >> 10, k = i & 1023; const float v = r < 8 ? P.c[r * 1024 + k] : P.c_ctx[k]; S[i] = siluf_(v); }
            __syncthreads();
            for (int it = bx; it < 4 * 48; it += G) {
                const int l = it / 48, j0 = (it % 48) * 64, j = tid & 63, ks = tid >> 6;
                float acc[9];
#pragma unroll
                for (int r = 0; r < 9; ++r) acc[r] = 0.f;
                const float* wp = P.w_mod + (size_t)l * 1024 * 3072 + (size_t)(ks * 128) * 3072 + j0 + j;
#pragma unroll 4
                for (int k = 0; k < 128; ++k) { const float w = wp[(size_t)k * 3072];
#pragma unroll
                    for (int r = 0; r < 9; ++r) acc[r] += S[r * 1024 + ks * 128 + k] * w; }
#pragma unroll
                for (int r = 0; r < 9; ++r) RED[(ks * 9 + r) * 64 + j] = acc[r];
                __syncthreads();
                for (int i = tid; i < 9 * 64; i += NT) { const int r = i >> 6, jj = i & 63; float s = P.b_mod[l * 3072 + j0 + jj];
#pragma unroll
                    for (int q = 0; q < 8; ++q) s += RED[(q * 9 + r) * 64 + jj];
                    MOD[(size_t)(l * 9 + r) * 3072 + j0 + jj] = s; }
                __syncthreads();
            }
        } else if constexpr (KIND == K_EMBED) {
            for (int r = gw; r < MT; r += NGW) {
                int b, t, n, base; row_info(r, b, t, n, base);
                const bool isx = r < MX; const int mr = isx ? b : 8;
                const float* src = isx ? P.x + (size_t)r * DM : P.ctx + (size_t)(r - MX) * DM;
                float* dst = isx ? out + (size_t)r * DM : CTXR + (size_t)(r - MX) * DM;
                f32x4 v[4]; float ss = 0.f;
#pragma unroll
                for (int j = 0; j < 4; ++j) {
                    v[j] = *(const f32x4*)(src + 256 * j + 4 * lane);
                    if (isx) {
                        const float p = (j < 2) ? (float)(t >> 6) : (float)(t & 63);
#pragma unroll
                        for (int e = 0; e < 4; ++e) { const int i = 4 * lane + e; const float om = 1.0f / powf(10000.0f, (float)i / 256.0f); const float ang = p * om;
                            v[j][e] += (j & 1) ? cosf(ang) : sinf(ang); }
                    }
                    *(f32x4*)(dst + 256 * j + 4 * lane) = v[j];
                    ss += (v[j][0] * v[j][0] + v[j][1] * v[j][1]) + (v[j][2] * v[j][2] + v[j][3] * v[j][3]);
                }
                const float rstd = 1.0f / sqrtf(wave_sum(ss) * (1.0f / DM) + EPS_RMS);
                const float* sh = MOD + (size_t)(0 * 9 + mr) * 3072; const float* sc = sh + 1024;
#pragma unroll
                for (int j = 0; j < 4; ++j) { const int d0 = 256 * j + 4 * lane; float h[4];
#pragma unroll
                    for (int e = 0; e < 4; ++e) h[e] = v[j][e] * rstd * P.g_pre[d0 + e] * (1.0f + sc[d0 + e]) + sh[d0 + e];
                    uint2 w; w.x = pk2(h[0], h[1]); w.y = pk2(h[2], h[3]); *(uint2*)(HX + (size_t)r * DM + d0) = w; }
            }
        } else {
            constexpr int k = KIND;
            if constexpr (k == 0) {
                pg8::Gemm g{HX, WIN + (size_t)l * NIN * DM, MT, NIN, DM}; pg8::StaticOrder S; S.init(MT, NIN, G, bx);
                pg8::EpiBf16<0> E{UX, NIN, nullptr, 0, 0, 1.f};
                pg8::gemm_phase<pg8::EpiBf16<0>, pg8::StaticOrder, true, true>(lds, g, S, E);
            } else if constexpr (k == 2) {
                for (int sidx = bx; sidx < NB * NCHUNK; sidx += G) { const int b = sidx / NCHUNK, ck = sidx % NCHUNK;
                    const int r0 = chunk_row0(b, ck), tpos0 = ck < 4 ? 64 * ck : 64 * (ck - 4), n = ck < 4 ? CTXL : SEQ;
                    strip_conv(lds, P, l, UX, r0, tpos0, n, tid);
                    __syncthreads();
                    lru_core<0>(lds, l, wave, lane, GW, (const float*)(ws + WS_GB), (const float*)(ws + WS_KC), SUM + (size_t)sidx * 2 * WL * 2);
                    __syncthreads();
                }
            } else if constexpr (k == 3) {
                for (int sidx = bx; sidx < NB * NCHUNK; sidx += G) { const int b = sidx / NCHUNK, ck = sidx % NCHUNK;
                    if (l == DEPTH - 1 && ck < 4) continue;
                    mixer_strip(lds, P, l, b, ck, UX, Z, GW, (const float*)(ws + WS_GB), (const float*)(ws + WS_KC), SUM, PW, CPW, tid, wave, lane);
                }
            } else if constexpr (k == 7) {
                pg8::Gemm g{Z, WOUT + (size_t)l * DM * DM, MT, DM, DM}; pg8::StaticOrder S; S.init(MT, DM, G, bx);
                EpiF32 E{O, DM};
                pg8::gemm_phase<EpiF32, pg8::StaticOrder, true, true>(lds, g, S, E);
            } else {
                for (int r = gw; r < MT; r += NGW) {
                    const bool isx = r < MX; if (!isx && l == DEPTH - 1) continue;
                    const int b = isx ? (r >> 11) : ((r - MX) >> 8); const int mr = isx ? b : 8;
                    float* xr = isx ? out + (size_t)r * DM : CTXR + (size_t)(r - MX) * DM;
                    const float* orow = O + (size_t)r * DM; const float* gt = MOD + (size_t)(l * 9 + mr) * 3072 + 2048;
                    f32x4 o[4]; float ss = 0.f;
#pragma unroll
                    for (int j = 0; j < 4; ++j) { o[j] = *(const f32x4*)(orow + 256 * j + 4 * lane); ss += (o[j][0] * o[j][0] + o[j][1] * o[j][1]) + (o[j][2] * o[j][2] + o[j][3] * o[j][3]); }
                    const float rstd = 1.0f / sqrtf(wave_sum(ss) * (1.0f / DM) + EPS_RMS);
                    f32x4 v[4]; float s2 = 0.f;
#pragma unroll
                    for (int j = 0; j < 4; ++j) { const int d0 = 256 * j + 4 * lane; v[j] = *(const f32x4*)(xr + d0);
#pragma unroll
                        for (int e = 0; e < 4; ++e) v[j][e] += gt[d0 + e] * (o[j][e] * rstd * P.g_post[l * DM + d0 + e]);
                        *(f32x4*)(xr + d0) = v[j];
                        s2 += (v[j][0] * v[j][0] + v[j][1] * v[j][1]) + (v[j][2] * v[j][2] + v[j][3] * v[j][3]); }
                    if (l < DEPTH - 1) {
                        const float rs2 = 1.0f / sqrtf(wave_sum(s2) * (1.0f / DM) + EPS_RMS);
                        const float* sh = MOD + (size_t)((l + 1) * 9 + mr) * 3072; const float* sc = sh + 1024;
#pragma unroll
                        for (int j = 0; j < 4; ++j) { const int d0 = 256 * j + 4 * lane; float h[4];
#pragma unroll
                            for (int e = 0; e < 4; ++e) h[e] = v[j][e] * rs2 * P.g_pre[(l + 1) * DM + d0 + e] * (1.0f + sc[d0 + e]) + sh[d0 + e];
                            uint2 w; w.x = pk2(h[0], h[1]); w.y = pk2(h[2], h[3]); *(uint2*)(HX + (size_t)r * DM + d0) = w; }
                    }
                }
            }
        }
    }
}


#define XB_TMO      128
#define XB_XCNT(j)  (256  + 64 * (j))
#define XB_XSUB(j)  (1280 + 64 * (j))
#define XB_XGEN(j)  (2304 + 64 * (j))
#define XB_TOP      3328
#define XB_TOPGEN   3392
#define XCD_BAR_WORDS 3456
#define XB_SPIN_CAP (1u << 18)
constexpr int CW_BAR = 4096;
__device__ __forceinline__ unsigned xb_ld(unsigned* p)              { return __hip_atomic_load(p, __ATOMIC_RELAXED, __HIP_MEMORY_SCOPE_AGENT); }
__device__ __forceinline__ unsigned xb_add(unsigned* p, unsigned v) { return __hip_atomic_fetch_add(p, v, __ATOMIC_RELAXED, __HIP_MEMORY_SCOPE_AGENT); }
__device__ __forceinline__ unsigned xb_xcc_id() { return (unsigned)__builtin_amdgcn_s_getreg((3 << 11) | 20) & 0xFu; }
#define XB_SPIN(cond, bar) do { unsigned _sp = 0; while (cond) { __builtin_amdgcn_s_sleep(1); \
    if ((++_sp & 255u) == 0u) { if (xb_ld(&(bar)[XB_TMO])) break; if (_sp > XB_SPIN_CAP) { atomicAdd(&(bar)[XB_TMO], 1u); break; } } } } while (0)
struct XcdBarrier { unsigned* bar; unsigned x; volatile LAS unsigned* st; };
__device__ __forceinline__ XcdBarrier xcd_barrier_post(unsigned* bar, volatile LAS unsigned* st) {
    XcdBarrier b; b.bar = bar; b.x = xb_xcc_id(); b.st = st;
    if (threadIdx.x == 0) (void)xb_add(&bar[XB_XCNT(b.x)], 1u);
    return b;
}
__device__ __forceinline__ void xcd_barrier_complete(unsigned* bar, unsigned x, unsigned& nloc, unsigned& nx) {
    const unsigned G = gridDim.x * gridDim.y * gridDim.z;
    unsigned sum, cnt, mine, sp = 0u;
    for (;;) {
        sum = 0u; cnt = 0u; mine = 0u;
#pragma unroll
        for (unsigned j = 0; j < 16; ++j) { const unsigned c = xb_ld(&bar[XB_XCNT(j)]); sum += c; cnt += (c > 0u) ? 1u : 0u; mine = (j == x) ? c : mine; }
        if (sum == G) break;
        __builtin_amdgcn_s_sleep(1);
        if ((++sp & 255u) == 0u) { if (xb_ld(&bar[XB_TMO])) break; if (sp > XB_SPIN_CAP) { atomicAdd(&bar[XB_TMO], 1u); break; } }
    }
    nloc = mine > 0u ? mine : 1u; nx = cnt > 0u ? cnt : 1u;
}
__device__ __forceinline__ void xcd_barrier(const XcdBarrier& b) {
    asm volatile("s_waitcnt vmcnt(0)" ::: "memory");
    __syncthreads();
    if (threadIdx.x == 0) {
        unsigned* bar = b.bar;
        __builtin_amdgcn_s_waitcnt(0);
        unsigned nloc = b.st[0], nx = b.st[1];
        if (nloc == 0u) { xcd_barrier_complete(bar, b.x, nloc, nx); b.st[0] = nloc; b.st[1] = nx; }
        const unsigned old = xb_add(&bar[XB_XSUB(b.x)], 1u);
        const unsigned gen = old / nloc;
        if (old + 1u == (gen + 1u) * nloc) {
            __builtin_amdgcn_fence(__ATOMIC_RELEASE, "agent");
            asm volatile("s_waitcnt vmcnt(0)" ::: "memory");
            const unsigned og = xb_add(&bar[XB_TOP], 1u);
            const unsigned tg = og / nx;
            if (og + 1u == (tg + 1u) * nx) xb_add(&bar[XB_TOPGEN], 1u);
            else XB_SPIN(xb_ld(&bar[XB_TOPGEN]) == tg, bar);
            __builtin_amdgcn_fence(__ATOMIC_ACQUIRE, "agent");
            xb_add(&bar[XB_XGEN(b.x)], 1u);
            asm volatile("s_waitcnt vmcnt(0)" ::: "memory");
        } else {
            XB_SPIN(xb_ld(&bar[XB_XGEN(b.x)]) == gen, bar);
            __builtin_amdgcn_fence(__ATOMIC_ACQUIRE, "agent");
            asm volatile("s_waitcnt vmcnt(0)" ::: "memory");
        }
    }
    __syncthreads();
}

template <int KIND> __global__ void __launch_bounds__(NT, 2) fwd(Args args) {
    extern __shared__ __attribute__((aligned(16))) unsigned char lds_raw[];
    KArgs ap = (KArgs)__builtin_amdgcn_kernarg_segment_ptr();
    run_phase<KIND>(ap, (LAS unsigned char*)lds_raw, args.ph_lo);
}
__global__ void __launch_bounds__(NT, 2) fwd_all(Args args) {
    extern __shared__ __attribute__((aligned(16))) unsigned char lds_raw[];
    LAS unsigned char* lds = (LAS unsigned char*)lds_raw;
    volatile LAS unsigned* MISC = (volatile LAS unsigned*)(lds + MISC_OFF);
    if (threadIdx.x < 32) MISC[threadIdx.x] = 0u;
    __syncthreads();
    KArgs ap = (KArgs)__builtin_amdgcn_kernarg_segment_ptr();
    XcdBarrier bar = xcd_barrier_post((unsigned*)(args.ws + WS_CTL) + CW_BAR, MISC + 8);
    run_phase<K_PREP>(ap, lds, 0); xcd_barrier(bar);
    run_phase<K_EMBED>(ap, lds, 0); xcd_barrier(bar);
#pragma unroll 1
    for (int l = 0; l < DEPTH; ++l) {
        run_phase<0>(ap, lds, l); xcd_barrier(bar);
        run_phase<2>(ap, lds, l); xcd_barrier(bar);
        run_phase<3>(ap, lds, l); xcd_barrier(bar);
        run_phase<7>(ap, lds, l); xcd_barrier(bar);
        run_phase<8>(ap, lds, l); if (l < DEPTH - 1) xcd_barrier(bar);
    }
}

#ifndef N_LAUNCH_MODE
#define N_LAUNCH_MODE 1
#endif

extern "C" void kernel_launch(void* const* d_in, const int* in_sizes, int n_in, void* d_out, int out_size, void* d_ws, size_t ws_size, hipStream_t stream) {
    static int grid = 0, fused = 0;
    if (grid == 0) {
        if (n_in != 24 || in_sizes[0] != MX * DM || out_size != MX * DM || ws_size < WS_END) { fprintf(stderr, "kernel_launch: unexpected shapes (n_in %d, in0 %d, out %d, ws %zu)\n", n_in, n_in > 0 ? in_sizes[0] : -1, out_size, ws_size); grid = -1; return; }
        int dev = 0, cus = 0, per_cu = 0;
        if (hipGetDevice(&dev) != hipSuccess || hipDeviceGetAttribute(&cus, hipDeviceAttributeMultiprocessorCount, dev) != hipSuccess) { grid = -1; return; }
        bool ok = true;
#define SETA(F) ok = ok && (hipFuncSetAttribute((const void*)F, hipFuncAttributeMaxDynamicSharedMemorySize, LDS_BYTES) == hipSuccess)
        SETA(fwd<K_PREP>); SETA(fwd<K_EMBED>); SETA(fwd<0>); SETA(fwd<2>); SETA(fwd<3>); SETA(fwd<7>); SETA(fwd<8>); SETA(fwd_all);
        if (!ok) { fprintf(stderr, "kernel_launch: hipFuncSetAttribute failed\n"); grid = -1; return; }
        grid = cus;
        if (hipOccupancyMaxActiveBlocksPerMultiprocessor(&per_cu, (const void*)fwd_all, NT, LDS_BYTES) != hipSuccess) per_cu = 0;
        (void)hipGetLastError();
        fused = (N_LAUNCH_MODE == 1 && per_cu >= 1) ? 1 : 0;
        if (!fused) fprintf(stderr, "kernel_launch: falling back to one launch per phase (occupancy query: %d per CU)\n", per_cu);
    }
    if (grid < 0) return;
    (void)hipMemsetAsync((char*)d_ws + WS_CTL, 0, CTL_ZERO_BYTES, stream);
    Args a{};
    const float** pp = (const float**)&a.p;
    for (int i = 0; i < 24; ++i) pp[i] = (const float*)d_in[i];
    a.out = (float*)d_out; a.ws = (unsigned char*)d_ws;
    a.ph_lo = 0; a.ph_hi = 0;
    if (fused) { hipLaunchKernelGGL(fwd_all, dim3(grid), dim3(NT), LDS_BYTES, stream, a); return; }
#define LAUNCH(K) hipLaunchKernelGGL(fwd<K>, dim3(grid), dim3(NT), LDS_BYTES, stream, a)
    LAUNCH(K_PREP); LAUNCH(K_EMBED);
    for (int l = 0; l < DEPTH; ++l) { a.ph_lo = l; LAUNCH(0); LAUNCH(2); LAUNCH(3); LAUNCH(7); LAUNCH(8); }
}
```

```cpp
#include <hip/hip_runtime.h>
#include <cstdio>
#include <cstdint>
namespace pg8 {
#define PG8_LAS __attribute__((address_space(3)))
typedef unsigned short bf16_t;
typedef short bf16x8 __attribute__((ext_vector_type(8)));
typedef float f32x4 __attribute__((ext_vector_type(4)));
typedef unsigned u32x4 __attribute__((ext_vector_type(4)));
constexpr int BM = 256, BK = 64, HALF = 128, HTB = HALF * BK * 2  , STAGE_BYTES = 8 * HTB, NXCD = 8, WGM = 8;

__host__ __device__ __forceinline__ int lds_byte(int r, int c) { const int st = (r >> 4) * 2 + (c >> 5), rr = r & 15, cc = c & 31, ob = rr * 64 + cc * 2; return st * 1024 + (ob ^ (((ob >> 9) & 1) << 5)); }
__host__ __device__ __forceinline__ void stage_rc(int b, int& R, int& C) { const int st = b / 1024, sb = b % 1024, swz = sb ^ (((sb >> 9) & 1) << 5); R = (st >> 1) * 16 + swz / 64; C = (st & 1) * 32 + (swz % 64) / 2; }
__host__ __device__ __forceinline__ int perm32(int rho) { const int n = rho >> 4, i = rho & 15; return 8 * (i >> 2) + 4 * n + (i & 3); }

struct Unit { int pm, pn; };
struct Gemm { const bf16_t* A; const bf16_t* Bt; int M, N, K; };

struct StaticOrder {
    int nM, nN, nwg, G, c;
    __host__ __device__ void init(int M, int N, int G_, int c_) { nM = M / BM; nN = N / BM; nwg = nM * nN; G = G_; c = c_; }
    __host__ __device__ bool next(int i, Unit& u) const {
        const long L = (long)i * G + c; if (L >= nwg) return false;
        int wgid = (int)L; { const int q = nwg / NXCD, r = nwg % NXCD, xcd = wgid % NXCD, off = wgid / NXCD; wgid = (xcd < r ? xcd * (q + 1) : r * (q + 1) + (xcd - r) * q) + off; }
        const int nig = WGM * nN, gid = wgid / nig, fm = gid * WGM, gsz = (nM - fm) < WGM ? (nM - fm) : WGM;
        u.pm = fm + ((wgid % nig) % gsz); u.pn = (wgid % nig) / gsz; return true;
    }
    __device__ __forceinline__ void a_ready(const Unit&) const {}
    __device__ __forceinline__ void done(const Unit&) const {}
};

__device__ __forceinline__ unsigned cvt_pk_bf16(float lo, float hi) { unsigned r; asm volatile("v_cvt_pk_bf16_f32 %0, %1, %2" : "=v"(r) : "v"(lo), "v"(hi)); return r; }
typedef float f32x2 __attribute__((ext_vector_type(2)));
__device__ __forceinline__ f32x2 gelu_pk(f32x2 v) {
    const f32x2 av = __builtin_elementwise_abs(v), d = av * 0.2316418882f + 1.0f;
    f32x2 t; t.x = __builtin_amdgcn_rcpf(d.x); t.y = __builtin_amdgcn_rcpf(d.y);
    f32x2 q = t * 0.5307027145f + (-0.7265760135f); q = q * t + 0.7107068705f; q = q * t + (-0.142248368f); q = q * t + 0.127414796f; q = q * t;
    const f32x2 s = (v * v) * (-0.72134752044f);
    f32x2 e; e.x = __builtin_amdgcn_exp2f(s.x); e.y = __builtin_amdgcn_exp2f(s.y);
    const f32x2 m = v * (q * e), r = v - m;
    f32x2 o; o.x = v.x < 0.f ? m.x : r.x; o.y = v.y < 0.f ? m.y : r.y; return o;
}

template <int ACT  > struct EpiBf16 {
    static constexpr bool PERM = true, AFTER_DRAIN = false; static_assert(ACT == 0 || ACT == 1, "EpiBf16: ACT is 0 (none) or 1 (gelu_pk)");
    bf16_t* O; int ldc; const float* bias; int split_cols; size_t split_stride; float scale0;
    __device__ __forceinline__ void operator()(const f32x4 (&acc)[2][2][4][2], const Unit& u, int wr, int wc, int fr, int fq) const {
        const int row0 = u.pm * BM + wr * 64 + fr; int colt = u.pn * BM; bf16_t* base = O;
        float sc = 1.f; if (split_cols) { const int t = colt / split_cols; base += (size_t)t * split_stride; colt -= t * split_cols; if (t == 0) sc = scale0; }
        const int col0 = colt + wc * 32 + 8 * fq, bcol0 = u.pn * BM + wc * 32 + 8 * fq;
        f32x4 bv[2][2];
#pragma unroll
        for (int bj = 0; bj < 2; ++bj)
#pragma unroll
            for (int n = 0; n < 2; ++n) bv[bj][n] = bias ? *(const f32x4*)(bias + bcol0 + bj * HALF + 4 * n) : (f32x4){0.f, 0.f, 0.f, 0.f};
#pragma unroll
        for (int ai = 0; ai < 2; ++ai)
#pragma unroll
            for (int m = 0; m < 4; ++m) { bf16_t* rowp = base + (size_t)(row0 + ai * HALF + m * 16) * ldc + col0;
#pragma unroll
                for (int bj = 0; bj < 2; ++bj) { f32x4 v0 = acc[ai][bj][m][0] + bv[bj][0], v1 = acc[ai][bj][m][1] + bv[bj][1];
                    if (ACT == 1) { f32x2 a = gelu_pk((f32x2){v0[0], v0[1]}), b = gelu_pk((f32x2){v0[2], v0[3]}), c = gelu_pk((f32x2){v1[0], v1[1]}), d = gelu_pk((f32x2){v1[2], v1[3]});
                        v0 = (f32x4){a.x, a.y, b.x, b.y}; v1 = (f32x4){c.x, c.y, d.x, d.y}; }
                    v0 = v0 * sc; v1 = v1 * sc; u32x4 w; w.x = cvt_pk_bf16(v0[0], v0[1]); w.y = cvt_pk_bf16(v0[2], v0[3]); w.z = cvt_pk_bf16(v1[0], v1[1]); w.w = cvt_pk_bf16(v1[2], v1[3]);
                    *(u32x4*)(rowp + bj * HALF) = w; } }
    }
};

struct PanelStats {
    unsigned* xbuf;
    unsigned* cnt;
    unsigned* tmo;
    int ntn; float eps;
    unsigned code;
    __device__ __forceinline__ bool run(const f32x4 (&v)[2][2][4][2], const Unit& u, int wr, int wc, int fr, int fq, PG8_LAS unsigned char* lds, int wid, int lane) const {
        typedef float f32x2v __attribute__((ext_vector_type(2)));
        PG8_LAS f32x2v* P = (PG8_LAS f32x2v*)lds;
        PG8_LAS f32x2v* S = (PG8_LAS f32x2v*)(lds + 8192);
        PG8_LAS unsigned* flag = (PG8_LAS unsigned*)(lds + 8192 + 2048);
#pragma unroll
        for (int ai = 0; ai < 2; ++ai)
#pragma unroll
            for (int m = 0; m < 4; ++m) {
                float s = 0.f;
#pragma unroll
                for (int bj = 0; bj < 2; ++bj)
#pragma unroll
                    for (int n = 0; n < 2; ++n) { const f32x4 x = v[ai][bj][m][n]; s += (x[0] + x[1]) + (x[2] + x[3]); }
                s += __shfl_xor(s, 16); s += __shfl_xor(s, 32);
                const float mw = s * (1.0f / 64.0f); float q = 0.f;
#pragma unroll
                for (int bj = 0; bj < 2; ++bj)
#pragma unroll
                    for (int n = 0; n < 2; ++n) { const f32x4 d = v[ai][bj][m][n] - mw; q += (d[0] * d[0] + d[1] * d[1]) + (d[2] * d[2] + d[3] * d[3]); }
                q += __shfl_xor(q, 16); q += __shfl_xor(q, 32);
                if (fq == 0) P[(ai * HALF + wr * 64 + m * 16 + fr) * 4 + wc] = (f32x2v){mw, q};
            }
        asm volatile("s_waitcnt lgkmcnt(0)" ::: "memory"); __builtin_amdgcn_s_barrier(); asm volatile("" ::: "memory");
#if defined(BROKEN_EXCHANGE_NO_WAIT)
#warning BROKEN CONTROL BUILD: the row-statistics exchange does not wait; results are wrong by design
        if (blockIdx.x >= 64) { const long long t0_ = clock64(); while (clock64() - t0_ < 60000) __builtin_amdgcn_s_sleep(8); }
#endif
        const int row = wid * 32 + (lane & 31);
        if (lane < 32) {
            const f32x2v a = P[row * 4 + 0], b = P[row * 4 + 1], c = P[row * 4 + 2], d = P[row * 4 + 3];
            const float mt = (a.x + b.x + c.x + d.x) * 0.25f;
            const float da = a.x - mt, db = b.x - mt, dc = c.x - mt, dd = d.x - mt;
            const float m2 = (a.y + b.y) + (c.y + d.y) + 64.0f * ((da * da + db * db) + (dc * dc + dd * dd));
            unsigned long long* slot = (unsigned long long*)xbuf + ((size_t)(u.pm * BM + row) * 4 + u.pn);
            __hip_atomic_store(slot, ((unsigned long long)__float_as_uint(m2) << 32) | __float_as_uint(mt), __ATOMIC_RELAXED, __HIP_MEMORY_SCOPE_AGENT);
        }
        asm volatile("s_waitcnt vmcnt(0)" ::: "memory");
        if (lane == 0) __hip_atomic_fetch_add(cnt + 64 * u.pm, 1u, __ATOMIC_RELAXED, __HIP_MEMORY_SCOPE_AGENT);
        if (wid == 0) {
            bool dead = false; const unsigned long long t0 = __builtin_amdgcn_s_memrealtime(); const unsigned want = 8u * (unsigned)ntn;
            for (;;) {
#if defined(BROKEN_EXCHANGE_NO_WAIT)
                break;
#endif
                if ((unsigned)__builtin_amdgcn_readfirstlane(__hip_atomic_load(cnt + 64 * u.pm, __ATOMIC_RELAXED, __HIP_MEMORY_SCOPE_AGENT)) >= want) break;
                if (__builtin_amdgcn_s_memrealtime() - t0 > 2000000ull) {
                    if (lane == 0) { unsigned expect = 0u; __hip_atomic_compare_exchange_strong(tmo + 1, &expect, code | (unsigned)(u.pm & 0xff), __ATOMIC_RELAXED, __ATOMIC_RELAXED, __HIP_MEMORY_SCOPE_AGENT);
                                     __hip_atomic_store(tmo, 1u, __ATOMIC_RELAXED, __HIP_MEMORY_SCOPE_AGENT); }
                    dead = true; break; }
                __builtin_amdgcn_s_sleep(2);
            }
            __builtin_amdgcn_fence(__ATOMIC_ACQUIRE, "agent");
            if (lane == 0) flag[0] = dead ? 1u : 0u;
        }
        asm volatile("s_waitcnt vmcnt(0) lgkmcnt(0)" ::: "memory"); __builtin_amdgcn_s_barrier(); asm volatile("" ::: "memory");
        const bool bad = flag[0] != 0u;
        if (lane < 32) {
            const unsigned long long* slot = (const unsigned long long*)xbuf + (size_t)(u.pm * BM + row) * 4; float mt[4], m2[4]; float ms = 0.f;
#pragma unroll
            for (int t = 0; t < 4; ++t) { if (t < ntn) { const unsigned long long w = __hip_atomic_load(slot + t, __ATOMIC_RELAXED, __HIP_MEMORY_SCOPE_AGENT); mt[t] = __uint_as_float((unsigned)w); m2[t] = __uint_as_float((unsigned)(w >> 32)); } else { mt[t] = 0.f; m2[t] = 0.f; } ms += mt[t]; }
            const float mean = ms / (float)ntn; float q = 0.f;
#pragma unroll
            for (int t = 0; t < 4; ++t) if (t < ntn) { const float dm = mt[t] - mean; q += m2[t] + 256.0f * dm * dm; }
            S[row] = (f32x2v){mean, 1.0f / sqrtf(q / (256.0f * (float)ntn) + eps)};
        }
        asm volatile("s_waitcnt lgkmcnt(0)" ::: "memory"); __builtin_amdgcn_s_barrier(); asm volatile("" ::: "memory");
        return bad;
    }
};
struct EpiLnRes {
    static constexpr bool PERM = false, AFTER_DRAIN = true;
    const float* base; float* out; int ldc; const float* bias; PanelStats st; unsigned poison;
    __device__ __forceinline__ void fused(f32x4 (&acc)[2][2][4][2], const Unit& u, int wr, int wc, int fr, int fq, PG8_LAS unsigned char* lds, int wid, int lane) const {
        typedef float f32x2v __attribute__((ext_vector_type(2)));
        const PG8_LAS f32x2v* S = (const PG8_LAS f32x2v*)(lds + 8192);
        const int col0 = u.pn * BM + wc * 32 + 4 * fq;
#pragma unroll
        for (int bj = 0; bj < 2; ++bj)
#pragma unroll
            for (int n = 0; n < 2; ++n) { const f32x4 bv = bias ? *(const f32x4*)(bias + col0 + bj * HALF + n * 16) : (f32x4){0.f, 0.f, 0.f, 0.f};
#pragma unroll
                for (int ai = 0; ai < 2; ++ai)
#pragma unroll
                    for (int m = 0; m < 4; ++m) acc[ai][bj][m][n] += bv; }
        f32x4 pre[4][2][2];
#pragma unroll
        for (int m = 0; m < 4; ++m) { const size_t off = (size_t)(u.pm * BM + wr * 64 + m * 16 + fr) * ldc + col0;
#pragma unroll
            for (int bj = 0; bj < 2; ++bj)
#pragma unroll
                for (int n = 0; n < 2; ++n) pre[m][bj][n] = *(const f32x4*)(base + off + bj * HALF + n * 16); }
        const bool bad = st.run(acc, u, wr, wc, fr, fq, lds, wid, lane) || poison != 0u;
        const float qnan = __builtin_nanf("");
#pragma unroll
        for (int ai = 0; ai < 2; ++ai)
#pragma unroll
            for (int m = 0; m < 4; ++m) { const int r = ai * HALF + wr * 64 + m * 16 + fr; const f32x2v sr = S[r]; const size_t off = (size_t)(u.pm * BM + r) * ldc + col0;
#pragma unroll
                for (int bj = 0; bj < 2; ++bj)
#pragma unroll
                    for (int n = 0; n < 2; ++n) { const f32x4 bs = ai == 0 ? pre[m][bj][n] : *(const f32x4*)(base + off + bj * HALF + n * 16); f32x4 o = bs + (acc[ai][bj][m][n] - sr.x) * sr.y;
                        if (bad) o = (f32x4){qnan, qnan, qnan, qnan}; *(f32x4*)(out + off + bj * HALF + n * 16) = o; }
                if (m & 1) asm volatile("" ::: "memory"); }
    }
};
struct EpiLnResLn {
    static constexpr bool PERM = false, AFTER_DRAIN = true;
    const float* base; float* out; bf16_t* xn; int ldc; const float* bias; PanelStats st1, st2; unsigned poison;
    __device__ __forceinline__ void fused(f32x4 (&acc)[2][2][4][2], const Unit& u, int wr, int wc, int fr, int fq, PG8_LAS unsigned char* lds, int wid, int lane) const {
        typedef float f32x2v __attribute__((ext_vector_type(2))); typedef unsigned u32x2v __attribute__((ext_vector_type(2)));
        const PG8_LAS f32x2v* S = (const PG8_LAS f32x2v*)(lds + 8192);
        const int col0 = u.pn * BM + wc * 32 + 4 * fq;
#pragma unroll
        for (int bj = 0; bj < 2; ++bj)
#pragma unroll
            for (int n = 0; n < 2; ++n) { const f32x4 bv = bias ? *(const f32x4*)(bias + col0 + bj * HALF + n * 16) : (f32x4){0.f, 0.f, 0.f, 0.f};
#pragma unroll
                for (int ai = 0; ai < 2; ++ai)
#pragma unroll
                    for (int m = 0; m < 4; ++m) acc[ai][bj][m][n] += bv; }
        bool bad = st1.run(acc, u, wr, wc, fr, fq, lds, wid, lane) || poison != 0u;
        const float qnan = __builtin_nanf("");
#pragma unroll
        for (int ai = 0; ai < 2; ++ai)
#pragma unroll
            for (int m = 0; m < 4; ++m) { const int r = ai * HALF + wr * 64 + m * 16 + fr; const f32x2v sr = S[r]; const size_t off = (size_t)(u.pm * BM + r) * ldc + col0;
#pragma unroll
                for (int bj = 0; bj < 2; ++bj)
#pragma unroll
                    for (int n = 0; n < 2; ++n) { const f32x4 bs = *(const f32x4*)(base + off + bj * HALF + n * 16); acc[ai][bj][m][n] = bs + (acc[ai][bj][m][n] - sr.x) * sr.y; }
                asm volatile("" : "+v"(acc[ai][0][m][0]), "+v"(acc[ai][0][m][1]), "+v"(acc[ai][1][m][0]), "+v"(acc[ai][1][m][1]));
                if (m & 1) asm volatile("" ::: "memory"); }
        const bool bad1 = bad;
        bad = st2.run(acc, u, wr, wc, fr, fq, lds, wid, lane) || bad;
#pragma unroll
        for (int ai = 0; ai < 2; ++ai)
#pragma unroll
            for (int m = 0; m < 4; ++m) { const int r = ai * HALF + wr * 64 + m * 16 + fr; const f32x2v sr = S[r]; const size_t off = (size_t)(u.pm * BM + r) * ldc + col0;
#pragma unroll
                for (int bj = 0; bj < 2; ++bj)
#pragma unroll
                    for (int n = 0; n < 2; ++n) { const f32x4 x1 = acc[ai][bj][m][n]; *(f32x4*)(out + off + bj * HALF + n * 16) = bad1 ? (f32x4){qnan, qnan, qnan, qnan} : x1;
                        const f32x4 o = (x1 - sr.x) * sr.y; u32x2v w; w.x = cvt_pk_bf16(o[0], o[1]); w.y = cvt_pk_bf16(o[2], o[3]);
                        if (bad) { w.x = 0x7fc07fc0u; w.y = 0x7fc07fc0u; } *(u32x2v*)(xn + off + bj * HALF + n * 16) = w; }
                asm volatile("" ::: "memory"); }
    }
};

template <class Epi, class Sched, bool ALIGN_EPI = false, bool SP2 = false>
__device__ __forceinline__ void gemm_phase(PG8_LAS unsigned char* lds, const Gemm g, const Sched& S, const Epi& E) {
    int tid_ = threadIdx.x; asm volatile("" : "+v"(tid_));
    const int tid = tid_, wid = __builtin_amdgcn_readfirstlane(tid >> 6), lane = tid & 63, wr = wid >> 2, wc = wid & 3, fr = lane & 15, fq = lane >> 4;
    const int K = g.K, nt = K / BK;
    unsigned voffA[2], voffB[2];
#pragma unroll
    for (int i = 0; i < 2; ++i) { int R, C; stage_rc(tid * 16 + i * 8192, R, C); const int Rb = Epi::PERM ? ((R & ~31) + perm32(R & 31)) : R;
        voffA[i] = (unsigned)(R * K + C) * 2u; voffB[i] = (unsigned)(Rb * K + C) * 2u; }
    const size_t kstep = (size_t)(BK * 2);
    const size_t hstep = (size_t)HALF * K * 2;
    const size_t tstep = 2 * hstep;
    const unsigned ldsw = (unsigned)wid * 1024u;
    const int aoff = lds_byte(wr * 64 + fr, fq * 8), boff = lds_byte(wc * 32 + fr, fq * 8);
#define PG8_SA(b, h) (((b) * 2 + (h)) * HTB)
#define PG8_SB(b, h) ((4 + (b) * 2 + (h)) * HTB)
#define PG8_STAGE(bufoff, gbase, voff) do { _Pragma("unroll") for (int _i = 0; _i < 2; ++_i) \
        __builtin_amdgcn_global_load_lds((const unsigned*)((const char*)(gbase) + (voff)[_i]), (PG8_LAS unsigned*)(lds + (bufoff) + ldsw + _i * 8192), 16, 0, 0); } while (0)
#define PG8_LDA(dst, b, h) do { _Pragma("unroll") for (int m = 0; m < 4; ++m) _Pragma("unroll") for (int k = 0; k < 2; ++k) dst[m][k] = *(const PG8_LAS bf16x8*)(lds + PG8_SA(b, h) + aoff + m * 2048 + k * 1024); } while (0)
#define PG8_LDB(dst, b, h) do { _Pragma("unroll") for (int n = 0; n < 2; ++n) _Pragma("unroll") for (int k = 0; k < 2; ++k) dst[n][k] = *(const PG8_LAS bf16x8*)(lds + PG8_SB(b, h) + boff + n * 2048 + k * 1024); } while (0)
#define PG8_MMA(ai, bj, At, Bt) do { __builtin_amdgcn_s_setprio(1); _Pragma("unroll") for (int m = 0; m < 4; ++m) _Pragma("unroll") for (int n = 0; n < 2; ++n) _Pragma("unroll") for (int k = 0; k < 2; ++k) \
        acc[ai][bj][m][n] = __builtin_amdgcn_mfma_f32_16x16x32_bf16(Bt[n][k], At[m][k], acc[ai][bj][m][n], 0, 0, 0); __builtin_amdgcn_s_setprio(0); } while (0)
#define PG8_WAIT_V(n) asm volatile("s_waitcnt vmcnt(" #n ")" ::: "memory")
#define PG8_WAIT_L(n) asm volatile("s_waitcnt lgkmcnt(" #n ")" ::: "memory")
#define PG8_BAR __builtin_amdgcn_s_barrier()
#define PG8_SCHED __builtin_amdgcn_sched_barrier(0)
    Unit cur, nxt; int ui = 0;
    if (!S.next(0, cur)) return;
    f32x4 acc[2][2][4][2];
#pragma unroll
    for (int a = 0; a < 2; ++a)
#pragma unroll
        for (int b = 0; b < 2; ++b)
#pragma unroll
            for (int m = 0; m < 4; ++m)
#pragma unroll
                for (int n = 0; n < 2; ++n) acc[a][b][m][n] = (f32x4){0.f, 0.f, 0.f, 0.f};
    bf16x8 At[4][2], B0[2][2], B1[2][2];
    const char* cA = (const char*)g.A + (size_t)cur.pm * tstep; const char* cB = (const char*)g.Bt + (size_t)cur.pn * tstep;
    S.a_ready(cur);
    if constexpr (SP2) {
        PG8_STAGE(PG8_SB(0, 0), cB, voffB); PG8_STAGE(PG8_SB(0, 1), cB + hstep, voffB); PG8_STAGE(PG8_SA(0, 0), cA, voffA); PG8_STAGE(PG8_SA(0, 1), cA + hstep, voffA);
        if (wr == 1) PG8_BAR;
        PG8_WAIT_V(2); PG8_BAR;
        PG8_STAGE(PG8_SB(1, 0), cB + kstep, voffB); PG8_STAGE(PG8_SA(1, 0), cA + kstep, voffA); PG8_STAGE(PG8_SB(1, 1), cB + hstep + kstep, voffB);
        PG8_WAIT_V(6); PG8_BAR;
    } else {
        PG8_STAGE(PG8_SB(0, 0), cB, voffB); PG8_STAGE(PG8_SA(0, 0), cA, voffA); PG8_STAGE(PG8_SB(0, 1), cB + hstep, voffB); PG8_STAGE(PG8_SA(0, 1), cA + hstep, voffA);
        if (wr == 1) PG8_BAR;
        PG8_WAIT_V(4); PG8_BAR;
        PG8_STAGE(PG8_SB(1, 0), cB + kstep, voffB); PG8_STAGE(PG8_SA(1, 0), cA + kstep, voffA); PG8_STAGE(PG8_SB(1, 1), cB + hstep + kstep, voffB);
        PG8_WAIT_V(6); PG8_BAR;
    }
    for (;;) {
        const bool has_next = S.next(ui + 1, nxt);
        const char* nA = has_next ? (const char*)g.A + (size_t)nxt.pm * tstep : cA; const char* nB = has_next ? (const char*)g.Bt + (size_t)nxt.pn * tstep : cB;
        for (int t = 0; t < nt; t += 2) {
            const bool last = (t == nt - 2);
            const char* a1 = cA + (size_t)(t + 1) * kstep;
            const char* a2 = last ? nA : cA + (size_t)(t + 2) * kstep; const char* b2 = last ? nB : cB + (size_t)(t + 2) * kstep;
            const char* a3 = a2 + kstep; const char* b3 = b2 + kstep;
            if (last && has_next) S.a_ready(nxt);
            if constexpr (SP2) {
            PG8_LDB(B0, 0, 0); PG8_LDB(B1, 0, 1); PG8_SCHED; PG8_LDA(At, 0, 0); PG8_STAGE(PG8_SA(1, 1), a1 + hstep, voffA);
            PG8_WAIT_V(8); PG8_WAIT_L(0); PG8_BAR; PG8_MMA(0, 0, At, B0); PG8_MMA(0, 1, At, B1); PG8_BAR; PG8_SCHED;
            PG8_LDA(At, 0, 1); PG8_STAGE(PG8_SB(0, 0), b2, voffB); PG8_STAGE(PG8_SB(0, 1), b2 + hstep, voffB); PG8_STAGE(PG8_SA(0, 0), a2, voffA);
            PG8_WAIT_V(8); PG8_WAIT_L(0); PG8_BAR; PG8_MMA(1, 0, At, B0); PG8_MMA(1, 1, At, B1); PG8_BAR; PG8_SCHED;
            PG8_LDB(B0, 1, 0); PG8_LDB(B1, 1, 1); PG8_SCHED; PG8_LDA(At, 1, 0); PG8_STAGE(PG8_SA(0, 1), a2 + hstep, voffA);
            PG8_WAIT_V(8); PG8_WAIT_L(0); PG8_BAR; PG8_MMA(0, 0, At, B0); PG8_MMA(0, 1, At, B1); PG8_BAR; PG8_SCHED;
            PG8_LDA(At, 1, 1); PG8_STAGE(PG8_SB(1, 0), b3, voffB); PG8_STAGE(PG8_SB(1, 1), b3 + hstep, voffB); PG8_STAGE(PG8_SA(1, 0), a3, voffA);
            PG8_WAIT_V(8); PG8_WAIT_L(0); PG8_BAR; PG8_MMA(1, 0, At, B0); PG8_MMA(1, 1, At, B1); PG8_BAR; PG8_SCHED;
            } else {
            PG8_LDB(B0, 0, 0); PG8_SCHED; PG8_LDA(At, 0, 0); PG8_STAGE(PG8_SA(1, 1), a1 + hstep, voffA);
            PG8_WAIT_L(8); PG8_BAR; PG8_WAIT_L(0); PG8_MMA(0, 0, At, B0); PG8_BAR; PG8_SCHED;
            PG8_LDB(B1, 0, 1); PG8_STAGE(PG8_SB(0, 0), b2, voffB);
            PG8_BAR; PG8_WAIT_L(0); PG8_MMA(0, 1, At, B1); PG8_BAR;
            PG8_LDA(At, 0, 1); PG8_STAGE(PG8_SA(0, 0), a2, voffA);
            PG8_BAR; PG8_WAIT_L(0); PG8_MMA(1, 0, At, B0); PG8_BAR; PG8_SCHED;
            PG8_STAGE(PG8_SB(0, 1), b2 + hstep, voffB);
            PG8_WAIT_V(6); PG8_BAR; PG8_MMA(1, 1, At, B1); PG8_BAR;
            PG8_LDB(B0, 1, 0); PG8_SCHED; PG8_LDA(At, 1, 0); PG8_STAGE(PG8_SA(0, 1), a2 + hstep, voffA);
            PG8_WAIT_L(8); PG8_BAR; PG8_WAIT_L(0); PG8_MMA(0, 0, At, B0); PG8_BAR; PG8_SCHED;
            PG8_LDB(B1, 1, 1); PG8_STAGE(PG8_SB(1, 0), b3, voffB);
            PG8_BAR; PG8_WAIT_L(0); PG8_MMA(0, 1, At, B1); PG8_BAR;
            PG8_LDA(At, 1, 1); PG8_STAGE(PG8_SA(1, 0), a3, voffA);
            PG8_BAR; PG8_WAIT_L(0); PG8_MMA(1, 0, At, B0); PG8_BAR; PG8_SCHED;
            PG8_STAGE(PG8_SB(1, 1), b3 + hstep, voffB);
            PG8_WAIT_V(6); PG8_BAR; PG8_MMA(1, 1, At, B1); PG8_BAR;
            }
        }
        if constexpr (ALIGN_EPI) { if (wr == 0) PG8_BAR; }
        if constexpr (!Epi::AFTER_DRAIN) { E(acc, cur, wr, wc, fr, fq); S.done(cur); }
        if (!has_next) break;
#pragma unroll
        for (int a = 0; a < 2; ++a)
#pragma unroll
            for (int b = 0; b < 2; ++b)
#pragma unroll
                for (int m = 0; m < 4; ++m)
#pragma unroll
                    for (int n = 0; n < 2; ++n) acc[a][b][m][n] = (f32x4){0.f, 0.f, 0.f, 0.f};
        cur = nxt; cA = nA; cB = nB; ++ui;
        if constexpr (ALIGN_EPI) { if (wr == 1) PG8_BAR; }
    }
    PG8_WAIT_V(0);
    if constexpr (!ALIGN_EPI) { if (wr == 0) PG8_BAR; }
    PG8_BAR;
    if constexpr (Epi::AFTER_DRAIN) { E.fused(acc, cur, wr, wc, fr, fq, lds, wid, lane); S.done(cur); }
#undef PG8_SA
#undef PG8_SB
#undef PG8_STAGE
#undef PG8_LDA
#undef PG8_LDB
#undef PG8_MMA
#undef PG8_WAIT_V
#undef PG8_WAIT_L
#undef PG8_BAR
#undef PG8_SCHED
}
}

constexpr int DM = 1024, NB = 8, SEQ = 2048, DEPTH = 4, CTXL = 256, NIN = 2304;
constexpr int MX = NB * SEQ, MC = NB * CTXL, MT = MX + MC;
constexpr int WL = 512, WP = 256, WC = 256;
constexpr int C_VL = 0, C_GL = 512, C_VP = 1024, C_GP = 1280, C_VC = 1536, C_GG = 1792, C_GC = 2048;
constexpr int NCHUNK = 36;
constexpr float EPS_RMS = 1e-6f, EPS_LN = 1e-5f;

constexpr size_t MiB = 1u << 20;
constexpr size_t WS_CTL = 0, CTL_ZERO_BYTES = 1 * MiB;
constexpr size_t WS_MOD = 1 * MiB;
constexpr size_t WS_GB = 1 * MiB + 512 * 1024;
constexpr size_t WS_KC = WS_GB + 32768;
constexpr float LOG2E = 1.4426950408889634f;
constexpr size_t WS_GW = 2 * MiB;
constexpr size_t WS_PW = 3 * MiB;
constexpr size_t WS_CPW = 3 * MiB + 512 * 1024;
constexpr size_t WS_WIN = 4 * MiB;
constexpr size_t WS_WOUT = 22 * MiB;
constexpr size_t WS_HX = 30 * MiB;
constexpr size_t WS_UX = 66 * MiB;
constexpr size_t WS_R2 = 147 * MiB;
constexpr size_t WS_CTXR = 219 * MiB;
constexpr size_t WS_SUM = 227 * MiB;
constexpr size_t WS_END = 230 * MiB;

constexpr int LDS_BYTES = 147456;
constexpr int MISC_OFF = LDS_BYTES - 256;
constexpr int NT = 512;

#define GAS __attribute__((address_space(1)))
#define LAS __attribute__((address_space(3)))
typedef unsigned short bf16;
typedef unsigned v4u __attribute__((ext_vector_type(4)));
typedef float f32x4 __attribute__((ext_vector_type(4)));
typedef unsigned v2u __attribute__((ext_vector_type(2)));
#define LDS_WAIT() asm volatile("s_waitcnt lgkmcnt(0)" ::: "memory")
#define VM_WAIT() asm volatile("s_waitcnt vmcnt(0)" ::: "memory")

__device__ __forceinline__ unsigned f2bf(float f) { unsigned u = __builtin_bit_cast(unsigned, f); return (u + 0x7fffu + ((u >> 16) & 1u)) >> 16; }
__device__ __forceinline__ unsigned pk2(float lo, float hi) { return f2bf(lo) | (f2bf(hi) << 16); }
__device__ __forceinline__ float bf2f(bf16 v) { return __builtin_bit_cast(float, (unsigned)v << 16); }
__device__ __forceinline__ float sigmoidf_(float v) { return 1.0f / (1.0f + expf(-v)); }
__device__ __forceinline__ float siluf_(float v) { return v / (1.0f + expf(-v)); }
__device__ __forceinline__ float wave_sum(float v) {
#pragma unroll
    for (int o = 1; o < 64; o <<= 1) v += __shfl_xor(v, o);
    return v;
}

struct Ptrs {
    const float *x, *c, *ctx, *c_ctx, *w_mod, *b_mod, *g_pre, *w_in, *lru_conv_w, *lru_conv_b, *lru_wa, *lru_ba, *lru_wx, *lru_bx, *lru_lambda,
        *pool_w, *pool_scale, *conf_dw, *conf_dw_b, *conf_ln_g, *conf_ln_b, *conf_pw, *w_out, *g_post;
};
struct Args { Ptrs p; float* out; unsigned char* ws; int ph_lo, ph_hi; };

__device__ __forceinline__ void row_info(int r, int& b, int& t, int& n, int& base) {
    if (r < MX) { b = r >> 11; t = r & 2047; n = SEQ; base = b << 11; }
    else { const int rc = r - MX; b = rc >> 8; t = rc & 255; n = CTXL; base = MX + (b << 8); }
}
__device__ __forceinline__ int chunk_row0(int b, int ck) { return ck < 4 ? MX + b * CTXL + 64 * ck : b * SEQ + 64 * (ck - 4); }

__device__ __forceinline__ void transpose_item(const float* W, int K, int N, bf16* WT, LAS float* scr, int item, int lane, float scale = 1.0f) {
    const int nblk = N / 32, kb = item / nblk, nb = item % nblk, k0 = 64 * kb, n0 = 32 * nb;
#pragma unroll 8
    for (int i = 0; i < 32; ++i) { const int kk = 2 * i + (lane >> 5); scr[kk * 33 + (lane & 31)] = W[(size_t)(k0 + kk) * N + n0 + (lane & 31)] * scale; }
    LDS_WAIT(); asm volatile("" ::: "memory");
    const int c = lane & 7;
#pragma unroll
    for (int j = 0; j < 4; ++j) { const int n = (lane >> 3) + 8 * j; const LAS float* s = scr + (8 * c) * 33 + n;
        v4u o; o.x = pk2(s[0 * 33], s[1 * 33]); o.y = pk2(s[2 * 33], s[3 * 33]); o.z = pk2(s[4 * 33], s[5 * 33]); o.w = pk2(s[6 * 33], s[7 * 33]);
        *(GAS v4u*)(WT + (size_t)(n0 + n) * K + k0 + 8 * c) = o; }
    LDS_WAIT(); asm volatile("" ::: "memory");
}

struct EpiF32 {
    static constexpr bool PERM = false, AFTER_DRAIN = false;
    float* O; int ldc;
    __device__ __forceinline__ void operator()(const pg8::f32x4 (&acc)[2][2][4][2], const pg8::Unit& u, int wr, int wc, int fr, int fq) const {
        const int row0 = u.pm * 256 + wr * 64 + fr, col0 = u.pn * 256 + wc * 32 + 4 * fq;
#pragma unroll
        for (int ai = 0; ai < 2; ++ai)
#pragma unroll
            for (int m = 0; m < 4; ++m) { float* rowp = O + (size_t)(row0 + ai * 128 + m * 16) * ldc + col0;
#pragma unroll
                for (int bj = 0; bj < 2; ++bj)
#pragma unroll
                    for (int n = 0; n < 2; ++n) *(pg8::f32x4*)(rowp + bj * 128 + n * 16) = acc[ai][bj][m][n]; }
    }
};

__device__ __forceinline__ void lru_ab(const Ptrs& P, int l, int d, const float* XC, int row, int c, float& a, float& bb) {
    const int h = c >> 6, j = c & 63;
    const float* wa = P.lru_wa + (size_t)((l * 2 + d) * 8 + h) * 4096 + j;
    const float* wx = P.lru_wx + (size_t)((l * 2 + d) * 8 + h) * 4096 + j;
    const float* xr = XC + (size_t)row * WL + h * 64;
    float rp = P.lru_ba[(l * 2 + d) * WL + c], ip = P.lru_bx[(l * 2 + d) * WL + c];
#pragma unroll 8
    for (int i = 0; i < 64; ++i) { const float xv = xr[i]; rp += xv * wa[i * 64]; ip += xv * wx[i * 64]; }
    const float r = sigmoidf_(rp), ig = sigmoidf_(ip);
    const float sp = log1pf(expf(-P.lru_lambda[(l * 2 + d) * WL + c]));
    const float la = -8.0f * r * sp;
    a = expf(la);
    bb = sqrtf(-expm1f(2.0f * la)) * (ig * xr[j]);
}


typedef short bf16x8 __attribute__((ext_vector_type(8)));
static_assert(133120 + 4096 <= MISC_OFF && 113664 + 32768 <= MISC_OFF, "LDS map");
constexpr int XCT_STRIDE = 1040;
constexpr int L_XCT = 0, L_GZ = 66560, L_CIN = 133120;
__device__ __forceinline__ float bflo(unsigned u) { return __builtin_bit_cast(float, u << 16); }
__device__ __forceinline__ float bfhi(unsigned u) { return __builtin_bit_cast(float, u & 0xffff0000u); }

__device__ __forceinline__ void strip_conv(LAS unsigned char* lds, const Ptrs& P, int l, const bf16* UX, int r0, int tpos0, int n, int tid) {
    const int o = tid & 63, tg = tid >> 6, c0 = 8 * o;
    float w[4][8], bias[8];
#pragma unroll
    for (int k = 0; k < 4; ++k) { const f32x4 a = *(const f32x4*)(P.lru_conv_w + (l * 4 + k) * WL + c0), b = *(const f32x4*)(P.lru_conv_w + (l * 4 + k) * WL + c0 + 4);
#pragma unroll
        for (int q = 0; q < 4; ++q) { w[k][q] = a[q]; w[k][4 + q] = b[q]; } }
    { const f32x4 a = *(const f32x4*)(P.lru_conv_b + l * WL + c0), b = *(const f32x4*)(P.lru_conv_b + l * WL + c0 + 4);
#pragma unroll
      for (int q = 0; q < 4; ++q) { bias[q] = a[q]; bias[4 + q] = b[q]; } }
    v4u v[11];
#pragma unroll
    for (int i = 0; i < 11; ++i) { const int tp = tpos0 + 8 * tg + i - 2;
        v[i] = (tp >= 0 && tp < n) ? *(const v4u*)(UX + (size_t)(r0 + 8 * tg + i - 2) * NIN + C_VL + c0) : (v4u){0u, 0u, 0u, 0u}; }
#pragma unroll
    for (int e = 0; e < 8; ++e) {
        float acc[8];
#pragma unroll
        for (int q = 0; q < 8; ++q) acc[q] = bias[q];
#pragma unroll
        for (int k = 0; k < 4; ++k) { const v4u x = v[e + k];
            acc[0] += w[k][0] * bflo(x.x); acc[1] += w[k][1] * bfhi(x.x); acc[2] += w[k][2] * bflo(x.y); acc[3] += w[k][3] * bfhi(x.y);
            acc[4] += w[k][4] * bflo(x.z); acc[5] += w[k][5] * bfhi(x.z); acc[6] += w[k][6] * bflo(x.w); acc[7] += w[k][7] * bfhi(x.w); }
        v4u ov; ov.x = pk2(acc[0], acc[1]); ov.y = pk2(acc[2], acc[3]); ov.z = pk2(acc[4], acc[5]); ov.w = pk2(acc[6], acc[7]);
        *(LAS v4u*)(lds + L_XCT + (8 * tg + e) * XCT_STRIDE + o * 16) = ov;
    }
}

struct GateW { bf16x8 Br[2][2], Bi[2][2]; float br[2], bi[2], kc[2]; };
__device__ __forceinline__ void gatew_load(GateW& w, int l, int h, int n, int fr, int fq, const bf16* GWS, const float* GB, const float* KC) {
    const int c = h * 64 + 16 * n + fr;
#pragma unroll
    for (int d = 0; d < 2; ++d) {
        const bf16* wr = GWS + ((size_t)(((l * 2 + d) * 2 + 0) * 8 + h) * 64 + 16 * n + fr) * 64 + fq * 8;
        const bf16* wi = GWS + ((size_t)(((l * 2 + d) * 2 + 1) * 8 + h) * 64 + 16 * n + fr) * 64 + fq * 8;
#pragma unroll
        for (int ks = 0; ks < 2; ++ks) { w.Br[d][ks] = *(const bf16x8*)(wr + ks * 32); w.Bi[d][ks] = *(const bf16x8*)(wi + ks * 32); }
        w.br[d] = GB[((l * 2 + d) * 2 + 0) * WL + c]; w.bi[d] = GB[((l * 2 + d) * 2 + 1) * WL + c]; w.kc[d] = KC[(l * 2 + d) * WL + c];
    }
}
template <int MODE>
__device__ __forceinline__ void lru_core(LAS unsigned char* lds, int l, int h, int lane, const bf16* GWS, const float* GB, const float* KC, float* sum_out) {
    const int fr = lane & 15, fq = lane >> 4;
    GateW wn; gatew_load(wn, l, h, 0, fr, fq, GWS, GB, KC);
    bf16x8 A[4][2];
#pragma unroll
    for (int m = 0; m < 4; ++m)
#pragma unroll
        for (int ks = 0; ks < 2; ++ks) { const int tau = (fr >> 2) * 16 + m * 4 + (fr & 3);
            A[m][ks] = *(const LAS bf16x8*)(lds + L_XCT + tau * XCT_STRIDE + (h * 64 + ks * 32 + fq * 8) * 2); }
#pragma unroll 1
    for (int n = 0; n < 4; ++n) {
        const int c = h * 64 + 16 * n + fr;
        const GateW w = wn;
        if (n < 3) gatew_load(wn, l, h, n + 1, fr, fq, GWS, GB, KC);
        float xv[16], y[16];
#pragma unroll
        for (int e = 0; e < 16; ++e) { xv[e] = bf2f(*(const LAS bf16*)(lds + L_XCT + (fq * 16 + e) * XCT_STRIDE + c * 2)); y[e] = 0.f; }
#pragma unroll
        for (int d = 0; d < 2; ++d) {
            f32x4 ar[4], ai[4];
#pragma unroll
            for (int m = 0; m < 4; ++m) { ar[m] = (f32x4){w.br[d], w.br[d], w.br[d], w.br[d]}; ai[m] = (f32x4){w.bi[d], w.bi[d], w.bi[d], w.bi[d]}; }
#pragma unroll
            for (int m = 0; m < 4; ++m)
#pragma unroll
                for (int ks = 0; ks < 2; ++ks) { ar[m] = __builtin_amdgcn_mfma_f32_16x16x32_bf16(A[m][ks], w.Br[d][ks], ar[m], 0, 0, 0); ai[m] = __builtin_amdgcn_mfma_f32_16x16x32_bf16(A[m][ks], w.Bi[d][ks], ai[m], 0, 0, 0); }
            const float kc = w.kc[d];
            float av[16], bv[16];
#pragma unroll
            for (int e = 0; e < 16; ++e) {
                const float er = __builtin_amdgcn_exp2f(ar[e >> 2][e & 3]), ei = __builtin_amdgcn_exp2f(ai[e >> 2][e & 3]);
                const float r = __builtin_amdgcn_rcpf(1.0f + er), ig = __builtin_amdgcn_rcpf(1.0f + ei);
                const float a = __builtin_amdgcn_exp2f(kc * r);
                av[e] = a; bv[e] = __builtin_amdgcn_sqrtf(fmaxf(1.0f - a * a, 0.0f)) * (ig * xv[e]);
            }
            float Pq = 1.f, Hq = 0.f;
#pragma unroll
            for (int s = 0; s < 16; ++s) { const int e = d ? 15 - s : s; Hq = av[e] * Hq + bv[e]; Pq *= av[e]; bv[e] = Hq; av[e] = Pq; }
            float Pg[4], Hg[4];
#pragma unroll
            for (int q = 0; q < 4; ++q) { Pg[q] = __shfl(Pq, fr + 16 * q); Hg[q] = __shfl(Hq, fr + 16 * q); }
            if constexpr (MODE == 0) {
                float At = 1.f, Ht = 0.f;
#pragma unroll
                for (int s = 0; s < 4; ++s) { const int q = d ? 3 - s : s; Ht = Pg[q] * Ht + Hg[q]; At *= Pg[q]; }
                if (fq == 0) { float2 o2; o2.x = At; o2.y = Ht; *(float2*)(sum_out + ((size_t)d * WL + c) * 2) = o2; }
            } else {
                float cq = *(const LAS float*)(lds + L_CIN + (d * WL + c) * 4);
#pragma unroll
                for (int s = 0; s < 4; ++s) { const int q = d ? 3 - s : s; const bool before = d ? (q > fq) : (q < fq); if (before) cq = Pg[q] * cq + Hg[q]; }
#pragma unroll
                for (int e = 0; e < 16; ++e) y[e] += bv[e] + av[e] * cq;
            }
        }
        if constexpr (MODE == 1) {
#pragma unroll
            for (int e = 0; e < 16; ++e) { LAS bf16* gp = (LAS bf16*)(lds + L_GZ + (fq * 16 + e) * XCT_STRIDE + c * 2); const float g = bf2f(*gp);
                *gp = (bf16)f2bf(y[e] * g * __builtin_amdgcn_rcpf(1.0f + __builtin_amdgcn_exp2f(-LOG2E * g))); }
        }
    }
}

constexpr int T_STRIDE = 528;
constexpr int L_DT = 0, L_ZP = 33792;
constexpr int L_ZC = 0, L_CT = 48128, L_CLT = 0, L_CG = 113664;
__device__ __forceinline__ float silu_fast(float g) { return g * __builtin_amdgcn_rcpf(1.0f + __builtin_amdgcn_exp2f(-LOG2E * g)); }
__device__ __forceinline__ float sigm_fast(float g) { return __builtin_amdgcn_rcpf(1.0f + __builtin_amdgcn_exp2f(-LOG2E * g)); }

template <int NCH> __device__ __forceinline__ void tile_out(LAS unsigned char* lds, int off, int stride, bf16* Zg, int r0, int col0, int tid) {
    constexpr int RPI = NT / NCH;
    const int ch = tid % NCH, rr = tid / NCH;
#pragma unroll
    for (int it = 0; it < 64 / RPI; ++it) { const int row = it * RPI + rr;
        *(v4u*)(Zg + (size_t)(r0 + row) * DM + col0 + ch * 8) = *(const LAS v4u*)(lds + off + row * stride + ch * 16); }
}

__device__ __forceinline__ void pool_part(LAS unsigned char* lds, const Ptrs& P, int l, const bf16* UX, const bf16* PWt, bf16* Zg, int r0, int tpos0, int n, int tid, int wave, int lane) {
    asm volatile("" : "+v"(tid)); lane = tid & 63; wave = __builtin_amdgcn_readfirstlane(tid >> 6);
    v4u gpre[4];
#pragma unroll
    for (int it = 0; it < 4; ++it) gpre[it] = *(const v4u*)(UX + (size_t)(r0 + it * 16 + (tid >> 5)) * NIN + C_GP + (tid & 31) * 8);
    {
        const int o = tid & 31, g = o >> 3, w2 = 1 << g, c0 = 8 * o;
#pragma unroll 1
        for (int it = 0; it < 4; ++it) { const int tok = it * 16 + (tid >> 5), t = tpos0 + tok;
            int lo = t - w2; lo = lo < 0 ? 0 : lo; int hi = t + w2; hi = hi > n ? n : hi;
            float sum[8];
#pragma unroll
            for (int q = 0; q < 8; ++q) sum[q] = 0.f;
            const bf16* colp = UX + (size_t)(r0 - tpos0) * NIN + C_VP + c0;
#pragma unroll 4
            for (int tt = lo; tt < hi; ++tt) { const v4u x = *(const v4u*)(colp + (size_t)tt * NIN);
                sum[0] += bflo(x.x); sum[1] += bfhi(x.x); sum[2] += bflo(x.y); sum[3] += bfhi(x.y); sum[4] += bflo(x.z); sum[5] += bfhi(x.z); sum[6] += bflo(x.w); sum[7] += bfhi(x.w); }
            const v4u xc = *(const v4u*)(colp + (size_t)t * NIN); const float inv = 1.0f / (float)(hi - lo);
            v4u ov; ov.x = pk2(sum[0] * inv - bflo(xc.x), sum[1] * inv - bfhi(xc.x)); ov.y = pk2(sum[2] * inv - bflo(xc.y), sum[3] * inv - bfhi(xc.y));
            ov.z = pk2(sum[4] * inv - bflo(xc.z), sum[5] * inv - bfhi(xc.z)); ov.w = pk2(sum[6] * inv - bflo(xc.w), sum[7] * inv - bfhi(xc.w));
            *(LAS v4u*)(lds + L_DT + tok * T_STRIDE + o * 16) = ov; }
    }
#pragma unroll
    for (int it = 0; it < 4; ++it) *(LAS v4u*)(lds + L_ZP + (it * 16 + (tid >> 5)) * T_STRIDE + (tid & 31) * 16) = gpre[it];
    __syncthreads();
    {
        const int fr = lane & 15, fq = lane >> 4, g = wave >> 1, nh = wave & 1;
        bf16x8 A[4][2];
#pragma unroll
        for (int m = 0; m < 4; ++m)
#pragma unroll
            for (int ks = 0; ks < 2; ++ks) A[m][ks] = *(const LAS bf16x8*)(lds + L_DT + (16 * m + fr) * T_STRIDE + (g * 64 + ks * 32 + fq * 8) * 2);
#pragma unroll
        for (int ni = 0; ni < 2; ++ni) { const int nn = 2 * nh + ni, cc = g * 64 + 16 * nn + fr;
            const bf16* wp = PWt + ((size_t)((l * 4 + g) * 64 + 16 * nn + fr)) * 64 + fq * 8;
            const bf16x8 B0 = *(const bf16x8*)(wp), B1 = *(const bf16x8*)(wp + 32);
            const float ps = P.pool_scale[l * WP + cc];
#pragma unroll
            for (int m = 0; m < 4; ++m) { f32x4 acc = (f32x4){0.f, 0.f, 0.f, 0.f};
                acc = __builtin_amdgcn_mfma_f32_16x16x32_bf16(A[m][0], B0, acc, 0, 0, 0); acc = __builtin_amdgcn_mfma_f32_16x16x32_bf16(A[m][1], B1, acc, 0, 0, 0);
#pragma unroll
                for (int j = 0; j < 4; ++j) { const int tok = 16 * m + 4 * fq + j; LAS bf16* gp = (LAS bf16*)(lds + L_ZP + tok * T_STRIDE + cc * 2); const float gt = bf2f(*gp);
                    *gp = (bf16)f2bf(acc[j] * ps * silu_fast(gt)); } }
        }
    }
    __syncthreads();
    tile_out<32>(lds, L_ZP, T_STRIDE, Zg, r0, 512, tid);
    __syncthreads();
}

__device__ __forceinline__ void conf_part(LAS unsigned char* lds, const Ptrs& P, int l, const bf16* UX, const bf16* CPWt, bf16* Zg, int r0, int tpos0, int n, int tid, int wave, int lane) {
    asm volatile("" : "+v"(tid)); lane = tid & 63; wave = __builtin_amdgcn_readfirstlane(tid >> 6);
#pragma unroll
    for (int it = 0; it < 4; ++it) *(LAS v4u*)(lds + L_CG + (it * 16 + (tid >> 5)) * 512 + (tid & 31) * 16) = *(const v4u*)(UX + (size_t)(r0 + it * 16 + (tid >> 5)) * NIN + C_GC + (tid & 31) * 8);
    {
        const int o = tid & 31, rg = tid >> 5, c0 = 8 * o;
#pragma unroll
        for (int it = 0; it < 6; ++it) { const int rho = it * 16 + rg; if (rho < 94) { const int tp = tpos0 + rho - 15; v4u ov = (v4u){0u, 0u, 0u, 0u};
            if (tp >= 0 && tp < n) { const bf16* rp = UX + (size_t)(r0 + rho - 15) * NIN; const v4u a = *(const v4u*)(rp + C_VC + c0), b = *(const v4u*)(rp + C_GG + c0);
                ov.x = pk2(bflo(a.x) * sigm_fast(bflo(b.x)), bfhi(a.x) * sigm_fast(bfhi(b.x))); ov.y = pk2(bflo(a.y) * sigm_fast(bflo(b.y)), bfhi(a.y) * sigm_fast(bfhi(b.y)));
                ov.z = pk2(bflo(a.z) * sigm_fast(bflo(b.z)), bfhi(a.z) * sigm_fast(bfhi(b.z))); ov.w = pk2(bflo(a.w) * sigm_fast(bflo(b.w)), bfhi(a.w) * sigm_fast(bfhi(b.w))); }
            *(LAS v4u*)(lds + L_ZC + rho * 512 + o * 16) = ov; } }
    }
    __syncthreads();
    {
        const int c = tid & 255, hf = tid >> 8;
        float w[31];
#pragma unroll
        for (int k = 0; k < 31; ++k) w[k] = P.conf_dw[(size_t)(l * 31 + k) * WC + c];
        const float bias = P.conf_dw_b[l * WC + c];
#pragma unroll 1
        for (int sh = 0; sh < 2; ++sh) { const int t0 = 32 * hf + 16 * sh; float acc[16];
#pragma unroll
            for (int oo = 0; oo < 16; ++oo) acc[oo] = bias;
#pragma unroll
            for (int rr = 0; rr < 46; ++rr) { const float val = bf2f(*(const LAS bf16*)(lds + L_ZC + (t0 + rr) * 512 + c * 2));
#pragma unroll
                for (int oo = 0; oo < 16; ++oo) { if (rr - oo >= 0 && rr - oo <= 30) acc[oo] += val * w[rr - oo]; } }
#pragma unroll
            for (int oo = 0; oo < 16; ++oo) *(LAS float*)(lds + L_CT + (t0 + oo) * 1024 + c * 4) = acc[oo]; }
    }
    __syncthreads();
    {
        const f32x4 lg = *(const f32x4*)(P.conf_ln_g + l * WC + 4 * lane), lb = *(const f32x4*)(P.conf_ln_b + l * WC + 4 * lane);
#pragma unroll
        for (int i = 0; i < 8; ++i) { const int tok = 8 * wave + i; const f32x4 v = *(const LAS f32x4*)(lds + L_CT + tok * 1024 + lane * 16);
            const float mu = wave_sum((v[0] + v[1]) + (v[2] + v[3])) * (1.0f / 256.0f); const f32x4 dv = v - mu;
            const float var = wave_sum((dv[0] * dv[0] + dv[1] * dv[1]) + (dv[2] * dv[2] + dv[3] * dv[3])) * (1.0f / 256.0f);
            const float rstd = 1.0f / sqrtf(var + EPS_LN); float o4[4];
#pragma unroll
            for (int e = 0; e < 4; ++e) o4[e] = silu_fast(dv[e] * rstd * lg[e] + lb[e]);
            v2u ov; ov.x = pk2(o4[0], o4[1]); ov.y = pk2(o4[2], o4[3]);
            *(LAS v2u*)(lds + L_CLT + tok * T_STRIDE + lane * 8) = ov; }
    }
    __syncthreads();
    {
        const int fr = lane & 15, fq = lane >> 4;
        f32x4 acc[4][2];
#pragma unroll
        for (int m = 0; m < 4; ++m) { acc[m][0] = (f32x4){0.f, 0.f, 0.f, 0.f}; acc[m][1] = (f32x4){0.f, 0.f, 0.f, 0.f}; }
        const bf16* wp0 = CPWt + ((size_t)(l * 256 + 16 * (2 * wave) + fr)) * 256 + fq * 8;
        const bf16* wp1 = wp0 + 16 * 256;
#pragma unroll
        for (int ks = 0; ks < 8; ++ks) { const bf16x8 B0 = *(const bf16x8*)(wp0 + ks * 32), B1 = *(const bf16x8*)(wp1 + ks * 32);
#pragma unroll
            for (int m = 0; m < 4; ++m) { const bf16x8 A = *(const LAS bf16x8*)(lds + L_CLT + (16 * m + fr) * T_STRIDE + (ks * 32 + fq * 8) * 2);
                acc[m][0] = __builtin_amdgcn_mfma_f32_16x16x32_bf16(A, B0, acc[m][0], 0, 0, 0); acc[m][1] = __builtin_amdgcn_mfma_f32_16x16x32_bf16(A, B1, acc[m][1], 0, 0, 0); } }
#pragma unroll
        for (int ni = 0; ni < 2; ++ni) { const int ee = 16 * (2 * wave + ni) + fr;
#pragma unroll
            for (int m = 0; m < 4; ++m)
#pragma unroll
                for (int j = 0; j < 4; ++j) { const int tok = 16 * m + 4 * fq + j; LAS bf16* gp = (LAS bf16*)(lds + L_CG + tok * 512 + ee * 2); const float gt = bf2f(*gp);
                    *gp = (bf16)f2bf(acc[m][ni][j] * silu_fast(gt)); } }
    }
    __syncthreads();
    tile_out<32>(lds, L_CG, 512, Zg, r0, 768, tid);
    __syncthreads();
}

__device__ __forceinline__ void mixer_strip(LAS unsigned char* lds, const Ptrs& P, int l, int b, int ck, const bf16* UX, bf16* Zg, const bf16* GWS, const float* GB, const float* KC, const float* SUM,
                                            const bf16* PWt, const bf16* CPWt, int tid, int wave, int lane) {
    const int r0 = chunk_row0(b, ck), tpos0 = ck < 4 ? 64 * ck : 64 * (ck - 4), n = ck < 4 ? CTXL : SEQ;
    asm volatile("" : "+v"(tid)); lane = tid & 63; wave = __builtin_amdgcn_readfirstlane(tid >> 6);
    strip_conv(lds, P, l, UX, r0, tpos0, n, tid);
    {
        const int o = tid & 63, tg = tid >> 6;
#pragma unroll
        for (int i = 0; i < 8; ++i) { const int tok = 8 * tg + i; *(LAS v4u*)(lds + L_GZ + tok * XCT_STRIDE + o * 16) = *(const v4u*)(UX + (size_t)(r0 + tok) * NIN + C_GL + 8 * o); }
    }
    {
        const int c = tid; const float* sb = SUM + (size_t)b * NCHUNK * 2 * WL * 2 + (size_t)c * 2;
        {   float2 sv[NCHUNK];
#pragma unroll
            for (int q = 0; q < NCHUNK; ++q) sv[q] = *(const float2*)(sb + (size_t)(q * 2 + 0) * WL * 2);
            float h = 0.f;
#pragma unroll
            for (int q = 0; q < NCHUNK; ++q) { const bool sel = q < ck; h = sel ? sv[q].x * h + sv[q].y : h; }
            *(LAS float*)(lds + L_CIN + c * 4) = h; }
        {   float2 sv[NCHUNK];
#pragma unroll
            for (int q = 0; q < NCHUNK; ++q) sv[q] = *(const float2*)(sb + (size_t)(q * 2 + 1) * WL * 2);
            float h = 0.f;
#pragma unroll
            for (int s2 = 0; s2 < NCHUNK; ++s2) { const int q = s2 < 4 ? 3 - s2 : NCHUNK + 3 - s2;
                const bool sel = ck < 4 ? (q < 4 && q > ck) : (q < 4 || q > ck); h = sel ? sv[q].x * h + sv[q].y : h; }
            *(LAS float*)(lds + L_CIN + (WL + c) * 4) = h; }
    }
    __syncthreads();
    asm volatile("" : "+v"(tid)); lane = tid & 63; wave = __builtin_amdgcn_readfirstlane(tid >> 6);
#ifndef NO_LRU
    lru_core<1>(lds, l, wave, lane, GWS, GB, KC, nullptr);
#endif
    __syncthreads();
    tile_out<64>(lds, L_GZ, XCT_STRIDE, Zg, r0, 0, tid);
    __syncthreads();
#ifndef NO_POOL
    pool_part(lds, P, l, UX, PWt, Zg, r0, tpos0, n, tid, wave, lane);
#endif
#ifndef NO_CONF
    conf_part(lds, P, l, UX, CPWt, Zg, r0, tpos0, n, tid, wave, lane);
#endif
}

enum { K_PREP = 100, K_EMBED = 101 };
typedef const __attribute__((address_space(4))) Args* KArgs;
template <int KIND> __device__ __forceinline__ void run_phase(KArgs ap_in, LAS unsigned char* lds, const int l) {
    KArgs ap = ap_in; asm volatile("" : "+s"(ap));
    const Args args = *(const Args*)ap;
    const Ptrs& P = args.p;
    int tid_ = threadIdx.x; asm volatile("" : "+v"(tid_));
    const int tid = tid_, lane = tid & 63, wave = __builtin_amdgcn_readfirstlane(tid >> 6);
    const int G = gridDim.x, bx = blockIdx.x;
    const int gtid = bx * NT + tid, NTH = G * NT;
    const int gw = bx * 8 + wave, NGW = G * 8;
    unsigned char* ws = args.ws;
    float* MOD = (float*)(ws + WS_MOD);
    bf16* GW = (bf16*)(ws + WS_GW); bf16* PW = (bf16*)(ws + WS_PW); bf16* CPW = (bf16*)(ws + WS_CPW);
    bf16* WIN = (bf16*)(ws + WS_WIN); bf16* WOUT = (bf16*)(ws + WS_WOUT);
    bf16* HX = (bf16*)(ws + WS_HX); bf16* Z = HX; bf16* UX = (bf16*)(ws + WS_UX);
    float* XC = (float*)(ws + WS_R2); float* Y = (float*)(ws + WS_R2 + 36 * MiB);
    float* Dp = (float*)(ws + WS_R2); float* ZC = (float*)(ws + WS_R2 + 18 * MiB); float* CL = (float*)(ws + WS_R2 + 36 * MiB);
    float* O = (float*)(ws + WS_R2);
    float* CTXR = (float*)(ws + WS_CTXR); float* SUM = (float*)(ws + WS_SUM);
    float* out = args.out;

    {
        if constexpr (KIND == K_PREP) {
            LAS float* scr = (LAS float*)(lds + wave * 16384);
            constexpr int I_IN = 16 * 72, I_OUT = 16 * 32, I_CPW = 4 * 8, I_S = 2;
            constexpr int N_IN = 4 * I_IN, N_OUT = 4 * I_OUT, N_CPW = 4 * I_CPW, N_PW = 16 * I_S, N_GW = 64 * I_S;
            constexpr int NITEMS = N_IN + N_OUT + N_CPW + N_PW + 2 * N_GW;
            for (int it = gw; it < NITEMS; it += NGW) {
                int r = it;
                if (r < N_IN) { const int l = r / I_IN; transpose_item(P.w_in + (size_t)l * DM * NIN, DM, NIN, WIN + (size_t)l * NIN * DM, scr, r % I_IN, lane); continue; } r -= N_IN;
                if (r < N_OUT) { const int l = r / I_OUT; transpose_item(P.w_out + (size_t)l * DM * DM, DM, DM, WOUT + (size_t)l * DM * DM, scr, r % I_OUT, lane); continue; } r -= N_OUT;
                if (r < N_CPW) { const int l = r / I_CPW; transpose_item(P.conf_pw + (size_t)l * 65536, 256, 256, CPW + (size_t)l * 65536, scr, r % I_CPW, lane); continue; } r -= N_CPW;
                if (r < N_PW) { const int m = r / I_S; transpose_item(P.pool_w + (size_t)m * 4096, 64, 64, PW + (size_t)m * 4096, scr, r % I_S, lane); continue; } r -= N_PW;
                if (r < N_GW) { const int m = r / I_S; const int ld = m >> 3, h = m & 7;
                    transpose_item(P.lru_wa + (size_t)m * 4096, 64, 64, GW + (size_t)((ld * 2 + 0) * 8 + h) * 4096, scr, r % I_S, lane, -LOG2E); continue; } r -= N_GW;
                { const int m = r / I_S; const int ld = m >> 3, h = m & 7;
                    transpose_item(P.lru_wx + (size_t)m * 4096, 64, 64, GW + (size_t)((ld * 2 + 1) * 8 + h) * 4096, scr, r % I_S, lane, -LOG2E); }
            }
            for (int i = gtid; i < 4 * 2 * 2 * WL; i += NTH) { const int c = i & 511, gate = (i >> 9) & 1, ld = i >> 10;
                ((float*)(ws + WS_GB))[i] = -LOG2E * (gate ? P.lru_bx[ld * WL + c] : P.lru_ba[ld * WL + c]); }
            for (int i = gtid; i < 4 * 2 * WL; i += NTH) ((float*)(ws + WS_KC))[i] = -8.0f * LOG2E * log1pf(expf(-P.lru_lambda[i]));
            __syncthreads();
            LAS float* S = (LAS float*)lds;
            LAS float* RED = (LAS float*)(lds + 40960);
            for (int i = tid; i < 9 * 1024; i += NT) { const int r = i >> 10, k = i & 1023; const float v = r < 8 ? P.c[r * 1024 + k] : P.c_ctx[k]; S[i] = siluf_(v); }
            __syncthreads();
            for (int it = bx; it < 4 * 48; it += G) {
                const int l = it / 48, j0 = (it % 48) * 64, j = tid & 63, ks = tid >> 6;
                float acc[9];
#pragma unroll
                for (int r = 0; r < 9; ++r) acc[r] = 0.f;
                const float* wp = P.w_mod + (size_t)l * 1024 * 3072 + (size_t)(ks * 128) * 3072 + j0 + j;
#pragma unroll 4
                for (int k = 0; k < 128; ++k) { const float w = wp[(size_t)k * 3072];
#pragma unroll
                    for (int r = 0; r < 9; ++r) acc[r] += S[r * 1024 + ks * 128 + k] * w; }
#pragma unroll
                for (int r = 0; r < 9; ++r) RED[(ks * 9 + r) * 64 + j] = acc[r];
                __syncthreads();
                for (int i = tid; i < 9 * 64; i += NT) { const int r = i >> 6, jj = i & 63; float s = P.b_mod[l * 3072 + j0 + jj];
#pragma unroll
                    for (int q = 0; q < 8; ++q) s += RED[(q * 9 + r) * 64 + jj];
                    MOD[(size_t)(l * 9 + r) * 3072 + j0 + jj] = s; }
                __syncthreads();
            }
        } else if constexpr (KIND == K_EMBED) {
            for (int r = gw; r < MT; r += NGW) {
                int b, t, n, base; row_info(r, b, t, n, base);
                const bool isx = r < MX; const int mr = isx ? b : 8;
                const float* src = isx ? P.x + (size_t)r * DM : P.ctx + (size_t)(r - MX) * DM;
                float* dst = isx ? out + (size_t)r * DM : CTXR + (size_t)(r - MX) * DM;
                f32x4 v[4]; float ss = 0.f;
#pragma unroll
                for (int j = 0; j < 4; ++j) {
                    v[j] = *(const f32x4*)(src + 256 * j + 4 * lane);
                    if (isx) {
                        const float p = (j < 2) ? (float)(t >> 6) : (float)(t & 63);
#pragma unroll
                        for (int e = 0; e < 4; ++e) { const int i = 4 * lane + e; const float om = 1.0f / powf(10000.0f, (float)i / 256.0f); const float ang = p * om;
                            v[j][e] += (j & 1) ? cosf(ang) : sinf(ang); }
                    }
                    *(f32x4*)(dst + 256 * j + 4 * lane) = v[j];
                    ss += (v[j][0] * v[j][0] + v[j][1] * v[j][1]) + (v[j][2] * v[j][2] + v[j][3] * v[j][3]);
                }
                const float rstd = 1.0f / sqrtf(wave_sum(ss) * (1.0f / DM) + EPS_RMS);
                const float* sh = MOD + (size_t)(0 * 9 + mr) * 3072; const float* sc = sh + 1024;
#pragma unroll
                for (int j = 0; j < 4; ++j) { const int d0 = 256 * j + 4 * lane; float h[4];
#pragma unroll
                    for (int e = 0; e < 4; ++e) h[e] = v[j][e] * rstd * P.g_pre[d0 + e] * (1.0f + sc[d0 + e]) + sh[d0 + e];
                    uint2 w; w.x = pk2(h[0], h[1]); w.y = pk2(h[2], h[3]); *(uint2*)(HX + (size_t)r * DM + d0) = w; }
            }
        } else {
            constexpr int k = KIND;
            if constexpr (k == 0) {
                pg8::Gemm g{HX, WIN + (size_t)l * NIN * DM, MT, NIN, DM}; pg8::StaticOrder S; S.init(MT, NIN, G, bx);
                pg8::EpiBf16<0> E{UX, NIN, nullptr, 0, 0, 1.f};
                pg8::gemm_phase<pg8::EpiBf16<0>, pg8::StaticOrder, true, true>(lds, g, S, E);
            } else if constexpr (k == 2) {
                for (int sidx = bx; sidx < NB * NCHUNK; sidx += G) { const int b = sidx / NCHUNK, ck = sidx % NCHUNK;
                    const int r0 = chunk_row0(b, ck), tpos0 = ck < 4 ? 64 * ck : 64 * (ck - 4), n = ck < 4 ? CTXL : SEQ;
                    strip_conv(lds, P, l, UX, r0, tpos0, n, tid);
                    __syncthreads();
                    lru_core<0>(lds, l, wave, lane, GW, (const float*)(ws + WS_GB), (const float*)(ws + WS_KC), SUM + (size_t)sidx * 2 * WL * 2);
                    __syncthreads();
                }
            } else if constexpr (k == 3) {
                for (int sidx = bx; sidx < NB * NCHUNK; sidx += G) { const int b = sidx / NCHUNK, ck = sidx % NCHUNK;
                    if (l == DEPTH - 1 && ck < 4) continue;
                    mixer_strip(lds, P, l, b, ck, UX, Z, GW, (const float*)(ws + WS_GB), (const float*)(ws + WS_KC), SUM, PW, CPW, tid, wave, lane);
                }
            } else if constexpr (k == 7) {
                pg8::Gemm g{Z, WOUT + (size_t)l * DM * DM, MT, DM, DM}; pg8::StaticOrder S; S.init(MT, DM, G, bx);
                EpiF32 E{O, DM};
                pg8::gemm_phase<EpiF32, pg8::StaticOrder, true, true>(lds, g, S, E);
            } else {
                for (int r = gw; r < MT; r += NGW) {
                    const bool isx = r < MX; if (!isx && l == DEPTH - 1) continue;
                    const int b = isx ? (r >> 11) : ((r - MX) >> 8); const int mr = isx ? b : 8;
                    float* xr = isx ? out + (size_t)r * DM : CTXR + (size_t)(r - MX) * DM;
                    const float* orow = O + (size_t)r * DM; const float* gt = MOD + (size_t)(l * 9 + mr) * 3072 + 2048;
                    f32x4 o[4]; float ss = 0.f;
#pragma unroll
                    for (int j = 0; j < 4; ++j) { o[j] = *(const f32x4*)(orow + 256 * j + 4 * lane); ss += (o[j][0] * o[j][0] + o[j][1] * o[j][1]) + (o[j][2] * o[j][2] + o[j][3] * o[j][3]); }
                    const float rstd = 1.0f / sqrtf(wave_sum(ss) * (1.0f / DM) + EPS_RMS);
                    f32x4 v[4]; float s2 = 0.f;
#pragma unroll
                    for (int j = 0; j < 4; ++j) { const int d0 = 256 * j + 4 * lane; v[j] = *(const f32x4*)(xr + d0);
#pragma unroll
                        for (int e = 0; e < 4; ++e) v[j][e] += gt[d0 + e] * (o[j][e] * rstd * P.g_post[l * DM + d0 + e]);
                        *(f32x4*)(xr + d0) = v[j];
                        s2 += (v[j][0] * v[j][0] + v[j][1] * v[j][1]) + (v[j][2] * v[j][2] + v[j][3] * v[j][3]); }
                    if (l < DEPTH - 1) {
                        const float rs2 = 1.0f / sqrtf(wave_sum(s2) * (1.0f / DM) + EPS_RMS);
                        const float* sh = MOD + (size_t)((l + 1) * 9 + mr) * 3072; const float* sc = sh + 1024;
#pragma unroll
                        for (int j = 0; j < 4; ++j) { const int d0 = 256 * j + 4 * lane; float h[4];
#pragma unroll
                            for (int e = 0; e < 4; ++e) h[e] = v[j][e] * rs2 * P.g_pre[(l + 1) * DM + d0 + e] * (1.0f + sc[d0 + e]) + sh[d0 + e];
                            uint2 w; w.x = pk2(h[0], h[1]); w.y = pk2(h[2], h[3]); *(uint2*)(HX + (size_t)r * DM + d0) = w; }
                    }
                }
            }
        }
    }
}


#define XB_TMO      128
#define XB_XCNT(j)  (256  + 64 * (j))
#define XB_XSUB(j)  (1280 + 64 * (j))
#define XB_XGEN(j)  (2304 + 64 * (j))
#define XB_TOP      3328
#define XB_TOPGEN   3392
#define XCD_BAR_WORDS 3456
#define XB_SPIN_CAP (1u << 18)
constexpr int CW_BAR = 4096;
__device__ __forceinline__ unsigned xb_ld(unsigned* p)              { return __hip_atomic_load(p, __ATOMIC_RELAXED, __HIP_MEMORY_SCOPE_AGENT); }
__device__ __forceinline__ unsigned xb_add(unsigned* p, unsigned v) { return __hip_atomic_fetch_add(p, v, __ATOMIC_RELAXED, __HIP_MEMORY_SCOPE_AGENT); }
__device__ __forceinline__ unsigned xb_xcc_id() { return (unsigned)__builtin_amdgcn_s_getreg((3 << 11) | 20) & 0xFu; }
#define XB_SPIN(cond, bar) do { unsigned _sp = 0; while (cond) { __builtin_amdgcn_s_sleep(1); \
    if ((++_sp & 255u) == 0u) { if (xb_ld(&(bar)[XB_TMO])) break; if (_sp > XB_SPIN_CAP) { atomicAdd(&(bar)[XB_TMO], 1u); break; } } } } while (0)
struct XcdBarrier { unsigned* bar; unsigned x; volatile LAS unsigned* st; };
__device__ __forceinline__ XcdBarrier xcd_barrier_post(unsigned* bar, volatile LAS unsigned* st) {
    XcdBarrier b; b.bar = bar; b.x = xb_xcc_id(); b.st = st;
    if (threadIdx.x == 0) (void)xb_add(&bar[XB_XCNT(b.x)], 1u);
    return b;
}
__device__ __forceinline__ void xcd_barrier_complete(unsigned* bar, unsigned x, unsigned& nloc, unsigned& nx) {
    const unsigned G = gridDim.x * gridDim.y * gridDim.z;
    unsigned sum, cnt, mine, sp = 0u;
    for (;;) {
        sum = 0u; cnt = 0u; mine = 0u;
#pragma unroll
        for (unsigned j = 0; j < 16; ++j) { const unsigned c = xb_ld(&bar[XB_XCNT(j)]); sum += c; cnt += (c > 0u) ? 1u : 0u; mine = (j == x) ? c : mine; }
        if (sum == G) break;
        __builtin_amdgcn_s_sleep(1);
        if ((++sp & 255u) == 0u) { if (xb_ld(&bar[XB_TMO])) break; if (sp > XB_SPIN_CAP) { atomicAdd(&bar[XB_TMO], 1u); break; } }
    }
    nloc = mine > 0u ? mine : 1u; nx = cnt > 0u ? cnt : 1u;
}
__device__ __forceinline__ void xcd_barrier(const XcdBarrier& b) {
    asm volatile("s_waitcnt vmcnt(0)" ::: "memory");
    __syncthreads();
    if (threadIdx.x == 0) {
        unsigned* bar = b.bar;
        __builtin_amdgcn_s_waitcnt(0);
        unsigned nloc = b.st[0], nx = b.st[1];
        if (nloc == 0u) { xcd_barrier_complete(bar, b.x, nloc, nx); b.st[0] = nloc; b.st[1] = nx; }
        const unsigned old = xb_add(&bar[XB_XSUB(b.x)], 1u);
        const unsigned gen = old / nloc;
        if (old + 1u == (gen + 1u) * nloc) {
            __builtin_amdgcn_fence(__ATOMIC_RELEASE, "agent");
            asm volatile("s_waitcnt vmcnt(0)" ::: "memory");
            const unsigned og = xb_add(&bar[XB_TOP], 1u);
            const unsigned tg = og / nx;
            if (og + 1u == (tg + 1u) * nx) xb_add(&bar[XB_TOPGEN], 1u);
            else XB_SPIN(xb_ld(&bar[XB_TOPGEN]) == tg, bar);
            __builtin_amdgcn_fence(__ATOMIC_ACQUIRE, "agent");
            xb_add(&bar[XB_XGEN(b.x)], 1u);
            asm volatile("s_waitcnt vmcnt(0)" ::: "memory");
        } else {
            XB_SPIN(xb_ld(&bar[XB_XGEN(b.x)]) == gen, bar);
            __builtin_amdgcn_fence(__ATOMIC_ACQUIRE, "agent");
            asm volatile("s_waitcnt vmcnt(0)" ::: "memory");
        }
    }
    __syncthreads();
}

template <int KIND> __global__ void __launch_bounds__(NT, 2) fwd(Args args) {
    extern __shared__ __attribute__((aligned(16))) unsigned char lds_raw[];
    KArgs ap = (KArgs)__builtin_amdgcn_kernarg_segment_ptr();
    run_phase<KIND>(ap, (LAS unsigned char*)lds_raw, args.ph_lo);
}
#ifndef REP_BAR
#define REP_BAR 1
#endif
#ifndef REP_G1
#define REP_G1 1
#endif
#ifndef REP_S
#define REP_S 1
#endif
#ifndef REP_M
#define REP_M 1
#endif
#ifndef REP_G2
#define REP_G2 1
#endif
#define GRID_BAR() do { for (int rb_ = 0; rb_ < REP_BAR; ++rb_) xcd_barrier(bar); } while (0)
__global__ void __launch_bounds__(NT, 2) fwd_all(Args args) {
    extern __shared__ __attribute__((aligned(16))) unsigned char lds_raw[];
    LAS unsigned char* lds = (LAS unsigned char*)lds_raw;
    volatile LAS unsigned* MISC = (volatile LAS unsigned*)(lds + MISC_OFF);
    if (threadIdx.x < 32) MISC[threadIdx.x] = 0u;
    __syncthreads();
    KArgs ap = (KArgs)__builtin_amdgcn_kernarg_segment_ptr();
    XcdBarrier bar = xcd_barrier_post((unsigned*)(args.ws + WS_CTL) + CW_BAR, MISC + 8);
    run_phase<K_PREP>(ap, lds, 0); GRID_BAR();
    run_phase<K_EMBED>(ap, lds, 0); GRID_BAR();
#pragma unroll 1
    for (int l = 0; l < DEPTH; ++l) {
        for (int r_ = 0; r_ < REP_G1; ++r_) run_phase<0>(ap, lds, l); GRID_BAR();
        for (int r_ = 0; r_ < REP_S; ++r_) run_phase<2>(ap, lds, l); GRID_BAR();
        for (int r_ = 0; r_ < REP_M; ++r_) run_phase<3>(ap, lds, l); GRID_BAR();
        for (int r_ = 0; r_ < REP_G2; ++r_) run_phase<7>(ap, lds, l); GRID_BAR();
        run_phase<8>(ap, lds, l); if (l < DEPTH - 1) GRID_BAR();
    }
}

#ifndef N_LAUNCH_MODE
#define N_LAUNCH_MODE 1
#endif

extern "C" void kernel_launch(void* const* d_in, const int* in_sizes, int n_in, void* d_out, int out_size, void* d_ws, size_t ws_size, hipStream_t stream) {
    static int grid = 0, fused = 0;
    if (grid == 0) {
        if (n_in != 24 || in_sizes[0] != MX * DM || out_size != MX * DM || ws_size < WS_END) { fprintf(stderr, "kernel_launch: unexpected shapes (n_in %d, in0 %d, out %d, ws %zu)\n", n_in, n_in > 0 ? in_sizes[0] : -1, out_size, ws_size); grid = -1; return; }
        int dev = 0, cus = 0, per_cu = 0;
        if (hipGetDevice(&dev) != hipSuccess || hipDeviceGetAttribute(&cus, hipDeviceAttributeMultiprocessorCount, dev) != hipSuccess) { grid = -1; return; }
        bool ok = true;
#define SETA(F) ok = ok && (hipFuncSetAttribute((const void*)F, hipFuncAttributeMaxDynamicSharedMemorySize, LDS_BYTES) == hipSuccess)
        SETA(fwd<K_PREP>); SETA(fwd<K_EMBED>); SETA(fwd<0>); SETA(fwd<2>); SETA(fwd<3>); SETA(fwd<7>); SETA(fwd<8>); SETA(fwd_all);
        if (!ok) { fprintf(stderr, "kernel_launch: hipFuncSetAttribute failed\n"); grid = -1; return; }
        grid = cus;
        if (hipOccupancyMaxActiveBlocksPerMultiprocessor(&per_cu, (const void*)fwd_all, NT, LDS_BYTES) != hipSuccess) per_cu = 0;
        (void)hipGetLastError();
        fused = (N_LAUNCH_MODE == 1 && per_cu >= 1) ? 1 : 0;
        if (!fused) fprintf(stderr, "kernel_launch: falling back to one launch per phase (occupancy query: %d per CU)\n", per_cu);
    }
    if (grid < 0) return;
    (void)hipMemsetAsync((char*)d_ws + WS_CTL, 0, CTL_ZERO_BYTES, stream);
    Args a{};
    const float** pp = (const float**)&a.p;
    for (int i = 0; i < 24; ++i) pp[i] = (const float*)d_in[i];
    a.out = (float*)d_out; a.ws = (unsigned char*)d_ws;
    a.ph_lo = 0; a.ph_hi = 0;
    if (fused) { hipLaunchKernelGGL(fwd_all, dim3(grid), dim3(NT), LDS_BYTES, stream, a); return; }
#define LAUNCH(K) hipLaunchKernelGGL(fwd<K>, dim3(grid), dim3(NT), LDS_BYTES, stream, a)
    LAUNCH(K_PREP); LAUNCH(K_EMBED);
    for (int l = 0; l < DEPTH; ++l) { a.ph_lo = l; LAUNCH(0); LAUNCH(2); LAUNCH(3); LAUNCH(7); LAUNCH(8); }
}
```

```cpp
#include <hip/hip_runtime.h>
#include <cstdio>
#include <cstdint>
namespace pg8 {
#define PG8_LAS __attribute__((address_space(3)))
typedef unsigned short bf16_t;
typedef short bf16x8 __attribute__((ext_vector_type(8)));
typedef float f32x4 __attribute__((ext_vector_type(4)));
typedef unsigned u32x4 __attribute__((ext_vector_type(4)));
constexpr int BM = 256, BK = 64, HALF = 128, HTB = HALF * BK * 2  , STAGE_BYTES = 8 * HTB, NXCD = 8, WGM = 8;

__host__ __device__ __forceinline__ int lds_byte(int r, int c) { const int st = (r >> 4) * 2 + (c >> 5), rr = r & 15, cc = c & 31, ob = rr * 64 + cc * 2; return st * 1024 + (ob ^ (((ob >> 9) & 1) << 5)); }
__host__ __device__ __forceinline__ void stage_rc(int b, int& R, int& C) { const int st = b / 1024, sb = b % 1024, swz = sb ^ (((sb >> 9) & 1) << 5); R = (st >> 1) * 16 + swz / 64; C = (st & 1) * 32 + (swz % 64) / 2; }
__host__ __device__ __forceinline__ int perm32(int rho) { const int n = rho >> 4, i = rho & 15; return 8 * (i >> 2) + 4 * n + (i & 3); }

struct Unit { int pm, pn; };
struct Gemm { const bf16_t* A; const bf16_t* Bt; int M, N, K; };

struct StaticOrder {
    int nM, nN, nwg, G, c;
    __host__ __device__ void init(int M, int N, int G_, int c_) { nM = M / BM; nN = N / BM; nwg = nM * nN; G = G_; c = c_; }
    __host__ __device__ bool next(int i, Unit& u) const {
        const long L = (long)i * G + c; if (L >= nwg) return false;
        int wgid = (int)L; { const int q = nwg / NXCD, r = nwg % NXCD, xcd = wgid % NXCD, off = wgid / NXCD; wgid = (xcd < r ? xcd * (q + 1) : r * (q + 1) + (xcd - r) * q) + off; }
        const int nig = WGM * nN, gid = wgid / nig, fm = gid * WGM, gsz = (nM - fm) < WGM ? (nM - fm) : WGM;
        u.pm = fm + ((wgid % nig) % gsz); u.pn = (wgid % nig) / gsz; return true;
    }
    __device__ __forceinline__ void a_ready(const Unit&) const {}
    __device__ __forceinline__ void done(const Unit&) const {}
};

__device__ __forceinline__ unsigned cvt_pk_bf16(float lo, float hi) { unsigned r; asm volatile("v_cvt_pk_bf16_f32 %0, %1, %2" : "=v"(r) : "v"(lo), "v"(hi)); return r; }
typedef float f32x2 __attribute__((ext_vector_type(2)));
__device__ __forceinline__ f32x2 gelu_pk(f32x2 v) {
    const f32x2 av = __builtin_elementwise_abs(v), d = av * 0.2316418882f + 1.0f;
    f32x2 t; t.x = __builtin_amdgcn_rcpf(d.x); t.y = __builtin_amdgcn_rcpf(d.y);
    f32x2 q = t * 0.5307027145f + (-0.7265760135f); q = q * t + 0.7107068705f; q = q * t + (-0.142248368f); q = q * t + 0.127414796f; q = q * t;
    const f32x2 s = (v * v) * (-0.72134752044f);
    f32x2 e; e.x = __builtin_amdgcn_exp2f(s.x); e.y = __builtin_amdgcn_exp2f(s.y);
    const f32x2 m = v * (q * e), r = v - m;
    f32x2 o; o.x = v.x < 0.f ? m.x : r.x; o.y = v.y < 0.f ? m.y : r.y; return o;
}

template <int ACT  > struct EpiBf16 {
    static constexpr bool PERM = true, AFTER_DRAIN = false; static_assert(ACT == 0 || ACT == 1, "EpiBf16: ACT is 0 (none) or 1 (gelu_pk)");
    bf16_t* O; int ldc; const float* bias; int split_cols; size_t split_stride; float scale0;
    __device__ __forceinline__ void operator()(const f32x4 (&acc)[2][2][4][2], const Unit& u, int wr, int wc, int fr, int fq) const {
        const int row0 = u.pm * BM + wr * 64 + fr; int colt = u.pn * BM; bf16_t* base = O;
        float sc = 1.f; if (split_cols) { const int t = colt / split_cols; base += (size_t)t * split_stride; colt -= t * split_cols; if (t == 0) sc = scale0; }
        const int col0 = colt + wc * 32 + 8 * fq, bcol0 = u.pn * BM + wc * 32 + 8 * fq;
        f32x4 bv[2][2];
#pragma unroll
        for (int bj = 0; bj < 2; ++bj)
#pragma unroll
            for (int n = 0; n < 2; ++n) bv[bj][n] = bias ? *(const f32x4*)(bias + bcol0 + bj * HALF + 4 * n) : (f32x4){0.f, 0.f, 0.f, 0.f};
#pragma unroll
        for (int ai = 0; ai < 2; ++ai)
#pragma unroll
            for (int m = 0; m < 4; ++m) { bf16_t* rowp = base + (size_t)(row0 + ai * HALF + m * 16) * ldc + col0;
#pragma unroll
                for (int bj = 0; bj < 2; ++bj) { f32x4 v0 = acc[ai][bj][m][0] + bv[bj][0], v1 = acc[ai][bj][m][1] + bv[bj][1];
                    if (ACT == 1) { f32x2 a = gelu_pk((f32x2){v0[0], v0[1]}), b = gelu_pk((f32x2){v0[2], v0[3]}), c = gelu_pk((f32x2){v1[0], v1[1]}), d = gelu_pk((f32x2){v1[2], v1[3]});
                        v0 = (f32x4){a.x, a.y, b.x, b.y}; v1 = (f32x4){c.x, c.y, d.x, d.y}; }
                    v0 = v0 * sc; v1 = v1 * sc; u32x4 w; w.x = cvt_pk_bf16(v0[0], v0[1]); w.y = cvt_pk_bf16(v0[2], v0[3]); w.z = cvt_pk_bf16(v1[0], v1[1]); w.w = cvt_pk_bf16(v1[2], v1[3]);
                    *(u32x4*)(rowp + bj * HALF) = w; } }
    }
};

struct PanelStats {
    unsigned* xbuf;
    unsigned* cnt;
    unsigned* tmo;
    int ntn; float eps;
    unsigned code;
    __device__ __forceinline__ bool run(const f32x4 (&v)[2][2][4][2], const Unit& u, int wr, int wc, int fr, int fq, PG8_LAS unsigned char* lds, int wid, int lane) const {
        typedef float f32x2v __attribute__((ext_vector_type(2)));
        PG8_LAS f32x2v* P = (PG8_LAS f32x2v*)lds;
        PG8_LAS f32x2v* S = (PG8_LAS f32x2v*)(lds + 8192);
        PG8_LAS unsigned* flag = (PG8_LAS unsigned*)(lds + 8192 + 2048);
#pragma unroll
        for (int ai = 0; ai < 2; ++ai)
#pragma unroll
            for (int m = 0; m < 4; ++m) {
                float s = 0.f;
#pragma unroll
                for (int bj = 0; bj < 2; ++bj)
#pragma unroll
                    for (int n = 0; n < 2; ++n) { const f32x4 x = v[ai][bj][m][n]; s += (x[0] + x[1]) + (x[2] + x[3]); }
                s += __shfl_xor(s, 16); s += __shfl_xor(s, 32);
                const float mw = s * (1.0f / 64.0f); float q = 0.f;
#pragma unroll
                for (int bj = 0; bj < 2; ++bj)
#pragma unroll
                    for (int n = 0; n < 2; ++n) { const f32x4 d = v[ai][bj][m][n] - mw; q += (d[0] * d[0] + d[1] * d[1]) + (d[2] * d[2] + d[3] * d[3]); }
                q += __shfl_xor(q, 16); q += __shfl_xor(q, 32);
                if (fq == 0) P[(ai * HALF + wr * 64 + m * 16 + fr) * 4 + wc] = (f32x2v){mw, q};
            }
        asm volatile("s_waitcnt lgkmcnt(0)" ::: "memory"); __builtin_amdgcn_s_barrier(); asm volatile("" ::: "memory");
#if defined(BROKEN_EXCHANGE_NO_WAIT)
#warning BROKEN CONTROL BUILD: the row-statistics exchange does not wait; results are wrong by design
        if (blockIdx.x >= 64) { const long long t0_ = clock64(); while (clock64() - t0_ < 60000) __builtin_amdgcn_s_sleep(8); }
#endif
        const int row = wid * 32 + (lane & 31);
        if (lane < 32) {
            const f32x2v a = P[row * 4 + 0], b = P[row * 4 + 1], c = P[row * 4 + 2], d = P[row * 4 + 3];
            const float mt = (a.x + b.x + c.x + d.x) * 0.25f;
            const float da = a.x - mt, db = b.x - mt, dc = c.x - mt, dd = d.x - mt;
            const float m2 = (a.y + b.y) + (c.y + d.y) + 64.0f * ((da * da + db * db) + (dc * dc + dd * dd));
            unsigned long long* slot = (unsigned long long*)xbuf + ((size_t)(u.pm * BM + row) * 4 + u.pn);
            __hip_atomic_store(slot, ((unsigned long long)__float_as_uint(m2) << 32) | __float_as_uint(mt), __ATOMIC_RELAXED, __HIP_MEMORY_SCOPE_AGENT);
        }
        asm volatile("s_waitcnt vmcnt(0)" ::: "memory");
        if (lane == 0) __hip_atomic_fetch_add(cnt + 64 * u.pm, 1u, __ATOMIC_RELAXED, __HIP_MEMORY_SCOPE_AGENT);
        if (wid == 0) {
            bool dead = false; const unsigned long long t0 = __builtin_amdgcn_s_memrealtime(); const unsigned want = 8u * (unsigned)ntn;
            for (;;) {
#if defined(BROKEN_EXCHANGE_NO_WAIT)
                break;
#endif
                if ((unsigned)__builtin_amdgcn_readfirstlane(__hip_atomic_load(cnt + 64 * u.pm, __ATOMIC_RELAXED, __HIP_MEMORY_SCOPE_AGENT)) >= want) break;
                if (__builtin_amdgcn_s_memrealtime() - t0 > 2000000ull) {
                    if (lane == 0) { unsigned expect = 0u; __hip_atomic_compare_exchange_strong(tmo + 1, &expect, code | (unsigned)(u.pm & 0xff), __ATOMIC_RELAXED, __ATOMIC_RELAXED, __HIP_MEMORY_SCOPE_AGENT);
                                     __hip_atomic_store(tmo, 1u, __ATOMIC_RELAXED, __HIP_MEMORY_SCOPE_AGENT); }
                    dead = true; break; }
                __builtin_amdgcn_s_sleep(2);
            }
            __builtin_amdgcn_fence(__ATOMIC_ACQUIRE, "agent");
            if (lane == 0) flag[0] = dead ? 1u : 0u;
        }
        asm volatile("s_waitcnt vmcnt(0) lgkmcnt(0)" ::: "memory"); __builtin_amdgcn_s_barrier(); asm volatile("" ::: "memory");
        const bool bad = flag[0] != 0u;
        if (lane < 32) {
            const unsigned long long* slot = (const unsigned long long*)xbuf + (size_t)(u.pm * BM + row) * 4; float mt[4], m2[4]; float ms = 0.f;
#pragma unroll
            for (int t = 0; t < 4; ++t) { if (t < ntn) { const unsigned long long w = __hip_atomic_load(slot + t, __ATOMIC_RELAXED, __HIP_MEMORY_SCOPE_AGENT); mt[t] = __uint_as_float((unsigned)w); m2[t] = __uint_as_float((unsigned)(w >> 32)); } else { mt[t] = 0.f; m2[t] = 0.f; } ms += mt[t]; }
            const float mean = ms / (float)ntn; float q = 0.f;
#pragma unroll
            for (int t = 0; t < 4; ++t) if (t < ntn) { const float dm = mt[t] - mean; q += m2[t] + 256.0f * dm * dm; }
            S[row] = (f32x2v){mean, 1.0f / sqrtf(q / (256.0f * (float)ntn) + eps)};
        }
        asm volatile("s_waitcnt lgkmcnt(0)" ::: "memory"); __builtin_amdgcn_s_barrier(); asm volatile("" ::: "memory");
        return bad;
    }
};
struct EpiLnRes {
    static constexpr bool PERM = false, AFTER_DRAIN = true;
    const float* base; float* out; int ldc; const float* bias; PanelStats st; unsigned poison;
    __device__ __forceinline__ void fused(f32x4 (&acc)[2][2][4][2], const Unit& u, int wr, int wc, int fr, int fq, PG8_LAS unsigned char* lds, int wid, int lane) const {
        typedef float f32x2v __attribute__((ext_vector_type(2)));
        const PG8_LAS f32x2v* S = (const PG8_LAS f32x2v*)(lds + 8192);
        const int col0 = u.pn * BM + wc * 32 + 4 * fq;
#pragma unroll
        for (int bj = 0; bj < 2; ++bj)
#pragma unroll
            for (int n = 0; n < 2; ++n) { const f32x4 bv = bias ? *(const f32x4*)(bias + col0 + bj * HALF + n * 16) : (f32x4){0.f, 0.f, 0.f, 0.f};
#pragma unroll
                for (int ai = 0; ai < 2; ++ai)
#pragma unroll
                    for (int m = 0; m < 4; ++m) acc[ai][bj][m][n] += bv; }
        f32x4 pre[4][2][2];
#pragma unroll
        for (int m = 0; m < 4; ++m) { const size_t off = (size_t)(u.pm * BM + wr * 64 + m * 16 + fr) * ldc + col0;
#pragma unroll
            for (int bj = 0; bj < 2; ++bj)
#pragma unroll
                for (int n = 0; n < 2; ++n) pre[m][bj][n] = *(const f32x4*)(base + off + bj * HALF + n * 16); }
        const bool bad = st.run(acc, u, wr, wc, fr, fq, lds, wid, lane) || poison != 0u;
        const float qnan = __builtin_nanf("");
#pragma unroll
        for (int ai = 0; ai < 2; ++ai)
#pragma unroll
            for (int m = 0; m < 4; ++m) { const int r = ai * HALF + wr * 64 + m * 16 + fr; const f32x2v sr = S[r]; const size_t off = (size_t)(u.pm * BM + r) * ldc + col0;
#pragma unroll
                for (int bj = 0; bj < 2; ++bj)
#pragma unroll
                    for (int n = 0; n < 2; ++n) { const f32x4 bs = ai == 0 ? pre[m][bj][n] : *(const f32x4*)(base + off + bj * HALF + n * 16); f32x4 o = bs + (acc[ai][bj][m][n] - sr.x) * sr.y;
                        if (bad) o = (f32x4){qnan, qnan, qnan, qnan}; *(f32x4*)(out + off + bj * HALF + n * 16) = o; }
                if (m & 1) asm volatile("" ::: "memory"); }
    }
};
struct EpiLnResLn {
    static constexpr bool PERM = false, AFTER_DRAIN = true;
    const float* base; float* out; bf16_t* xn; int ldc; const float* bias; PanelStats st1, st2; unsigned poison;
    __device__ __forceinline__ void fused(f32x4 (&acc)[2][2][4][2], const Unit& u, int wr, int wc, int fr, int fq, PG8_LAS unsigned char* lds, int wid, int lane) const {
        typedef float f32x2v __attribute__((ext_vector_type(2))); typedef unsigned u32x2v __attribute__((ext_vector_type(2)));
        const PG8_LAS f32x2v* S = (const PG8_LAS f32x2v*)(lds + 8192);
        const int col0 = u.pn * BM + wc * 32 + 4 * fq;
#pragma unroll
        for (int bj = 0; bj < 2; ++bj)
#pragma unroll
            for (int n = 0; n < 2; ++n) { const f32x4 bv = bias ? *(const f32x4*)(bias + col0 + bj * HALF + n * 16) : (f32x4){0.f, 0.f, 0.f, 0.f};
#pragma unroll
                for (int ai = 0; ai < 2; ++ai)
#pragma unroll
                    for (int m = 0; m < 4; ++m) acc[ai][bj][m][n] += bv; }
        bool bad = st1.run(acc, u, wr, wc, fr, fq, lds, wid, lane) || poison != 0u;
        const float qnan = __builtin_nanf("");
#pragma unroll
        for (int ai = 0; ai < 2; ++ai)
#pragma unroll
            for (int m = 0; m < 4; ++m) { const int r = ai * HALF + wr * 64 + m * 16 + fr; const f32x2v sr = S[r]; const size_t off = (size_t)(u.pm * BM + r) * ldc + col0;
#pragma unroll
                for (int bj = 0; bj < 2; ++bj)
#pragma unroll
                    for (int n = 0; n < 2; ++n) { const f32x4 bs = *(const f32x4*)(base + off + bj * HALF + n * 16); acc[ai][bj][m][n] = bs + (acc[ai][bj][m][n] - sr.x) * sr.y; }
                asm volatile("" : "+v"(acc[ai][0][m][0]), "+v"(acc[ai][0][m][1]), "+v"(acc[ai][1][m][0]), "+v"(acc[ai][1][m][1]));
                if (m & 1) asm volatile("" ::: "memory"); }
        const bool bad1 = bad;
        bad = st2.run(acc, u, wr, wc, fr, fq, lds, wid, lane) || bad;
#pragma unroll
        for (int ai = 0; ai < 2; ++ai)
#pragma unroll
            for (int m = 0; m < 4; ++m) { const int r = ai * HALF + wr * 64 + m * 16 + fr; const f32x2v sr = S[r]; const size_t off = (size_t)(u.pm * BM + r) * ldc + col0;
#pragma unroll
                for (int bj = 0; bj < 2; ++bj)
#pragma unroll
                    for (int n = 0; n < 2; ++n) { const f32x4 x1 = acc[ai][bj][m][n]; *(f32x4*)(out + off + bj * HALF + n * 16) = bad1 ? (f32x4){qnan, qnan, qnan, qnan} : x1;
                        const f32x4 o = (x1 - sr.x) * sr.y; u32x2v w; w.x = cvt_pk_bf16(o[0], o[1]); w.y = cvt_pk_bf16(o[2], o[3]);
                        if (bad) { w.x = 0x7fc07fc0u; w.y = 0x7fc07fc0u; } *(u32x2v*)(xn + off + bj * HALF + n * 16) = w; }
                asm volatile("" ::: "memory"); }
    }
};

template <class Epi, class Sched, bool ALIGN_EPI = false, bool SP2 = false>
__device__ __forceinline__ void gemm_phase(PG8_LAS unsigned char* lds, const Gemm g, const Sched& S, const Epi& E) {
    int tid_ = threadIdx.x; asm volatile("" : "+v"(tid_));
    const int tid = tid_, wid = __builtin_amdgcn_readfirstlane(tid >> 6), lane = tid & 63, wr = wid >> 2, wc = wid & 3, fr = lane & 15, fq = lane >> 4;
    const int K = g.K, nt = K / BK;
    unsigned voffA[2], voffB[2];
#pragma unroll
    for (int i = 0; i < 2; ++i) { int R, C; stage_rc(tid * 16 + i * 8192, R, C); const int Rb = Epi::PERM ? ((R & ~31) + perm32(R & 31)) : R;
        voffA[i] = (unsigned)(R * K + C) * 2u; voffB[i] = (unsigned)(Rb * K + C) * 2u; }
    const size_t kstep = (size_t)(BK * 2);
    const size_t hstep = (size_t)HALF * K * 2;
    const size_t tstep = 2 * hstep;
    const unsigned ldsw = (unsigned)wid * 1024u;
    const int aoff = lds_byte(wr * 64 + fr, fq * 8), boff = lds_byte(wc * 32 + fr, fq * 8);
#define PG8_SA(b, h) (((b) * 2 + (h)) * HTB)
#define PG8_SB(b, h) ((4 + (b) * 2 + (h)) * HTB)
#define PG8_STAGE(bufoff, gbase, voff) do { _Pragma("unroll") for (int _i = 0; _i < 2; ++_i) \
        __builtin_amdgcn_global_load_lds((const unsigned*)((const char*)(gbase) + (voff)[_i]), (PG8_LAS unsigned*)(lds + (bufoff) + ldsw + _i * 8192), 16, 0, 0); } while (0)
#define PG8_LDA(dst, b, h) do { _Pragma("unroll") for (int m = 0; m < 4; ++m) _Pragma("unroll") for (int k = 0; k < 2; ++k) dst[m][k] = *(const PG8_LAS bf16x8*)(lds + PG8_SA(b, h) + aoff + m * 2048 + k * 1024); } while (0)
#define PG8_LDB(dst, b, h) do { _Pragma("unroll") for (int n = 0; n < 2; ++n) _Pragma("unroll") for (int k = 0; k < 2; ++k) dst[n][k] = *(const PG8_LAS bf16x8*)(lds + PG8_SB(b, h) + boff + n * 2048 + k * 1024); } while (0)
#define PG8_MMA(ai, bj, At, Bt) do { __builtin_amdgcn_s_setprio(1); _Pragma("unroll") for (int m = 0; m < 4; ++m) _Pragma("unroll") for (int n = 0; n < 2; ++n) _Pragma("unroll") for (int k = 0; k < 2; ++k) \
        acc[ai][bj][m][n] = __builtin_amdgcn_mfma_f32_16x16x32_bf16(Bt[n][k], At[m][k], acc[ai][bj][m][n], 0, 0, 0); __builtin_amdgcn_s_setprio(0); } while (0)
#define PG8_WAIT_V(n) asm volatile("s_waitcnt vmcnt(" #n ")" ::: "memory")
#define PG8_WAIT_L(n) asm volatile("s_waitcnt lgkmcnt(" #n ")" ::: "memory")
#define PG8_BAR __builtin_amdgcn_s_barrier()
#define PG8_SCHED __builtin_amdgcn_sched_barrier(0)
    Unit cur, nxt; int ui = 0;
    if (!S.next(0, cur)) return;
    f32x4 acc[2][2][4][2];
#pragma unroll
    for (int a = 0; a < 2; ++a)
#pragma unroll
        for (int b = 0; b < 2; ++b)
#pragma unroll
            for (int m = 0; m < 4; ++m)
#pragma unroll
                for (int n = 0; n < 2; ++n) acc[a][b][m][n] = (f32x4){0.f, 0.f, 0.f, 0.f};
    bf16x8 At[4][2], B0[2][2], B1[2][2];
    const char* cA = (const char*)g.A + (size_t)cur.pm * tstep; const char* cB = (const char*)g.Bt + (size_t)cur.pn * tstep;
    S.a_ready(cur);
    if constexpr (SP2) {
        PG8_STAGE(PG8_SB(0, 0), cB, voffB); PG8_STAGE(PG8_SB(0, 1), cB + hstep, voffB); PG8_STAGE(PG8_SA(0, 0), cA, voffA); PG8_STAGE(PG8_SA(0, 1), cA + hstep, voffA);
        if (wr == 1) PG8_BAR;
        PG8_WAIT_V(2); PG8_BAR;
        PG8_STAGE(PG8_SB(1, 0), cB + kstep, voffB); PG8_STAGE(PG8_SA(1, 0), cA + kstep, voffA); PG8_STAGE(PG8_SB(1, 1), cB + hstep + kstep, voffB);
        PG8_WAIT_V(6); PG8_BAR;
    } else {
        PG8_STAGE(PG8_SB(0, 0), cB, voffB); PG8_STAGE(PG8_SA(0, 0), cA, voffA); PG8_STAGE(PG8_SB(0, 1), cB + hstep, voffB); PG8_STAGE(PG8_SA(0, 1), cA + hstep, voffA);
        if (wr == 1) PG8_BAR;
        PG8_WAIT_V(4); PG8_BAR;
        PG8_STAGE(PG8_SB(1, 0), cB + kstep, voffB); PG8_STAGE(PG8_SA(1, 0), cA + kstep, voffA); PG8_STAGE(PG8_SB(1, 1), cB + hstep + kstep, voffB);
        PG8_WAIT_V(6); PG8_BAR;
    }
    for (;;) {
        const bool has_next = S.next(ui + 1, nxt);
        const char* nA = has_next ? (const char*)g.A + (size_t)nxt.pm * tstep : cA; const char* nB = has_next ? (const char*)g.Bt + (size_t)nxt.pn * tstep : cB;
        for (int t = 0; t < nt; t += 2) {
            const bool last = (t == nt - 2);
            const char* a1 = cA + (size_t)(t + 1) * kstep;
            const char* a2 = last ? nA : cA + (size_t)(t + 2) * kstep; const char* b2 = last ? nB : cB + (size_t)(t + 2) * kstep;
            const char* a3 = a2 + kstep; const char* b3 = b2 + kstep;
            if (last && has_next) S.a_ready(nxt);
            if constexpr (SP2) {
            PG8_LDB(B0, 0, 0); PG8_LDB(B1, 0, 1); PG8_SCHED; PG8_LDA(At, 0, 0); PG8_STAGE(PG8_SA(1, 1), a1 + hstep, voffA);
            PG8_WAIT_V(8); PG8_WAIT_L(0); PG8_BAR; PG8_MMA(0, 0, At, B0); PG8_MMA(0, 1, At, B1); PG8_BAR; PG8_SCHED;
            PG8_LDA(At, 0, 1); PG8_STAGE(PG8_SB(0, 0), b2, voffB); PG8_STAGE(PG8_SB(0, 1), b2 + hstep, voffB); PG8_STAGE(PG8_SA(0, 0), a2, voffA);
            PG8_WAIT_V(8); PG8_WAIT_L(0); PG8_BAR; PG8_MMA(1, 0, At, B0); PG8_MMA(1, 1, At, B1); PG8_BAR; PG8_SCHED;
            PG8_LDB(B0, 1, 0); PG8_LDB(B1, 1, 1); PG8_SCHED; PG8_LDA(At, 1, 0); PG8_STAGE(PG8_SA(0, 1), a2 + hstep, voffA);
            PG8_WAIT_V(8); PG8_WAIT_L(0); PG8_BAR; PG8_MMA(0, 0, At, B0); PG8_MMA(0, 1, At, B1); PG8_BAR; PG8_SCHED;
            PG8_LDA(At, 1, 1); PG8_STAGE(PG8_SB(1, 0), b3, voffB); PG8_STAGE(PG8_SB(1, 1), b3 + hstep, voffB); PG8_STAGE(PG8_SA(1, 0), a3, voffA);
            PG8_WAIT_V(8); PG8_WAIT_L(0); PG8_BAR; PG8_MMA(1, 0, At, B0); PG8_MMA(1, 1, At, B1); PG8_BAR; PG8_SCHED;
            } else {
            PG8_LDB(B0, 0, 0); PG8_SCHED; PG8_LDA(At, 0, 0); PG8_STAGE(PG8_SA(1, 1), a1 + hstep, voffA);
            PG8_WAIT_L(8); PG8_BAR; PG8_WAIT_L(0); PG8_MMA(0, 0, At, B0); PG8_BAR; PG8_SCHED;
            PG8_LDB(B1, 0, 1); PG8_STAGE(PG8_SB(0, 0), b2, voffB);
            PG8_BAR; PG8_WAIT_L(0); PG8_MMA(0, 1, At, B1); PG8_BAR;
            PG8_LDA(At, 0, 1); PG8_STAGE(PG8_SA(0, 0), a2, voffA);
            PG8_BAR; PG8_WAIT_L(0); PG8_MMA(1, 0, At, B0); PG8_BAR; PG8_SCHED;
            PG8_STAGE(PG8_SB(0, 1), b2 + hstep, voffB);
            PG8_WAIT_V(6); PG8_BAR; PG8_MMA(1, 1, At, B1); PG8_BAR;
            PG8_LDB(B0, 1, 0); PG8_SCHED; PG8_LDA(At, 1, 0); PG8_STAGE(PG8_SA(0, 1), a2 + hstep, voffA);
            PG8_WAIT_L(8); PG8_BAR; PG8_WAIT_L(0); PG8_MMA(0, 0, At, B0); PG8_BAR; PG8_SCHED;
            PG8_LDB(B1, 1, 1); PG8_STAGE(PG8_SB(1, 0), b3, voffB);
            PG8_BAR; PG8_WAIT_L(0); PG8_MMA(0, 1, At, B1); PG8_BAR;
            PG8_LDA(At, 1, 1); PG8_STAGE(PG8_SA(1, 0), a3, voffA);
            PG8_BAR; PG8_WAIT_L(0); PG8_MMA(1, 0, At, B0); PG8_BAR; PG8_SCHED;
            PG8_STAGE(PG8_SB(1, 1), b3 + hstep, voffB);
            PG8_WAIT_V(6); PG8_BAR; PG8_MMA(1, 1, At, B1); PG8_BAR;
            }
        }
        if constexpr (ALIGN_EPI) { if (wr == 0) PG8_BAR; }
        if constexpr (!Epi::AFTER_DRAIN) { E(acc, cur, wr, wc, fr, fq); S.done(cur); }
        if (!has_next) break;
#pragma unroll
        for (int a = 0; a < 2; ++a)
#pragma unroll
            for (int b = 0; b < 2; ++b)
#pragma unroll
                for (int m = 0; m < 4; ++m)
#pragma unroll
                    for (int n = 0; n < 2; ++n) acc[a][b][m][n] = (f32x4){0.f, 0.f, 0.f, 0.f};
        cur = nxt; cA = nA; cB = nB; ++ui;
        if constexpr (ALIGN_EPI) { if (wr == 1) PG8_BAR; }
    }
    PG8_WAIT_V(0);
    if constexpr (!ALIGN_EPI) { if (wr == 0) PG8_BAR; }
    PG8_BAR;
    if constexpr (Epi::AFTER_DRAIN) { E.fused(acc, cur, wr, wc, fr, fq, lds, wid, lane); S.done(cur); }
#undef PG8_SA
#undef PG8_SB
#undef PG8_STAGE
#undef PG8_LDA
#undef PG8_LDB
#undef PG8_MMA
#undef PG8_WAIT_V
#undef PG8_WAIT_L
#undef PG8_BAR
#undef PG8_SCHED
}
}

constexpr int DM = 1024, NB = 8, SEQ = 2048, DEPTH = 4, CTXL = 256, NIN = 2304;
constexpr int MX = NB * SEQ, MC = NB * CTXL, MT = MX + MC;
constexpr int WL = 512, WP = 256, WC = 256;
constexpr int C_VL = 0, C_GL = 512, C_VP = 1024, C_GP = 1280, C_VC = 1536, C_GG = 1792, C_GC = 2048;
constexpr int NCHUNK = 36;
constexpr float EPS_RMS = 1e-6f, EPS_LN = 1e-5f;

constexpr size_t MiB = 1u << 20;
constexpr size_t WS_CTL = 0, CTL_ZERO_BYTES = 1 * MiB;
constexpr size_t WS_MOD = 1 * MiB;
constexpr size_t WS_GB = 1 * MiB + 512 * 1024;
constexpr size_t WS_KC = WS_GB + 32768;
constexpr float LOG2E = 1.4426950408889634f;
constexpr size_t WS_GW = 2 * MiB;
constexpr size_t WS_PW = 3 * MiB;
constexpr size_t WS_CPW = 3 * MiB + 512 * 1024;
constexpr size_t WS_WIN = 4 * MiB;
constexpr size_t WS_WOUT = 22 * MiB;
constexpr size_t WS_HX = 30 * MiB;
constexpr size_t WS_UX = 66 * MiB;
constexpr size_t WS_R2 = 147 * MiB;
constexpr size_t WS_CTXR = 219 * MiB;
constexpr size_t WS_SUM = 227 * MiB;
constexpr size_t WS_END = 230 * MiB;

constexpr int LDS_BYTES = 147456;
constexpr int MISC_OFF = LDS_BYTES - 256;
constexpr int NT = 512;

#define GAS __attribute__((address_space(1)))
#define LAS __attribute__((address_space(3)))
typedef unsigned short bf16;
typedef unsigned v4u __attribute__((ext_vector_type(4)));
typedef float f32x4 __attribute__((ext_vector_type(4)));
typedef unsigned v2u __attribute__((ext_vector_type(2)));
#define LDS_WAIT() asm volatile("s_waitcnt lgkmcnt(0)" ::: "memory")
#define VM_WAIT() asm volatile("s_waitcnt vmcnt(0)" ::: "memory")

__device__ __forceinline__ unsigned f2bf(float f) { unsigned u = __builtin_bit_cast(unsigned, f); return (u + 0x7fffu + ((u >> 16) & 1u)) >> 16; }
__device__ __forceinline__ unsigned pk2(float lo, float hi) { return f2bf(lo) | (f2bf(hi) << 16); }
__device__ __forceinline__ float bf2f(bf16 v) { return __builtin_bit_cast(float, (unsigned)v << 16); }
__device__ __forceinline__ float sigmoidf_(float v) { return 1.0f / (1.0f + expf(-v)); }
__device__ __forceinline__ float siluf_(float v) { return v / (1.0f + expf(-v)); }
__device__ __forceinline__ float wave_sum(float v) {
#pragma unroll
    for (int o = 1; o < 64; o <<= 1) v += __shfl_xor(v, o);
    return v;
}

struct Ptrs {
    const float *x, *c, *ctx, *c_ctx, *w_mod, *b_mod, *g_pre, *w_in, *lru_conv_w, *lru_conv_b, *lru_wa, *lru_ba, *lru_wx, *lru_bx, *lru_lambda,
        *pool_w, *pool_scale, *conf_dw, *conf_dw_b, *conf_ln_g, *conf_ln_b, *conf_pw, *w_out, *g_post;
};
struct Args { Ptrs p; float* out; unsigned char* ws; int ph_lo, ph_hi; };

__device__ __forceinline__ void row_info(int r, int& b, int& t, int& n, int& base) {
    if (r < MX) { b = r >> 11; t = r & 2047; n = SEQ; base = b << 11; }
    else { const int rc = r - MX; b = rc >> 8; t = rc & 255; n = CTXL; base = MX + (b << 8); }
}
__device__ __forceinline__ int chunk_row0(int b, int ck) { return ck < 4 ? MX + b * CTXL + 64 * ck : b * SEQ + 64 * (ck - 4); }

__device__ __forceinline__ void transpose_item(const float* W, int K, int N, bf16* WT, LAS float* scr, int item, int lane, float scale = 1.0f) {
    const int nblk = N / 32, kb = item / nblk, nb = item % nblk, k0 = 64 * kb, n0 = 32 * nb;
#pragma unroll 8
    for (int i = 0; i < 32; ++i) { const int kk = 2 * i + (lane >> 5); scr[kk * 33 + (lane & 31)] = W[(size_t)(k0 + kk) * N + n0 + (lane & 31)] * scale; }
    LDS_WAIT(); asm volatile("" ::: "memory");
    const int c = lane & 7;
#pragma unroll
    for (int j = 0; j < 4; ++j) { const int n = (lane >> 3) + 8 * j; const LAS float* s = scr + (8 * c) * 33 + n;
        v4u o; o.x = pk2(s[0 * 33], s[1 * 33]); o.y = pk2(s[2 * 33], s[3 * 33]); o.z = pk2(s[4 * 33], s[5 * 33]); o.w = pk2(s[6 * 33], s[7 * 33]);
        *(GAS v4u*)(WT + (size_t)(n0 + n) * K + k0 + 8 * c) = o; }
    LDS_WAIT(); asm volatile("" ::: "memory");
}

struct EpiF32 {
    static constexpr bool PERM = false, AFTER_DRAIN = false;
    float* O; int ldc;
    __device__ __forceinline__ void operator()(const pg8::f32x4 (&acc)[2][2][4][2], const pg8::Unit& u, int wr, int wc, int fr, int fq) const {
        const int row0 = u.pm * 256 + wr * 64 + fr, col0 = u.pn * 256 + wc * 32 + 4 * fq;
#pragma unroll
        for (int ai = 0; ai < 2; ++ai)
#pragma unroll
            for (int m = 0; m < 4; ++m) { float* rowp = O + (size_t)(row0 + ai * 128 + m * 16) * ldc + col0;
#pragma unroll
                for (int bj = 0; bj < 2; ++bj)
#pragma unroll
                    for (int n = 0; n < 2; ++n) *(pg8::f32x4*)(rowp + bj * 128 + n * 16) = acc[ai][bj][m][n]; }
    }
};

__device__ __forceinline__ void lru_ab(const Ptrs& P, int l, int d, const float* XC, int row, int c, float& a, float& bb) {
    const int h = c >> 6, j = c & 63;
    const float* wa = P.lru_wa + (size_t)((l * 2 + d) * 8 + h) * 4096 + j;
    const float* wx = P.lru_wx + (size_t)((l * 2 + d) * 8 + h) * 4096 + j;
    const float* xr = XC + (size_t)row * WL + h * 64;
    float rp = P.lru_ba[(l * 2 + d) * WL + c], ip = P.lru_bx[(l * 2 + d) * WL + c];
#pragma unroll 8
    for (int i = 0; i < 64; ++i) { const float xv = xr[i]; rp += xv * wa[i * 64]; ip += xv * wx[i * 64]; }
    const float r = sigmoidf_(rp), ig = sigmoidf_(ip);
    const float sp = log1pf(expf(-P.lru_lambda[(l * 2 + d) * WL + c]));
    const float la = -8.0f * r * sp;
    a = expf(la);
    bb = sqrtf(-expm1f(2.0f * la)) * (ig * xr[j]);
}


typedef short bf16x8 __attribute__((ext_vector_type(8)));
static_assert(133120 + 4096 <= MISC_OFF && 113664 + 32768 <= MISC_OFF, "LDS map");
constexpr int XCT_STRIDE = 1040;
constexpr int L_XCT = 0, L_GZ = 66560, L_CIN = 133120;
__device__ __forceinline__ float bflo(unsigned u) { return __builtin_bit_cast(float, u << 16); }
__device__ __forceinline__ float bfhi(unsigned u) { return __builtin_bit_cast(float, u & 0xffff0000u); }

__device__ __forceinline__ void strip_conv(LAS unsigned char* lds, const Ptrs& P, int l, const bf16* UX, int r0, int tpos0, int n, int tid) {
    const int o = tid & 63, tg = tid >> 6, c0 = 8 * o;
    float w[4][8], bias[8];
#pragma unroll
    for (int k = 0; k < 4; ++k) { const f32x4 a = *(const f32x4*)(P.lru_conv_w + (l * 4 + k) * WL + c0), b = *(const f32x4*)(P.lru_conv_w + (l * 4 + k) * WL + c0 + 4);
#pragma unroll
        for (int q = 0; q < 4; ++q) { w[k][q] = a[q]; w[k][4 + q] = b[q]; } }
    { const f32x4 a = *(const f32x4*)(P.lru_conv_b + l * WL + c0), b = *(const f32x4*)(P.lru_conv_b + l * WL + c0 + 4);
#pragma unroll
      for (int q = 0; q < 4; ++q) { bias[q] = a[q]; bias[4 + q] = b[q]; } }
    v4u v[11];
#pragma unroll
    for (int i = 0; i < 11; ++i) { const int tp = tpos0 + 8 * tg + i - 2;
        v[i] = (tp >= 0 && tp < n) ? *(const v4u*)(UX + (size_t)(r0 + 8 * tg + i - 2) * NIN + C_VL + c0) : (v4u){0u, 0u, 0u, 0u}; }
#pragma unroll
    for (int e = 0; e < 8; ++e) {
        float acc[8];
#pragma unroll
        for (int q = 0; q < 8; ++q) acc[q] = bias[q];
#pragma unroll
        for (int k = 0; k < 4; ++k) { const v4u x = v[e + k];
            acc[0] += w[k][0] * bflo(x.x); acc[1] += w[k][1] * bfhi(x.x); acc[2] += w[k][2] * bflo(x.y); acc[3] += w[k][3] * bfhi(x.y);
            acc[4] += w[k][4] * bflo(x.z); acc[5] += w[k][5] * bfhi(x.z); acc[6] += w[k][6] * bflo(x.w); acc[7] += w[k][7] * bfhi(x.w); }
        v4u ov; ov.x = pk2(acc[0], acc[1]); ov.y = pk2(acc[2], acc[3]); ov.z = pk2(acc[4], acc[5]); ov.w = pk2(acc[6], acc[7]);
        *(LAS v4u*)(lds + L_XCT + (8 * tg + e) * XCT_STRIDE + o * 16) = ov;
    }
}

struct GateW { bf16x8 Br[2][2], Bi[2][2]; float br[2], bi[2], kc[2]; };
__device__ __forceinline__ void gatew_load(GateW& w, int l, int h, int n, int fr, int fq, const bf16* GWS, const float* GB, const float* KC) {
    const int c = h * 64 + 16 * n + fr;
#pragma unroll
    for (int d = 0; d < 2; ++d) {
        const bf16* wr = GWS + ((size_t)(((l * 2 + d) * 2 + 0) * 8 + h) * 64 + 16 * n + fr) * 64 + fq * 8;
        const bf16* wi = GWS + ((size_t)(((l * 2 + d) * 2 + 1) * 8 + h) * 64 + 16 * n + fr) * 64 + fq * 8;
#pragma unroll
        for (int ks = 0; ks < 2; ++ks) { w.Br[d][ks] = *(const bf16x8*)(wr + ks * 32); w.Bi[d][ks] = *(const bf16x8*)(wi + ks * 32); }
        w.br[d] = GB[((l * 2 + d) * 2 + 0) * WL + c]; w.bi[d] = GB[((l * 2 + d) * 2 + 1) * WL + c]; w.kc[d] = KC[(l * 2 + d) * WL + c];
    }
}
template <int MODE>
__device__ __forceinline__ void lru_core(LAS unsigned char* lds, int l, int h, int lane, const bf16* GWS, const float* GB, const float* KC, float* sum_out) {
    const int fr = lane & 15, fq = lane >> 4;
    GateW wn; gatew_load(wn, l, h, 0, fr, fq, GWS, GB, KC);
    bf16x8 A[4][2];
#pragma unroll
    for (int m = 0; m < 4; ++m)
#pragma unroll
        for (int ks = 0; ks < 2; ++ks) { const int tau = (fr >> 2) * 16 + m * 4 + (fr & 3);
            A[m][ks] = *(const LAS bf16x8*)(lds + L_XCT + tau * XCT_STRIDE + (h * 64 + ks * 32 + fq * 8) * 2); }
#pragma unroll 1
    for (int n = 0; n < 4; ++n) {
        const int c = h * 64 + 16 * n + fr;
        const GateW w = wn;
        if (n < 3) gatew_load(wn, l, h, n + 1, fr, fq, GWS, GB, KC);
        float xv[16], y[16];
#pragma unroll
        for (int e = 0; e < 16; ++e) { xv[e] = bf2f(*(const LAS bf16*)(lds + L_XCT + (fq * 16 + e) * XCT_STRIDE + c * 2)); y[e] = 0.f; }
#pragma unroll
        for (int d = 0; d < 2; ++d) {
            f32x4 ar[4], ai[4];
#pragma unroll
            for (int m = 0; m < 4; ++m) { ar[m] = (f32x4){w.br[d], w.br[d], w.br[d], w.br[d]}; ai[m] = (f32x4){w.bi[d], w.bi[d], w.bi[d], w.bi[d]}; }
#pragma unroll
            for (int m = 0; m < 4; ++m)
#pragma unroll
                for (int ks = 0; ks < 2; ++ks) { ar[m] = __builtin_amdgcn_mfma_f32_16x16x32_bf16(A[m][ks], w.Br[d][ks], ar[m], 0, 0, 0); ai[m] = __builtin_amdgcn_mfma_f32_16x16x32_bf16(A[m][ks], w.Bi[d][ks], ai[m], 0, 0, 0); }
            const float kc = w.kc[d];
            float av[16], bv[16];
#pragma unroll
            for (int e = 0; e < 16; ++e) {
                const float er = __builtin_amdgcn_exp2f(ar[e >> 2][e & 3]), ei = __builtin_amdgcn_exp2f(ai[e >> 2][e & 3]);
                const float r = __builtin_amdgcn_rcpf(1.0f + er), ig = __builtin_amdgcn_rcpf(1.0f + ei);
                const float a = __builtin_amdgcn_exp2f(kc * r);
                av[e] = a; bv[e] = __builtin_amdgcn_sqrtf(fmaxf(1.0f - a * a, 0.0f)) * (ig * xv[e]);
            }
            float Pq = 1.f, Hq = 0.f;
#pragma unroll
            for (int s = 0; s < 16; ++s) { const int e = d ? 15 - s : s; Hq = av[e] * Hq + bv[e]; Pq *= av[e]; bv[e] = Hq; av[e] = Pq; }
            float Pg[4], Hg[4];
#pragma unroll
            for (int q = 0; q < 4; ++q) { Pg[q] = __shfl(Pq, fr + 16 * q); Hg[q] = __shfl(Hq, fr + 16 * q); }
            if constexpr (MODE == 0) {
                float At = 1.f, Ht = 0.f;
#pragma unroll
                for (int s = 0; s < 4; ++s) { const int q = d ? 3 - s : s; Ht = Pg[q] * Ht + Hg[q]; At *= Pg[q]; }
                if (fq == 0) { float2 o2; o2.x = At; o2.y = Ht; *(float2*)(sum_out + ((size_t)d * WL + c) * 2) = o2; }
            } else {
                float cq = *(const LAS float*)(lds + L_CIN + (d * WL + c) * 4);
#pragma unroll
                for (int s = 0; s < 4; ++s) { const int q = d ? 3 - s : s; const bool before = d ? (q > fq) : (q < fq); if (before) cq = Pg[q] * cq + Hg[q]; }
#pragma unroll
                for (int e = 0; e < 16; ++e) y[e] += bv[e] + av[e] * cq;
            }
        }
        if constexpr (MODE == 1) {
#pragma unroll
            for (int e = 0; e < 16; ++e) { LAS bf16* gp = (LAS bf16*)(lds + L_GZ + (fq * 16 + e) * XCT_STRIDE + c * 2); const float g = bf2f(*gp);
                *gp = (bf16)f2bf(y[e] * g * __builtin_amdgcn_rcpf(1.0f + __builtin_amdgcn_exp2f(-LOG2E * g))); }
        }
    }
}

constexpr int T_STRIDE = 528;
constexpr int L_DT = 0, L_ZP = 33792, L_VP = 67584;
constexpr int L_ZC = 0, L_CT = 48128, L_CLT = 0, L_CG = 113664;
__device__ __forceinline__ float silu_fast(float g) { return g * __builtin_amdgcn_rcpf(1.0f + __builtin_amdgcn_exp2f(-LOG2E * g)); }
__device__ __forceinline__ float sigm_fast(float g) { return __builtin_amdgcn_rcpf(1.0f + __builtin_amdgcn_exp2f(-LOG2E * g)); }

template <int NCH> __device__ __forceinline__ void tile_out(LAS unsigned char* lds, int off, int stride, bf16* Zg, int r0, int col0, int tid) {
    constexpr int RPI = NT / NCH;
    const int ch = tid % NCH, rr = tid / NCH;
#pragma unroll
    for (int it = 0; it < 64 / RPI; ++it) { const int row = it * RPI + rr;
        *(v4u*)(Zg + (size_t)(r0 + row) * DM + col0 + ch * 8) = *(const LAS v4u*)(lds + off + row * stride + ch * 16); }
}

__device__ __forceinline__ void pool_part(LAS unsigned char* lds, const Ptrs& P, int l, const bf16* UX, const bf16* PWt, bf16* Zg, int r0, int tpos0, int n, int tid, int wave, int lane) {
    asm volatile("" : "+v"(tid)); lane = tid & 63; wave = __builtin_amdgcn_readfirstlane(tid >> 6);
    const int fr = lane & 15, fq = lane >> 4, g = wave >> 1, nh = wave & 1;
    {
        v4u vp[5], gp[4];
#pragma unroll
        for (int it = 0; it < 5; ++it) { const int id = it * NT + tid, rho = id >> 5, ch = id & 31, tp = tpos0 + rho - 8;
            vp[it] = (tp >= 0 && tp < n) ? *(const v4u*)(UX + (size_t)(r0 + rho - 8) * NIN + C_VP + ch * 8) : (v4u){0u, 0u, 0u, 0u}; }
#pragma unroll
        for (int it = 0; it < 4; ++it) gp[it] = *(const v4u*)(UX + (size_t)(r0 + it * 16 + (tid >> 5)) * NIN + C_GP + (tid & 31) * 8);
#pragma unroll
        for (int it = 0; it < 5; ++it) { const int id = it * NT + tid; *(LAS v4u*)(lds + L_VP + (id >> 5) * 512 + (id & 31) * 16) = vp[it]; }
#pragma unroll
        for (int it = 0; it < 4; ++it) *(LAS v4u*)(lds + L_ZP + (it * 16 + (tid >> 5)) * T_STRIDE + (tid & 31) * 16) = gp[it];
    }
    bf16x8 Bw[2][2];
#pragma unroll
    for (int ni = 0; ni < 2; ++ni) { const bf16* wp = PWt + ((size_t)((l * 4 + g) * 64 + 16 * (2 * nh + ni) + fr)) * 64 + fq * 8; Bw[ni][0] = *(const bf16x8*)(wp); Bw[ni][1] = *(const bf16x8*)(wp + 32); }
    __syncthreads();
    {
        const int o = tid & 31, gg = o >> 3, w2 = 1 << gg;
#pragma unroll
        for (int it = 0; it < 4; ++it) { const int tok = it * 16 + (tid >> 5), t = tpos0 + tok;
            int lo = t - w2; lo = lo < 0 ? 0 : lo; int hi = t + w2; hi = hi > n ? n : hi;
            float sum[8];
#pragma unroll
            for (int q = 0; q < 8; ++q) sum[q] = 0.f;
#pragma unroll
            for (int k = 0; k < 16; ++k) { if (k < 2 * w2) { const v4u x = *(const LAS v4u*)(lds + L_VP + (tok + 8 - w2 + k) * 512 + o * 16);
                sum[0] += bflo(x.x); sum[1] += bfhi(x.x); sum[2] += bflo(x.y); sum[3] += bfhi(x.y); sum[4] += bflo(x.z); sum[5] += bfhi(x.z); sum[6] += bflo(x.w); sum[7] += bfhi(x.w); } }
            const v4u xc = *(const LAS v4u*)(lds + L_VP + (tok + 8) * 512 + o * 16); const float inv = 1.0f / (float)(hi - lo);
            v4u ov; ov.x = pk2(sum[0] * inv - bflo(xc.x), sum[1] * inv - bfhi(xc.x)); ov.y = pk2(sum[2] * inv - bflo(xc.y), sum[3] * inv - bfhi(xc.y));
            ov.z = pk2(sum[4] * inv - bflo(xc.z), sum[5] * inv - bfhi(xc.z)); ov.w = pk2(sum[6] * inv - bflo(xc.w), sum[7] * inv - bfhi(xc.w));
            *(LAS v4u*)(lds + L_DT + tok * T_STRIDE + o * 16) = ov; }
    }
    __syncthreads();
    {
        bf16x8 A[4][2];
#pragma unroll
        for (int m = 0; m < 4; ++m)
#pragma unroll
            for (int ks = 0; ks < 2; ++ks) A[m][ks] = *(const LAS bf16x8*)(lds + L_DT + (16 * m + fr) * T_STRIDE + (g * 64 + ks * 32 + fq * 8) * 2);
#pragma unroll
        for (int ni = 0; ni < 2; ++ni) { const int nn = 2 * nh + ni, cc = g * 64 + 16 * nn + fr;
            const float ps = P.pool_scale[l * WP + cc];
#pragma unroll
            for (int m = 0; m < 4; ++m) { f32x4 acc = (f32x4){0.f, 0.f, 0.f, 0.f};
                acc = __builtin_amdgcn_mfma_f32_16x16x32_bf16(A[m][0], Bw[ni][0], acc, 0, 0, 0); acc = __builtin_amdgcn_mfma_f32_16x16x32_bf16(A[m][1], Bw[ni][1], acc, 0, 0, 0);
#pragma unroll
                for (int j = 0; j < 4; ++j) { const int tok = 16 * m + 4 * fq + j; LAS bf16* gp = (LAS bf16*)(lds + L_ZP + tok * T_STRIDE + cc * 2); const float gt = bf2f(*gp);
                    *gp = (bf16)f2bf(acc[j] * ps * silu_fast(gt)); } }
        }
    }
    __syncthreads();
    tile_out<32>(lds, L_ZP, T_STRIDE, Zg, r0, 512, tid);
    __syncthreads();
}

__device__ __forceinline__ void conf_part(LAS unsigned char* lds, const Ptrs& P, int l, const bf16* UX, const bf16* CPWt, bf16* Zg, int r0, int tpos0, int n, int tid, int wave, int lane) {
    asm volatile("" : "+v"(tid)); lane = tid & 63; wave = __builtin_amdgcn_readfirstlane(tid >> 6);
#pragma unroll
    for (int it = 0; it < 4; ++it) *(LAS v4u*)(lds + L_CG + (it * 16 + (tid >> 5)) * 512 + (tid & 31) * 16) = *(const v4u*)(UX + (size_t)(r0 + it * 16 + (tid >> 5)) * NIN + C_GC + (tid & 31) * 8);
    {
        const int o = tid & 31, rg = tid >> 5, c0 = 8 * o;
#pragma unroll
        for (int it = 0; it < 6; ++it) { const int rho = it * 16 + rg; if (rho < 94) { const int tp = tpos0 + rho - 15; v4u ov = (v4u){0u, 0u, 0u, 0u};
            if (tp >= 0 && tp < n) { const bf16* rp = UX + (size_t)(r0 + rho - 15) * NIN; const v4u a = *(const v4u*)(rp + C_VC + c0), b = *(const v4u*)(rp + C_GG + c0);
                ov.x = pk2(bflo(a.x) * sigm_fast(bflo(b.x)), bfhi(a.x) * sigm_fast(bfhi(b.x))); ov.y = pk2(bflo(a.y) * sigm_fast(bflo(b.y)), bfhi(a.y) * sigm_fast(bfhi(b.y)));
                ov.z = pk2(bflo(a.z) * sigm_fast(bflo(b.z)), bfhi(a.z) * sigm_fast(bfhi(b.z))); ov.w = pk2(bflo(a.w) * sigm_fast(bflo(b.w)), bfhi(a.w) * sigm_fast(bfhi(b.w))); }
            *(LAS v4u*)(lds + L_ZC + rho * 512 + o * 16) = ov; } }
    }
    __syncthreads();
    bf16x8 Bw[8][2];
    {   const int fr = lane & 15, fq = lane >> 4; const bf16* wp0 = CPWt + ((size_t)(l * 256 + 16 * (2 * wave) + fr)) * 256 + fq * 8;
#pragma unroll
        for (int ks = 0; ks < 8; ++ks) { Bw[ks][0] = *(const bf16x8*)(wp0 + ks * 32); Bw[ks][1] = *(const bf16x8*)(wp0 + 16 * 256 + ks * 32); } }
    {
        const int c = tid & 255, hf = tid >> 8;
        float w[31];
#pragma unroll
        for (int k = 0; k < 31; ++k) w[k] = P.conf_dw[(size_t)(l * 31 + k) * WC + c];
        const float bias = P.conf_dw_b[l * WC + c];
#pragma unroll 1
        for (int sh = 0; sh < 2; ++sh) { const int t0 = 32 * hf + 16 * sh; float acc[16];
#pragma unroll
            for (int oo = 0; oo < 16; ++oo) acc[oo] = bias;
#pragma unroll
            for (int rr = 0; rr < 46; ++rr) { const float val = bf2f(*(const LAS bf16*)(lds + L_ZC + (t0 + rr) * 512 + c * 2));
#pragma unroll
                for (int oo = 0; oo < 16; ++oo) { if (rr - oo >= 0 && rr - oo <= 30) acc[oo] += val * w[rr - oo]; } }
#pragma unroll
            for (int oo = 0; oo < 16; ++oo) *(LAS float*)(lds + L_CT + (t0 + oo) * 1024 + c * 4) = acc[oo]; }
    }
    __syncthreads();
    {
        const f32x4 lg = *(const f32x4*)(P.conf_ln_g + l * WC + 4 * lane), lb = *(const f32x4*)(P.conf_ln_b + l * WC + 4 * lane);
#pragma unroll
        for (int i = 0; i < 8; ++i) { const int tok = 8 * wave + i; const f32x4 v = *(const LAS f32x4*)(lds + L_CT + tok * 1024 + lane * 16);
            const float mu = wave_sum((v[0] + v[1]) + (v[2] + v[3])) * (1.0f / 256.0f); const f32x4 dv = v - mu;
            const float var = wave_sum((dv[0] * dv[0] + dv[1] * dv[1]) + (dv[2] * dv[2] + dv[3] * dv[3])) * (1.0f / 256.0f);
            const float rstd = 1.0f / sqrtf(var + EPS_LN); float o4[4];
#pragma unroll
            for (int e = 0; e < 4; ++e) o4[e] = silu_fast(dv[e] * rstd * lg[e] + lb[e]);
            v2u ov; ov.x = pk2(o4[0], o4[1]); ov.y = pk2(o4[2], o4[3]);
            *(LAS v2u*)(lds + L_CLT + tok * T_STRIDE + lane * 8) = ov; }
    }
    __syncthreads();
    {
        const int fr = lane & 15, fq = lane >> 4;
        f32x4 acc[4][2];
#pragma unroll
        for (int m = 0; m < 4; ++m) { acc[m][0] = (f32x4){0.f, 0.f, 0.f, 0.f}; acc[m][1] = (f32x4){0.f, 0.f, 0.f, 0.f}; }
#pragma unroll
        for (int ks = 0; ks < 8; ++ks) {
#pragma unroll
            for (int m = 0; m < 4; ++m) { const bf16x8 A = *(const LAS bf16x8*)(lds + L_CLT + (16 * m + fr) * T_STRIDE + (ks * 32 + fq * 8) * 2);
                acc[m][0] = __builtin_amdgcn_mfma_f32_16x16x32_bf16(A, Bw[ks][0], acc[m][0], 0, 0, 0); acc[m][1] = __builtin_amdgcn_mfma_f32_16x16x32_bf16(A, Bw[ks][1], acc[m][1], 0, 0, 0); } }
#pragma unroll
        for (int ni = 0; ni < 2; ++ni) { const int ee = 16 * (2 * wave + ni) + fr;
#pragma unroll
            for (int m = 0; m < 4; ++m)
#pragma unroll
                for (int j = 0; j < 4; ++j) { const int tok = 16 * m + 4 * fq + j; LAS bf16* gp = (LAS bf16*)(lds + L_CG + tok * 512 + ee * 2); const float gt = bf2f(*gp);
                    *gp = (bf16)f2bf(acc[m][ni][j] * silu_fast(gt)); } }
    }
    __syncthreads();
    tile_out<32>(lds, L_CG, 512, Zg, r0, 768, tid);
    __syncthreads();
}

__device__ __forceinline__ void mixer_strip(LAS unsigned char* lds, const Ptrs& P, int l, int b, int ck, const bf16* UX, bf16* Zg, const bf16* GWS, const float* GB, const float* KC, const float* SUM,
                                            const bf16* PWt, const bf16* CPWt, int tid, int wave, int lane) {
    const int r0 = chunk_row0(b, ck), tpos0 = ck < 4 ? 64 * ck : 64 * (ck - 4), n = ck < 4 ? CTXL : SEQ;
    asm volatile("" : "+v"(tid)); lane = tid & 63; wave = __builtin_amdgcn_readfirstlane(tid >> 6);
    strip_conv(lds, P, l, UX, r0, tpos0, n, tid);
    {
        const int o = tid & 63, tg = tid >> 6;
#pragma unroll
        for (int i = 0; i < 8; ++i) { const int tok = 8 * tg + i; *(LAS v4u*)(lds + L_GZ + tok * XCT_STRIDE + o * 16) = *(const v4u*)(UX + (size_t)(r0 + tok) * NIN + C_GL + 8 * o); }
    }
    {
        const int c = tid; const float* sb = SUM + (size_t)b * NCHUNK * 2 * WL * 2 + (size_t)c * 2;
        {   float2 sv[NCHUNK];
#pragma unroll
            for (int q = 0; q < NCHUNK; ++q) sv[q] = *(const float2*)(sb + (size_t)(q * 2 + 0) * WL * 2);
            float h = 0.f;
#pragma unroll
            for (int q = 0; q < NCHUNK; ++q) { const bool sel = q < ck; h = sel ? sv[q].x * h + sv[q].y : h; }
            *(LAS float*)(lds + L_CIN + c * 4) = h; }
        {   float2 sv[NCHUNK];
#pragma unroll
            for (int q = 0; q < NCHUNK; ++q) sv[q] = *(const float2*)(sb + (size_t)(q * 2 + 1) * WL * 2);
            float h = 0.f;
#pragma unroll
            for (int s2 = 0; s2 < NCHUNK; ++s2) { const int q = s2 < 4 ? 3 - s2 : NCHUNK + 3 - s2;
                const bool sel = ck < 4 ? (q < 4 && q > ck) : (q < 4 || q > ck); h = sel ? sv[q].x * h + sv[q].y : h; }
            *(LAS float*)(lds + L_CIN + (WL + c) * 4) = h; }
    }
    __syncthreads();
    asm volatile("" : "+v"(tid)); lane = tid & 63; wave = __builtin_amdgcn_readfirstlane(tid >> 6);
#ifndef NO_LRU
    lru_core<1>(lds, l, wave, lane, GWS, GB, KC, nullptr);
#endif
    __syncthreads();
    tile_out<64>(lds, L_GZ, XCT_STRIDE, Zg, r0, 0, tid);
    __syncthreads();
#ifndef NO_POOL
    pool_part(lds, P, l, UX, PWt, Zg, r0, tpos0, n, tid, wave, lane);
#endif
#ifndef NO_CONF
    conf_part(lds, P, l, UX, CPWt, Zg, r0, tpos0, n, tid, wave, lane);
#endif
}

enum { K_PREP = 100, K_EMBED = 101 };
typedef const __attribute__((address_space(4))) Args* KArgs;
template <int KIND> __device__ __forceinline__ void run_phase(KArgs ap_in, LAS unsigned char* lds, const int l) {
    KArgs ap = ap_in; asm volatile("" : "+s"(ap));
    const Args args = *(const Args*)ap;
    const Ptrs& P = args.p;
    int tid_ = threadIdx.x; asm volatile("" : "+v"(tid_));
    const int tid = tid_, lane = tid & 63, wave = __builtin_amdgcn_readfirstlane(tid >> 6);
    const int G = gridDim.x, bx = blockIdx.x;
    const int gtid = bx * NT + tid, NTH = G * NT;
    const int gw = bx * 8 + wave, NGW = G * 8;
    unsigned char* ws = args.ws;
    float* MOD = (float*)(ws + WS_MOD);
    bf16* GW = (bf16*)(ws + WS_GW); bf16* PW = (bf16*)(ws + WS_PW); bf16* CPW = (bf16*)(ws + WS_CPW);
    bf16* WIN = (bf16*)(ws + WS_WIN); bf16* WOUT = (bf16*)(ws + WS_WOUT);
    bf16* HX = (bf16*)(ws + WS_HX); bf16* Z = HX; bf16* UX = (bf16*)(ws + WS_UX);
    float* XC = (float*)(ws + WS_R2); float* Y = (float*)(ws + WS_R2 + 36 * MiB);
    float* Dp = (float*)(ws + WS_R2); float* ZC = (float*)(ws + WS_R2 + 18 * MiB); float* CL = (float*)(ws + WS_R2 + 36 * MiB);
    float* O = (float*)(ws + WS_R2);
    float* CTXR = (float*)(ws + WS_CTXR); float* SUM = (float*)(ws + WS_SUM);
    float* out = args.out;

    {
        if constexpr (KIND == K_PREP) {
            LAS float* scr = (LAS float*)(lds + wave * 16384);
            constexpr int I_IN = 16 * 72, I_OUT = 16 * 32, I_CPW = 4 * 8, I_S = 2;
            constexpr int N_IN = 4 * I_IN, N_OUT = 4 * I_OUT, N_CPW = 4 * I_CPW, N_PW = 16 * I_S, N_GW = 64 * I_S;
            constexpr int NITEMS = N_IN + N_OUT + N_CPW + N_PW + 2 * N_GW;
            for (int it = gw; it < NITEMS; it += NGW) {
                int r = it;
                if (r < N_IN) { const int l = r / I_IN; transpose_item(P.w_in + (size_t)l * DM * NIN, DM, NIN, WIN + (size_t)l * NIN * DM, scr, r % I_IN, lane); continue; } r -= N_IN;
                if (r < N_OUT) { const int l = r / I_OUT; transpose_item(P.w_out + (size_t)l * DM * DM, DM, DM, WOUT + (size_t)l * DM * DM, scr, r % I_OUT, lane); continue; } r -= N_OUT;
                if (r < N_CPW) { const int l = r / I_CPW; transpose_item(P.conf_pw + (size_t)l * 65536, 256, 256, CPW + (size_t)l * 65536, scr, r % I_CPW, lane); continue; } r -= N_CPW;
                if (r < N_PW) { const int m = r / I_S; transpose_item(P.pool_w + (size_t)m * 4096, 64, 64, PW + (size_t)m * 4096, scr, r % I_S, lane); continue; } r -= N_PW;
                if (r < N_GW) { const int m = r / I_S; const int ld = m >> 3, h = m & 7;
                    transpose_item(P.lru_wa + (size_t)m * 4096, 64, 64, GW + (size_t)((ld * 2 + 0) * 8 + h) * 4096, scr, r % I_S, lane, -LOG2E); continue; } r -= N_GW;
                { const int m = r / I_S; const int ld = m >> 3, h = m & 7;
                    transpose_item(P.lru_wx + (size_t)m * 4096, 64, 64, GW + (size_t)((ld * 2 + 1) * 8 + h) * 4096, scr, r % I_S, lane, -LOG2E); }
            }
            for (int i = gtid; i < 4 * 2 * 2 * WL; i += NTH) { const int c = i & 511, gate = (i >> 9) & 1, ld = i >> 10;
                ((float*)(ws + WS_GB))[i] = -LOG2E * (gate ? P.lru_bx[ld * WL + c] : P.lru_ba[ld * WL + c]); }
            for (int i = gtid; i < 4 * 2 * WL; i += NTH) ((float*)(ws + WS_KC))[i] = -8.0f * LOG2E * log1pf(expf(-P.lru_lambda[i]));
            __syncthreads();
            LAS float* S = (LAS float*)lds;
            LAS float* RED = (LAS float*)(lds + 40960);
            for (int i = tid; i < 9 * 1024; i += NT) { const int r = i >> 10, k = i & 1023; const float v = r < 8 ? P.c[r * 1024 + k] : P.c_ctx[k]; S[i] = siluf_(v); }
            __syncthreads();
            for (int it = bx; it < 4 * 48; it += G) {
                const int l = it / 48, j0 = (it % 48) * 64, j = tid & 63, ks = tid >> 6;
                float acc[9];
#pragma unroll
                for (int r = 0; r < 9; ++r) acc[r] = 0.f;
                const float* wp = P.w_mod + (size_t)l * 1024 * 3072 + (size_t)(ks * 128) * 3072 + j0 + j;
#pragma unroll 4
                for (int k = 0; k < 128; ++k) { const float w = wp[(size_t)k * 3072];
#pragma unroll
                    for (int r = 0; r < 9; ++r) acc[r] += S[r * 1024 + ks * 128 + k] * w; }
#pragma unroll
                for (int r = 0; r < 9; ++r) RED[(ks * 9 + r) * 64 + j] = acc[r];
                __syncthreads();
                for (int i = tid; i < 9 * 64; i += NT) { const int r = i >> 6, jj = i & 63; float s = P.b_mod[l * 3072 + j0 + jj];
#pragma unroll
                    for (int q = 0; q < 8; ++q) s += RED[(q * 9 + r) * 64 + jj];
                    MOD[(size_t)(l * 9 + r) * 3072 + j0 + jj] = s; }
                __syncthreads();
            }
        } else if constexpr (KIND == K_EMBED) {
            for (int r = gw; r < MT; r += NGW) {
                int b, t, n, base; row_info(r, b, t, n, base);
                const bool isx = r < MX; const int mr = isx ? b : 8;
                const float* src = isx ? P.x + (size_t)r * DM : P.ctx + (size_t)(r - MX) * DM;
                float* dst = isx ? out + (size_t)r * DM : CTXR + (size_t)(r - MX) * DM;
                f32x4 v[4]; float ss = 0.f;
#pragma unroll
                for (int j = 0; j < 4; ++j) {
                    v[j] = *(const f32x4*)(src + 256 * j + 4 * lane);
                    if (isx) {
                        const float p = (j < 2) ? (float)(t >> 6) : (float)(t & 63);
#pragma unroll
                        for (int e = 0; e < 4; ++e) { const int i = 4 * lane + e; const float om = 1.0f / powf(10000.0f, (float)i / 256.0f); const float ang = p * om;
                            v[j][e] += (j & 1) ? cosf(ang) : sinf(ang); }
                    }
                    *(f32x4*)(dst + 256 * j + 4 * lane) = v[j];
                    ss += (v[j][0] * v[j][0] + v[j][1] * v[j][1]) + (v[j][2] * v[j][2] + v[j][3] * v[j][3]);
                }
                const float rstd = 1.0f / sqrtf(wave_sum(ss) * (1.0f / DM) + EPS_RMS);
                const float* sh = MOD + (size_t)(0 * 9 + mr) * 3072; const float* sc = sh + 1024;
#pragma unroll
                for (int j = 0; j < 4; ++j) { const int d0 = 256 * j + 4 * lane; float h[4];
#pragma unroll
                    for (int e = 0; e < 4; ++e) h[e] = v[j][e] * rstd * P.g_pre[d0 + e] * (1.0f + sc[d0 + e]) + sh[d0 + e];
                    uint2 w; w.x = pk2(h[0], h[1]); w.y = pk2(h[2], h[3]); *(uint2*)(HX + (size_t)r * DM + d0) = w; }
            }
        } else {
            constexpr int k = KIND;
            if constexpr (k == 0) {
                pg8::Gemm g{HX, WIN + (size_t)l * NIN * DM, MT, NIN, DM}; pg8::StaticOrder S; S.init(MT, NIN, G, bx);
                pg8::EpiBf16<0> E{UX, NIN, nullptr, 0, 0, 1.f};
                pg8::gemm_phase<pg8::EpiBf16<0>, pg8::StaticOrder, true, true>(lds, g, S, E);
            } else if constexpr (k == 2) {
                for (int sidx = bx; sidx < NB * NCHUNK; sidx += G) { const int b = sidx / NCHUNK, ck = sidx % NCHUNK;
                    const int r0 = chunk_row0(b, ck), tpos0 = ck < 4 ? 64 * ck : 64 * (ck - 4), n = ck < 4 ? CTXL : SEQ;
                    strip_conv(lds, P, l, UX, r0, tpos0, n, tid);
                    __syncthreads();
                    lru_core<0>(lds, l, wave, lane, GW, (const float*)(ws + WS_GB), (const float*)(ws + WS_KC), SUM + (size_t)sidx * 2 * WL * 2);
                    __syncthreads();
                }
            } else if constexpr (k == 3) {
                for (int sidx = bx; sidx < NB * NCHUNK; sidx += G) { const int b = sidx / NCHUNK, ck = sidx % NCHUNK;
                    if (l == DEPTH - 1 && ck < 4) continue;
                    mixer_strip(lds, P, l, b, ck, UX, Z, GW, (const float*)(ws + WS_GB), (const float*)(ws + WS_KC), SUM, PW, CPW, tid, wave, lane);
                }
            } else if constexpr (k == 7) {
                pg8::Gemm g{Z, WOUT + (size_t)l * DM * DM, MT, DM, DM}; pg8::StaticOrder S; S.init(MT, DM, G, bx);
                EpiF32 E{O, DM};
                pg8::gemm_phase<EpiF32, pg8::StaticOrder, true, true>(lds, g, S, E);
            } else {
                for (int r = gw; r < MT; r += NGW) {
                    const bool isx = r < MX; if (!isx && l == DEPTH - 1) continue;
                    const int b = isx ? (r >> 11) : ((r - MX) >> 8); const int mr = isx ? b : 8;
                    float* xr = isx ? out + (size_t)r * DM : CTXR + (size_t)(r - MX) * DM;
                    const float* orow = O + (size_t)r * DM; const float* gt = MOD + (size_t)(l * 9 + mr) * 3072 + 2048;
                    f32x4 o[4]; float ss = 0.f;
#pragma unroll
                    for (int j = 0; j < 4; ++j) { o[j] = *(const f32x4*)(orow + 256 * j + 4 * lane); ss += (o[j][0] * o[j][0] + o[j][1] * o[j][1]) + (o[j][2] * o[j][2] + o[j][3] * o[j][3]); }
                    const float rstd = 1.0f / sqrtf(wave_sum(ss) * (1.0f / DM) + EPS_RMS);
                    f32x4 v[4]; float s2 = 0.f;
#pragma unroll
                    for (int j = 0; j < 4; ++j) { const int d0 = 256 * j + 4 * lane; v[j] = *(const f32x4*)(xr + d0);
#pragma unroll
                        for (int e = 0; e < 4; ++e) v[j][e] += gt[d0 + e] * (o[j][e] * rstd * P.g_post[l * DM + d0 + e]);
                        *(f32x4*)(xr + d0) = v[j];
                        s2 += (v[j][0] * v[j][0] + v[j][1] * v[j][1]) + (v[j][2] * v[j][2] + v[j][3] * v[j][3]); }
                    if (l < DEPTH - 1) {
                        const float rs2 = 1.0f / sqrtf(wave_sum(s2) * (1.0f / DM) + EPS_RMS);
                        const float* sh = MOD + (size_t)((l + 1) * 9 + mr) * 3072; const float* sc = sh + 1024;
#pragma unroll
                        for (int j = 0; j < 4; ++j) { const int d0 = 256 * j + 4 * lane; float h[4];
#pragma unroll
                            for (int e = 0; e < 4; ++e) h[e] = v[j][e] * rs2 * P.g_pre[(l + 1) * DM + d0 + e] * (1.0f + sc[d0 + e]) + sh[d0 + e];
                            uint2 w; w.x = pk2(h[0], h[1]); w.y = pk2(h[2], h[3]); *(uint2*)(HX + (size_t)r * DM + d0) = w; }
                    }
                }
            }
        }
    }
}


#define XB_TMO      128
#define XB_XCNT(j)  (256  + 64 * (j))
#define XB_XSUB(j)  (1280 + 64 * (j))
#define XB_XGEN(j)  (2304 + 64 * (j))
#define XB_TOP      3328
#define XB_TOPGEN   3392
#define XCD_BAR_WORDS 3456
#define XB_SPIN_CAP (1u << 18)
constexpr int CW_BAR = 4096;
__device__ __forceinline__ unsigned xb_ld(unsigned* p)              { return __hip_atomic_load(p, __ATOMIC_RELAXED, __HIP_MEMORY_SCOPE_AGENT); }
__device__ __forceinline__ unsigned xb_add(unsigned* p, unsigned v) { return __hip_atomic_fetch_add(p, v, __ATOMIC_RELAXED, __HIP_MEMORY_SCOPE_AGENT); }
__device__ __forceinline__ unsigned xb_xcc_id() { return (unsigned)__builtin_amdgcn_s_getreg((3 << 11) | 20) & 0xFu; }
#define XB_SPIN(cond, bar) do { unsigned _sp = 0; while (cond) { __builtin_amdgcn_s_sleep(1); \
    if ((++_sp & 255u) == 0u) { if (xb_ld(&(bar)[XB_TMO])) break; if (_sp > XB_SPIN_CAP) { atomicAdd(&(bar)[XB_TMO], 1u); break; } } } } while (0)
struct XcdBarrier { unsigned* bar; unsigned x; volatile LAS unsigned* st; };
__device__ __forceinline__ XcdBarrier xcd_barrier_post(unsigned* bar, volatile LAS unsigned* st) {
    XcdBarrier b; b.bar = bar; b.x = xb_xcc_id(); b.st = st;
    if (threadIdx.x == 0) (void)xb_add(&bar[XB_XCNT(b.x)], 1u);
    return b;
}
__device__ __forceinline__ void xcd_barrier_complete(unsigned* bar, unsigned x, unsigned& nloc, unsigned& nx) {
    const unsigned G = gridDim.x * gridDim.y * gridDim.z;
    unsigned sum, cnt, mine, sp = 0u;
    for (;;) {
        sum = 0u; cnt = 0u; mine = 0u;
#pragma unroll
        for (unsigned j = 0; j < 16; ++j) { const unsigned c = xb_ld(&bar[XB_XCNT(j)]); sum += c; cnt += (c > 0u) ? 1u : 0u; mine = (j == x) ? c : mine; }
        if (sum == G) break;
        __builtin_amdgcn_s_sleep(1);
        if ((++sp & 255u) == 0u) { if (xb_ld(&bar[XB_TMO])) break; if (sp > XB_SPIN_CAP) { atomicAdd(&bar[XB_TMO], 1u); break; } }
    }
    nloc = mine > 0u ? mine : 1u; nx = cnt > 0u ? cnt : 1u;
}
__device__ __forceinline__ void xcd_barrier(const XcdBarrier& b) {
    asm volatile("s_waitcnt vmcnt(0)" ::: "memory");
    __syncthreads();
    if (threadIdx.x == 0) {
        unsigned* bar = b.bar;
        __builtin_amdgcn_s_waitcnt(0);
        unsigned nloc = b.st[0], nx = b.st[1];
        if (nloc == 0u) { xcd_barrier_complete(bar, b.x, nloc, nx); b.st[0] = nloc; b.st[1] = nx; }
        const unsigned old = xb_add(&bar[XB_XSUB(b.x)], 1u);
        const unsigned gen = old / nloc;
        if (old + 1u == (gen + 1u) * nloc) {
            __builtin_amdgcn_fence(__ATOMIC_RELEASE, "agent");
            asm volatile("s_waitcnt vmcnt(0)" ::: "memory");
            const unsigned og = xb_add(&bar[XB_TOP], 1u);
            const unsigned tg = og / nx;
            if (og + 1u == (tg + 1u) * nx) xb_add(&bar[XB_TOPGEN], 1u);
            else XB_SPIN(xb_ld(&bar[XB_TOPGEN]) == tg, bar);
            __builtin_amdgcn_fence(__ATOMIC_ACQUIRE, "agent");
            xb_add(&bar[XB_XGEN(b.x)], 1u);
            asm volatile("s_waitcnt vmcnt(0)" ::: "memory");
        } else {
            XB_SPIN(xb_ld(&bar[XB_XGEN(b.x)]) == gen, bar);
            __builtin_amdgcn_fence(__ATOMIC_ACQUIRE, "agent");
            asm volatile("s_waitcnt vmcnt(0)" ::: "memory");
        }
    }
    __syncthreads();
}

template <int KIND> __global__ void __launch_bounds__(NT, 2) fwd(Args args) {
    extern __shared__ __attribute__((aligned(16))) unsigned char lds_raw[];
    KArgs ap = (KArgs)__builtin_amdgcn_kernarg_segment_ptr();
    run_phase<KIND>(ap, (LAS unsigned char*)lds_raw, args.ph_lo);
}
#ifndef REP_BAR
#define REP_BAR 1
#endif
#ifndef REP_G1
#define REP_G1 1
#endif
#ifndef REP_S
#define REP_S 1
#endif
#ifndef REP_M
#define REP_M 1
#endif
#ifndef REP_G2
#define REP_G2 1
#endif
#define GRID_BAR() do { for (int rb_ = 0; rb_ < REP_BAR; ++rb_) xcd_barrier(bar); } while (0)
__global__ void __launch_bounds__(NT, 2) fwd_all(Args args) {
    extern __shared__ __attribute__((aligned(16))) unsigned char lds_raw[];
    LAS unsigned char* lds = (LAS unsigned char*)lds_raw;
    volatile LAS unsigned* MISC = (volatile LAS unsigned*)(lds + MISC_OFF);
    if (threadIdx.x < 32) MISC[threadIdx.x] = 0u;
    __syncthreads();
    KArgs ap = (KArgs)__builtin_amdgcn_kernarg_segment_ptr();
    XcdBarrier bar = xcd_barrier_post((unsigned*)(args.ws + WS_CTL) + CW_BAR, MISC + 8);
    run_phase<K_PREP>(ap, lds, 0); GRID_BAR();
    run_phase<K_EMBED>(ap, lds, 0); GRID_BAR();
#pragma unroll 1
    for (int l = 0; l < DEPTH; ++l) {
        for (int r_ = 0; r_ < REP_G1; ++r_) run_phase<0>(ap, lds, l); GRID_BAR();
        for (int r_ = 0; r_ < REP_S; ++r_) run_phase<2>(ap, lds, l); GRID_BAR();
        for (int r_ = 0; r_ < REP_M; ++r_) run_phase<3>(ap, lds, l); GRID_BAR();
        for (int r_ = 0; r_ < REP_G2; ++r_) run_phase<7>(ap, lds, l); GRID_BAR();
        run_phase<8>(ap, lds, l); if (l < DEPTH - 1) GRID_BAR();
    }
}

#ifndef N_LAUNCH_MODE
#define N_LAUNCH_MODE 1
#endif

extern "C" void kernel_launch(void* const* d_in, const int* in_sizes, int n_in, void* d_out, int out_size, void* d_ws, size_t ws_size, hipStream_t stream) {
    static int grid = 0, fused = 0;
    if (grid == 0) {
        if (n_in != 24 || in_sizes[0] != MX * DM || out_size != MX * DM || ws_size < WS_END) { fprintf(stderr, "kernel_launch: unexpected shapes (n_in %d, in0 %d, out %d, ws %zu)\n", n_in, n_in > 0 ? in_sizes[0] : -1, out_size, ws_size); grid = -1; return; }
        int dev = 0, cus = 0, per_cu = 0;
        if (hipGetDevice(&dev) != hipSuccess || hipDeviceGetAttribute(&cus, hipDeviceAttributeMultiprocessorCount, dev) != hipSuccess) { grid = -1; return; }
        bool ok = true;
#define SETA(F) ok = ok && (hipFuncSetAttribute((const void*)F, hipFuncAttributeMaxDynamicSharedMemorySize, LDS_BYTES) == hipSuccess)
        SETA(fwd<K_PREP>); SETA(fwd<K_EMBED>); SETA(fwd<0>); SETA(fwd<2>); SETA(fwd<3>); SETA(fwd<7>); SETA(fwd<8>); SETA(fwd_all);
        if (!ok) { fprintf(stderr, "kernel_launch: hipFuncSetAttribute failed\n"); grid = -1; return; }
        grid = cus;
        if (hipOccupancyMaxActiveBlocksPerMultiprocessor(&per_cu, (const void*)fwd_all, NT, LDS_BYTES) != hipSuccess) per_cu = 0;
        (void)hipGetLastError();
        fused = (N_LAUNCH_MODE == 1 && per_cu >= 1) ? 1 : 0;
        if (!fused) fprintf(stderr, "kernel_launch: falling back to one launch per phase (occupancy query: %d per CU)\n", per_cu);
    }
    if (grid < 0) return;
    (void)hipMemsetAsync((char*)d_ws + WS_CTL, 0, CTL_ZERO_BYTES, stream);
    Args a{};
    const float** pp = (const float**)&a.p;
    for (int i = 0; i < 24; ++i) pp[i] = (const float*)d_in[i];
    a.out = (float*)d_out; a.ws = (unsigned char*)d_ws;
    a.ph_lo = 0; a.ph_hi = 0;
    if (fused) { hipLaunchKernelGGL(fwd_all, dim3(grid), dim3(NT), LDS_BYTES, stream, a); return; }
#define LAUNCH(K) hipLaunchKernelGGL(fwd<K>, dim3(grid), dim3(NT), LDS_BYTES, stream, a)
    LAUNCH(K_PREP); LAUNCH(K_EMBED);
    for (int l = 0; l < DEPTH; ++l) { a.ph_lo = l; LAUNCH(0); LAUNCH(2); LAUNCH(3); LAUNCH(7); LAUNCH(8); }
}
```

```cpp
#include <hip/hip_runtime.h>
#include <cstdio>
#include <cstdint>
namespace pg8 {
#define PG8_LAS __attribute__((address_space(3)))
typedef unsigned short bf16_t;
typedef short bf16x8 __attribute__((ext_vector_type(8)));
typedef float f32x4 __attribute__((ext_vector_type(4)));
typedef unsigned u32x4 __attribute__((ext_vector_type(4)));
constexpr int BM = 256, BK = 64, HALF = 128, HTB = HALF * BK * 2  , STAGE_BYTES = 8 * HTB, NXCD = 8, WGM = 8;

__host__ __device__ __forceinline__ int lds_byte(int r, int c) { const int st = (r >> 4) * 2 + (c >> 5), rr = r & 15, cc = c & 31, ob = rr * 64 + cc * 2; return st * 1024 + (ob ^ (((ob >> 9) & 1) << 5)); }
__host__ __device__ __forceinline__ void stage_rc(int b, int& R, int& C) { const int st = b / 1024, sb = b % 1024, swz = sb ^ (((sb >> 9) & 1) << 5); R = (st >> 1) * 16 + swz / 64; C = (st & 1) * 32 + (swz % 64) / 2; }
__host__ __device__ __forceinline__ int perm32(int rho) { const int n = rho >> 4, i = rho & 15; return 8 * (i >> 2) + 4 * n + (i & 3); }

struct Unit { int pm, pn; };
struct Gemm { const bf16_t* A; const bf16_t* Bt; int M, N, K; };

struct StaticOrder {
    int nM, nN, nwg, G, c;
    __host__ __device__ void init(int M, int N, int G_, int c_) { nM = M / BM; nN = N / BM; nwg = nM * nN; G = G_; c = c_; }
    __host__ __device__ bool next(int i, Unit& u) const {
        const long L = (long)i * G + c; if (L >= nwg) return false;
        int wgid = (int)L; { const int q = nwg / NXCD, r = nwg % NXCD, xcd = wgid % NXCD, off = wgid / NXCD; wgid = (xcd < r ? xcd * (q + 1) : r * (q + 1) + (xcd - r) * q) + off; }
        const int nig = WGM * nN, gid = wgid / nig, fm = gid * WGM, gsz = (nM - fm) < WGM ? (nM - fm) : WGM;
        u.pm = fm + ((wgid % nig) % gsz); u.pn = (wgid % nig) / gsz; return true;
    }
    __device__ __forceinline__ void a_ready(const Unit&) const {}
    __device__ __forceinline__ void done(const Unit&) const {}
};

__device__ __forceinline__ unsigned cvt_pk_bf16(float lo, float hi) { unsigned r; asm volatile("v_cvt_pk_bf16_f32 %0, %1, %2" : "=v"(r) : "v"(lo), "v"(hi)); return r; }
typedef float f32x2 __attribute__((ext_vector_type(2)));
__device__ __forceinline__ f32x2 gelu_pk(f32x2 v) {
    const f32x2 av = __builtin_elementwise_abs(v), d = av * 0.2316418882f + 1.0f;
    f32x2 t; t.x = __builtin_amdgcn_rcpf(d.x); t.y = __builtin_amdgcn_rcpf(d.y);
    f32x2 q = t * 0.5307027145f + (-0.7265760135f); q = q * t + 0.7107068705f; q = q * t + (-0.142248368f); q = q * t + 0.127414796f; q = q * t;
    const f32x2 s = (v * v) * (-0.72134752044f);
    f32x2 e; e.x = __builtin_amdgcn_exp2f(s.x); e.y = __builtin_amdgcn_exp2f(s.y);
    const f32x2 m = v * (q * e), r = v - m;
    f32x2 o; o.x = v.x < 0.f ? m.x : r.x; o.y = v.y < 0.f ? m.y : r.y; return o;
}

template <int ACT  > struct EpiBf16 {
    static constexpr bool PERM = true, AFTER_DRAIN = false; static_assert(ACT == 0 || ACT == 1, "EpiBf16: ACT is 0 (none) or 1 (gelu_pk)");
    bf16_t* O; int ldc; const float* bias; int split_cols; size_t split_stride; float scale0;
    __device__ __forceinline__ void operator()(const f32x4 (&acc)[2][2][4][2], const Unit& u, int wr, int wc, int fr, int fq) const {
        const int row0 = u.pm * BM + wr * 64 + fr; int colt = u.pn * BM; bf16_t* base = O;
        float sc = 1.f; if (split_cols) { const int t = colt / split_cols; base += (size_t)t * split_stride; colt -= t * split_cols; if (t == 0) sc = scale0; }
        const int col0 = colt + wc * 32 + 8 * fq, bcol0 = u.pn * BM + wc * 32 + 8 * fq;
        f32x4 bv[2][2];
#pragma unroll
        for (int bj = 0; bj < 2; ++bj)
#pragma unroll
            for (int n = 0; n < 2; ++n) bv[bj][n] = bias ? *(const f32x4*)(bias + bcol0 + bj * HALF + 4 * n) : (f32x4){0.f, 0.f, 0.f, 0.f};
#pragma unroll
        for (int ai = 0; ai < 2; ++ai)
#pragma unroll
            for (int m = 0; m < 4; ++m) { bf16_t* rowp = base + (size_t)(row0 + ai * HALF + m * 16) * ldc + col0;
#pragma unroll
                for (int bj = 0; bj < 2; ++bj) { f32x4 v0 = acc[ai][bj][m][0] + bv[bj][0], v1 = acc[ai][bj][m][1] + bv[bj][1];
                    if (ACT == 1) { f32x2 a = gelu_pk((f32x2){v0[0], v0[1]}), b = gelu_pk((f32x2){v0[2], v0[3]}), c = gelu_pk((f32x2){v1[0], v1[1]}), d = gelu_pk((f32x2){v1[2], v1[3]});
                        v0 = (f32x4){a.x, a.y, b.x, b.y}; v1 = (f32x4){c.x, c.y, d.x, d.y}; }
                    v0 = v0 * sc; v1 = v1 * sc; u32x4 w; w.x = cvt_pk_bf16(v0[0], v0[1]); w.y = cvt_pk_bf16(v0[2], v0[3]); w.z = cvt_pk_bf16(v1[0], v1[1]); w.w = cvt_pk_bf16(v1[2], v1[3]);
                    *(u32x4*)(rowp + bj * HALF) = w; } }
    }
};

struct PanelStats {
    unsigned* xbuf;
    unsigned* cnt;
    unsigned* tmo;
    int ntn; float eps;
    unsigned code;
    __device__ __forceinline__ bool run(const f32x4 (&v)[2][2][4][2], const Unit& u, int wr, int wc, int fr, int fq, PG8_LAS unsigned char* lds, int wid, int lane) const {
        typedef float f32x2v __attribute__((ext_vector_type(2)));
        PG8_LAS f32x2v* P = (PG8_LAS f32x2v*)lds;
        PG8_LAS f32x2v* S = (PG8_LAS f32x2v*)(lds + 8192);
        PG8_LAS unsigned* flag = (PG8_LAS unsigned*)(lds + 8192 + 2048);
#pragma unroll
        for (int ai = 0; ai < 2; ++ai)
#pragma unroll
            for (int m = 0; m < 4; ++m) {
                float s = 0.f;
#pragma unroll
                for (int bj = 0; bj < 2; ++bj)
#pragma unroll
                    for (int n = 0; n < 2; ++n) { const f32x4 x = v[ai][bj][m][n]; s += (x[0] + x[1]) + (x[2] + x[3]); }
                s += __shfl_xor(s, 16); s += __shfl_xor(s, 32);
                const float mw = s * (1.0f / 64.0f); float q = 0.f;
#pragma unroll
                for (int bj = 0; bj < 2; ++bj)
#pragma unroll
                    for (int n = 0; n < 2; ++n) { const f32x4 d = v[ai][bj][m][n] - mw; q += (d[0] * d[0] + d[1] * d[1]) + (d[2] * d[2] + d[3] * d[3]); }
                q += __shfl_xor(q, 16); q += __shfl_xor(q, 32);
                if (fq == 0) P[(ai * HALF + wr * 64 + m * 16 + fr) * 4 + wc] = (f32x2v){mw, q};
            }
        asm volatile("s_waitcnt lgkmcnt(0)" ::: "memory"); __builtin_amdgcn_s_barrier(); asm volatile("" ::: "memory");
#if defined(BROKEN_EXCHANGE_NO_WAIT)
#warning BROKEN CONTROL BUILD: the row-statistics exchange does not wait; results are wrong by design
        if (blockIdx.x >= 64) { const long long t0_ = clock64(); while (clock64() - t0_ < 60000) __builtin_amdgcn_s_sleep(8); }
#endif
        const int row = wid * 32 + (lane & 31);
        if (lane < 32) {
            const f32x2v a = P[row * 4 + 0], b = P[row * 4 + 1], c = P[row * 4 + 2], d = P[row * 4 + 3];
            const float mt = (a.x + b.x + c.x + d.x) * 0.25f;
            const float da = a.x - mt, db = b.x - mt, dc = c.x - mt, dd = d.x - mt;
            const float m2 = (a.y + b.y) + (c.y + d.y) + 64.0f * ((da * da + db * db) + (dc * dc + dd * dd));
            unsigned long long* slot = (unsigned long long*)xbuf + ((size_t)(u.pm * BM + row) * 4 + u.pn);
            __hip_atomic_store(slot, ((unsigned long long)__float_as_uint(m2) << 32) | __float_as_uint(mt), __ATOMIC_RELAXED, __HIP_MEMORY_SCOPE_AGENT);
        }
        asm volatile("s_waitcnt vmcnt(0)" ::: "memory");
        if (lane == 0) __hip_atomic_fetch_add(cnt + 64 * u.pm, 1u, __ATOMIC_RELAXED, __HIP_MEMORY_SCOPE_AGENT);
        if (wid == 0) {
            bool dead = false; const unsigned long long t0 = __builtin_amdgcn_s_memrealtime(); const unsigned want = 8u * (unsigned)ntn;
            for (;;) {
#if defined(BROKEN_EXCHANGE_NO_WAIT)
                break;
#endif
                if ((unsigned)__builtin_amdgcn_readfirstlane(__hip_atomic_load(cnt + 64 * u.pm, __ATOMIC_RELAXED, __HIP_MEMORY_SCOPE_AGENT)) >= want) break;
                if (__builtin_amdgcn_s_memrealtime() - t0 > 2000000ull) {
                    if (lane == 0) { unsigned expect = 0u; __hip_atomic_compare_exchange_strong(tmo + 1, &expect, code | (unsigned)(u.pm & 0xff), __ATOMIC_RELAXED, __ATOMIC_RELAXED, __HIP_MEMORY_SCOPE_AGENT);
                                     __hip_atomic_store(tmo, 1u, __ATOMIC_RELAXED, __HIP_MEMORY_SCOPE_AGENT); }
                    dead = true; break; }
                __builtin_amdgcn_s_sleep(2);
            }
            __builtin_amdgcn_fence(__ATOMIC_ACQUIRE, "agent");
            if (lane == 0) flag[0] = dead ? 1u : 0u;
        }
        asm volatile("s_waitcnt vmcnt(0) lgkmcnt(0)" ::: "memory"); __builtin_amdgcn_s_barrier(); asm volatile("" ::: "memory");
        const bool bad = flag[0] != 0u;
        if (lane < 32) {
            const unsigned long long* slot = (const unsigned long long*)xbuf + (size_t)(u.pm * BM + row) * 4; float mt[4], m2[4]; float ms = 0.f;
#pragma unroll
            for (int t = 0; t < 4; ++t) { if (t < ntn) { const unsigned long long w = __hip_atomic_load(slot + t, __ATOMIC_RELAXED, __HIP_MEMORY_SCOPE_AGENT); mt[t] = __uint_as_float((unsigned)w); m2[t] = __uint_as_float((unsigned)(w >> 32)); } else { mt[t] = 0.f; m2[t] = 0.f; } ms += mt[t]; }
            const float mean = ms / (float)ntn; float q = 0.f;
#pragma unroll
            for (int t = 0; t < 4; ++t) if (t < ntn) { const float dm = mt[t] - mean; q += m2[t] + 256.0f * dm * dm; }
            S[row] = (f32x2v){mean, 1.0f / sqrtf(q / (256.0f * (float)ntn) + eps)};
        }
        asm volatile("s_waitcnt lgkmcnt(0)" ::: "memory"); __builtin_amdgcn_s_barrier(); asm volatile("" ::: "memory");
        return bad;
    }
};
struct EpiLnRes {
    static constexpr bool PERM = false, AFTER_DRAIN = true;
    const float* base; float* out; int ldc; const float* bias; PanelStats st; unsigned poison;
    __device__ __forceinline__ void fused(f32x4 (&acc)[2][2][4][2], const Unit& u, int wr, int wc, int fr, int fq, PG8_LAS unsigned char* lds, int wid, int lane) const {
        typedef float f32x2v __attribute__((ext_vector_type(2)));
        const PG8_LAS f32x2v* S = (const PG8_LAS f32x2v*)(lds + 8192);
        const int col0 = u.pn * BM + wc * 32 + 4 * fq;
#pragma unroll
        for (int bj = 0; bj < 2; ++bj)
#pragma unroll
            for (int n = 0; n < 2; ++n) { const f32x4 bv = bias ? *(const f32x4*)(bias + col0 + bj * HALF + n * 16) : (f32x4){0.f, 0.f, 0.f, 0.f};
#pragma unroll
                for (int ai = 0; ai < 2; ++ai)
#pragma unroll
                    for (int m = 0; m < 4; ++m) acc[ai][bj][m][n] += bv; }
        f32x4 pre[4][2][2];
#pragma unroll
        for (int m = 0; m < 4; ++m) { const size_t off = (size_t)(u.pm * BM + wr * 64 + m * 16 + fr) * ldc + col0;
#pragma unroll
            for (int bj = 0; bj < 2; ++bj)
#pragma unroll
                for (int n = 0; n < 2; ++n) pre[m][bj][n] = *(const f32x4*)(base + off + bj * HALF + n * 16); }
        const bool bad = st.run(acc, u, wr, wc, fr, fq, lds, wid, lane) || poison != 0u;
        const float qnan = __builtin_nanf("");
#pragma unroll
        for (int ai = 0; ai < 2; ++ai)
#pragma unroll
            for (int m = 0; m < 4; ++m) { const int r = ai * HALF + wr * 64 + m * 16 + fr; const f32x2v sr = S[r]; const size_t off = (size_t)(u.pm * BM + r) * ldc + col0;
#pragma unroll
                for (int bj = 0; bj < 2; ++bj)
#pragma unroll
                    for (int n = 0; n < 2; ++n) { const f32x4 bs = ai == 0 ? pre[m][bj][n] : *(const f32x4*)(base + off + bj * HALF + n * 16); f32x4 o = bs + (acc[ai][bj][m][n] - sr.x) * sr.y;
                        if (bad) o = (f32x4){qnan, qnan, qnan, qnan}; *(f32x4*)(out + off + bj * HALF + n * 16) = o; }
                if (m & 1) asm volatile("" ::: "memory"); }
    }
};
struct EpiLnResLn {
    static constexpr bool PERM = false, AFTER_DRAIN = true;
    const float* base; float* out; bf16_t* xn; int ldc; const float* bias; PanelStats st1, st2; unsigned poison;
    __device__ __forceinline__ void fused(f32x4 (&acc)[2][2][4][2], const Unit& u, int wr, int wc, int fr, int fq, PG8_LAS unsigned char* lds, int wid, int lane) const {
        typedef float f32x2v __attribute__((ext_vector_type(2))); typedef unsigned u32x2v __attribute__((ext_vector_type(2)));
        const PG8_LAS f32x2v* S = (const PG8_LAS f32x2v*)(lds + 8192);
        const int col0 = u.pn * BM + wc * 32 + 4 * fq;
#pragma unroll
        for (int bj = 0; bj < 2; ++bj)
#pragma unroll
            for (int n = 0; n < 2; ++n) { const f32x4 bv = bias ? *(const f32x4*)(bias + col0 + bj * HALF + n * 16) : (f32x4){0.f, 0.f, 0.f, 0.f};
#pragma unroll
                for (int ai = 0; ai < 2; ++ai)
#pragma unroll
                    for (int m = 0; m < 4; ++m) acc[ai][bj][m][n] += bv; }
        bool bad = st1.run(acc, u, wr, wc, fr, fq, lds, wid, lane) || poison != 0u;
        const float qnan = __builtin_nanf("");
#pragma unroll
        for (int ai = 0; ai < 2; ++ai)
#pragma unroll
            for (int m = 0; m < 4; ++m) { const int r = ai * HALF + wr * 64 + m * 16 + fr; const f32x2v sr = S[r]; const size_t off = (size_t)(u.pm * BM + r) * ldc + col0;
#pragma unroll
                for (int bj = 0; bj < 2; ++bj)
#pragma unroll
                    for (int n = 0; n < 2; ++n) { const f32x4 bs = *(const f32x4*)(base + off + bj * HALF + n * 16); acc[ai][bj][m][n] = bs + (acc[ai][bj][m][n] - sr.x) * sr.y; }
                asm volatile("" : "+v"(acc[ai][0][m][0]), "+v"(acc[ai][0][m][1]), "+v"(acc[ai][1][m][0]), "+v"(acc[ai][1][m][1]));
                if (m & 1) asm volatile("" ::: "memory"); }
        const bool bad1 = bad;
        bad = st2.run(acc, u, wr, wc, fr, fq, lds, wid, lane) || bad;
#pragma unroll
        for (int ai = 0; ai < 2; ++ai)
#pragma unroll
            for (int m = 0; m < 4; ++m) { const int r = ai * HALF + wr * 64 + m * 16 + fr; const f32x2v sr = S[r]; const size_t off = (size_t)(u.pm * BM + r) * ldc + col0;
#pragma unroll
                for (int bj = 0; bj < 2; ++bj)
#pragma unroll
                    for (int n = 0; n < 2; ++n) { const f32x4 x1 = acc[ai][bj][m][n]; *(f32x4*)(out + off + bj * HALF + n * 16) = bad1 ? (f32x4){qnan, qnan, qnan, qnan} : x1;
                        const f32x4 o = (x1 - sr.x) * sr.y; u32x2v w; w.x = cvt_pk_bf16(o[0], o[1]); w.y = cvt_pk_bf16(o[2], o[3]);
                        if (bad) { w.x = 0x7fc07fc0u; w.y = 0x7fc07fc0u; } *(u32x2v*)(xn + off + bj * HALF + n * 16) = w; }
                asm volatile("" ::: "memory"); }
    }
};

template <class Epi, class Sched, bool ALIGN_EPI = false, bool SP2 = false>
__device__ __forceinline__ void gemm_phase(PG8_LAS unsigned char* lds, const Gemm g, const Sched& S, const Epi& E) {
    int tid_ = threadIdx.x; asm volatile("" : "+v"(tid_));
    const int tid = tid_, wid = __builtin_amdgcn_readfirstlane(tid >> 6), lane = tid & 63, wr = wid >> 2, wc = wid & 3, fr = lane & 15, fq = lane >> 4;
    const int K = g.K, nt = K / BK;
    unsigned voffA[2], voffB[2];
#pragma unroll
    for (int i = 0; i < 2; ++i) { int R, C; stage_rc(tid * 16 + i * 8192, R, C); const int Rb = Epi::PERM ? ((R & ~31) + perm32(R & 31)) : R;
        voffA[i] = (unsigned)(R * K + C) * 2u; voffB[i] = (unsigned)(Rb * K + C) * 2u; }
    const size_t kstep = (size_t)(BK * 2);
    const size_t hstep = (size_t)HALF * K * 2;
    const size_t tstep = 2 * hstep;
    const unsigned ldsw = (unsigned)wid * 1024u;
    const int aoff = lds_byte(wr * 64 + fr, fq * 8), boff = lds_byte(wc * 32 + fr, fq * 8);
#define PG8_SA(b, h) (((b) * 2 + (h)) * HTB)
#define PG8_SB(b, h) ((4 + (b) * 2 + (h)) * HTB)
#define PG8_STAGE(bufoff, gbase, voff) do { _Pragma("unroll") for (int _i = 0; _i < 2; ++_i) \
        __builtin_amdgcn_global_load_lds((const unsigned*)((const char*)(gbase) + (voff)[_i]), (PG8_LAS unsigned*)(lds + (bufoff) + ldsw + _i * 8192), 16, 0, 0); } while (0)
#define PG8_LDA(dst, b, h) do { _Pragma("unroll") for (int m = 0; m < 4; ++m) _Pragma("unroll") for (int k = 0; k < 2; ++k) dst[m][k] = *(const PG8_LAS bf16x8*)(lds + PG8_SA(b, h) + aoff + m * 2048 + k * 1024); } while (0)
#define PG8_LDB(dst, b, h) do { _Pragma("unroll") for (int n = 0; n < 2; ++n) _Pragma("unroll") for (int k = 0; k < 2; ++k) dst[n][k] = *(const PG8_LAS bf16x8*)(lds + PG8_SB(b, h) + boff + n * 2048 + k * 1024); } while (0)
#define PG8_MMA(ai, bj, At, Bt) do { __builtin_amdgcn_s_setprio(1); _Pragma("unroll") for (int m = 0; m < 4; ++m) _Pragma("unroll") for (int n = 0; n < 2; ++n) _Pragma("unroll") for (int k = 0; k < 2; ++k) \
        acc[ai][bj][m][n] = __builtin_amdgcn_mfma_f32_16x16x32_bf16(Bt[n][k], At[m][k], acc[ai][bj][m][n], 0, 0, 0); __builtin_amdgcn_s_setprio(0); } while (0)
#define PG8_WAIT_V(n) asm volatile("s_waitcnt vmcnt(" #n ")" ::: "memory")
#define PG8_WAIT_L(n) asm volatile("s_waitcnt lgkmcnt(" #n ")" ::: "memory")
#define PG8_BAR __builtin_amdgcn_s_barrier()
#define PG8_SCHED __builtin_amdgcn_sched_barrier(0)
    Unit cur, nxt; int ui = 0;
    if (!S.next(0, cur)) return;
    f32x4 acc[2][2][4][2];
#pragma unroll
    for (int a = 0; a < 2; ++a)
#pragma unroll
        for (int b = 0; b < 2; ++b)
#pragma unroll
            for (int m = 0; m < 4; ++m)
#pragma unroll
                for (int n = 0; n < 2; ++n) acc[a][b][m][n] = (f32x4){0.f, 0.f, 0.f, 0.f};
    bf16x8 At[4][2], B0[2][2], B1[2][2];
    const char* cA = (const char*)g.A + (size_t)cur.pm * tstep; const char* cB = (const char*)g.Bt + (size_t)cur.pn * tstep;
    S.a_ready(cur);
    if constexpr (SP2) {
        PG8_STAGE(PG8_SB(0, 0), cB, voffB); PG8_STAGE(PG8_SB(0, 1), cB + hstep, voffB); PG8_STAGE(PG8_SA(0, 0), cA, voffA); PG8_STAGE(PG8_SA(0, 1), cA + hstep, voffA);
        if (wr == 1) PG8_BAR;
        PG8_WAIT_V(2); PG8_BAR;
        PG8_STAGE(PG8_SB(1, 0), cB + kstep, voffB); PG8_STAGE(PG8_SA(1, 0), cA + kstep, voffA); PG8_STAGE(PG8_SB(1, 1), cB + hstep + kstep, voffB);
        PG8_WAIT_V(6); PG8_BAR;
    } else {
        PG8_STAGE(PG8_SB(0, 0), cB, voffB); PG8_STAGE(PG8_SA(0, 0), cA, voffA); PG8_STAGE(PG8_SB(0, 1), cB + hstep, voffB); PG8_STAGE(PG8_SA(0, 1), cA + hstep, voffA);
        if (wr == 1) PG8_BAR;
        PG8_WAIT_V(4); PG8_BAR;
        PG8_STAGE(PG8_SB(1, 0), cB + kstep, voffB); PG8_STAGE(PG8_SA(1, 0), cA + kstep, voffA); PG8_STAGE(PG8_SB(1, 1), cB + hstep + kstep, voffB);
        PG8_WAIT_V(6); PG8_BAR;
    }
    for (;;) {
        const bool has_next = S.next(ui + 1, nxt);
        const char* nA = has_next ? (const char*)g.A + (size_t)nxt.pm * tstep : cA; const char* nB = has_next ? (const char*)g.Bt + (size_t)nxt.pn * tstep : cB;
        for (int t = 0; t < nt; t += 2) {
            const bool last = (t == nt - 2);
            const char* a1 = cA + (size_t)(t + 1) * kstep;
            const char* a2 = last ? nA : cA + (size_t)(t + 2) * kstep; const char* b2 = last ? nB : cB + (size_t)(t + 2) * kstep;
            const char* a3 = a2 + kstep; const char* b3 = b2 + kstep;
            if (last && has_next) S.a_ready(nxt);
            if constexpr (SP2) {
            PG8_LDB(B0, 0, 0); PG8_LDB(B1, 0, 1); PG8_SCHED; PG8_LDA(At, 0, 0); PG8_STAGE(PG8_SA(1, 1), a1 + hstep, voffA);
            PG8_WAIT_V(8); PG8_WAIT_L(0); PG8_BAR; PG8_MMA(0, 0, At, B0); PG8_MMA(0, 1, At, B1); PG8_BAR; PG8_SCHED;
            PG8_LDA(At, 0, 1); PG8_STAGE(PG8_SB(0, 0), b2, voffB); PG8_STAGE(PG8_SB(0, 1), b2 + hstep, voffB); PG8_STAGE(PG8_SA(0, 0), a2, voffA);
            PG8_WAIT_V(8); PG8_WAIT_L(0); PG8_BAR; PG8_MMA(1, 0, At, B0); PG8_MMA(1, 1, At, B1); PG8_BAR; PG8_SCHED;
            PG8_LDB(B0, 1, 0); PG8_LDB(B1, 1, 1); PG8_SCHED; PG8_LDA(At, 1, 0); PG8_STAGE(PG8_SA(0, 1), a2 + hstep, voffA);
            PG8_WAIT_V(8); PG8_WAIT_L(0); PG8_BAR; PG8_MMA(0, 0, At, B0); PG8_MMA(0, 1, At, B1); PG8_BAR; PG8_SCHED;
            PG8_LDA(At, 1, 1); PG8_STAGE(PG8_SB(1, 0), b3, voffB); PG8_STAGE(PG8_SB(1, 1), b3 + hstep, voffB); PG8_STAGE(PG8_SA(1, 0), a3, voffA);
            PG8_WAIT_V(8); PG8_WAIT_L(0); PG8_BAR; PG8_MMA(1, 0, At, B0); PG8_MMA(1, 1, At, B1); PG8_BAR; PG8_SCHED;
            } else {
            PG8_LDB(B0, 0, 0); PG8_SCHED; PG8_LDA(At, 0, 0); PG8_STAGE(PG8_SA(1, 1), a1 + hstep, voffA);
            PG8_WAIT_L(8); PG8_BAR; PG8_WAIT_L(0); PG8_MMA(0, 0, At, B0); PG8_BAR; PG8_SCHED;
            PG8_LDB(B1, 0, 1); PG8_STAGE(PG8_SB(0, 0), b2, voffB);
            PG8_BAR; PG8_WAIT_L(0); PG8_MMA(0, 1, At, B1); PG8_BAR;
            PG8_LDA(At, 0, 1); PG8_STAGE(PG8_SA(0, 0), a2, voffA);
            PG8_BAR; PG8_WAIT_L(0); PG8_MMA(1, 0, At, B0); PG8_BAR; PG8_SCHED;
            PG8_STAGE(PG8_SB(0, 1), b2 + hstep, voffB);
            PG8_WAIT_V(6); PG8_BAR; PG8_MMA(1, 1, At, B1); PG8_BAR;
            PG8_LDB(B0, 1, 0); PG8_SCHED; PG8_LDA(At, 1, 0); PG8_STAGE(PG8_SA(0, 1), a2 + hstep, voffA);
            PG8_WAIT_L(8); PG8_BAR; PG8_WAIT_L(0); PG8_MMA(0, 0, At, B0); PG8_BAR; PG8_SCHED;
            PG8_LDB(B1, 1, 1); PG8_STAGE(PG8_SB(1, 0), b3, voffB);
            PG8_BAR; PG8_WAIT_L(0); PG8_MMA(0, 1, At, B1); PG8_BAR;
            PG8_LDA(At, 1, 1); PG8_STAGE(PG8_SA(1, 0), a3, voffA);
            PG8_BAR; PG8_WAIT_L(0); PG8_MMA(1, 0, At, B0); PG8_BAR; PG8_SCHED;
            PG8_STAGE(PG8_SB(1, 1), b3 + hstep, voffB);
            PG8_WAIT_V(6); PG8_BAR; PG8_MMA(1, 1, At, B1); PG8_BAR;
            }
        }
        if constexpr (ALIGN_EPI) { if (wr == 0) PG8_BAR; }
        if constexpr (!Epi::AFTER_DRAIN) { E(acc, cur, wr, wc, fr, fq); S.done(cur); }
        if (!has_next) break;
#pragma unroll
        for (int a = 0; a < 2; ++a)
#pragma unroll
            for (int b = 0; b < 2; ++b)
#pragma unroll
                for (int m = 0; m < 4; ++m)
#pragma unroll
                    for (int n = 0; n < 2; ++n) acc[a][b][m][n] = (f32x4){0.f, 0.f, 0.f, 0.f};
        cur = nxt; cA = nA; cB = nB; ++ui;
        if constexpr (ALIGN_EPI) { if (wr == 1) PG8_BAR; }
    }
    PG8_WAIT_V(0);
    if constexpr (!ALIGN_EPI) { if (wr == 0) PG8_BAR; }
    PG8_BAR;
    if constexpr (Epi::AFTER_DRAIN) { E.fused(acc, cur, wr, wc, fr, fq, lds, wid, lane); S.done(cur); }
#undef PG8_SA
#undef PG8_SB
#undef PG8_STAGE
#undef PG8_LDA
#undef PG8_LDB
#undef PG8_MMA
#undef PG8_WAIT_V
#undef PG8_WAIT_L
#undef PG8_BAR
#undef PG8_SCHED
}
}

constexpr int DM = 1024, NB = 8, SEQ = 2048, DEPTH = 4, CTXL = 256, NIN = 2304;
constexpr int MX = NB * SEQ, MC = NB * CTXL, MT = MX + MC;
constexpr int WL = 512, WP = 256, WC = 256;
constexpr int C_VL = 0, C_GL = 512, C_VP = 1024, C_GP = 1280, C_VC = 1536, C_GG = 1792, C_GC = 2048;
constexpr int NCHUNK = 36;
constexpr float EPS_RMS = 1e-6f, EPS_LN = 1e-5f;

constexpr size_t MiB = 1u << 20;
constexpr size_t WS_CTL = 0, CTL_ZERO_BYTES = 1 * MiB;
constexpr size_t WS_MOD = 1 * MiB;
constexpr size_t WS_GB = 1 * MiB + 512 * 1024;
constexpr size_t WS_KC = WS_GB + 32768;
constexpr float LOG2E = 1.4426950408889634f;
constexpr size_t WS_GW = 2 * MiB;
constexpr size_t WS_PW = 3 * MiB;
constexpr size_t WS_CPW = 3 * MiB + 512 * 1024;
constexpr size_t WS_WIN = 4 * MiB;
constexpr size_t WS_WOUT = 22 * MiB;
constexpr size_t WS_HX = 30 * MiB;
constexpr size_t WS_UX = 66 * MiB;
constexpr size_t WS_R2 = 147 * MiB;
constexpr size_t WS_CTXR = 219 * MiB;
constexpr size_t WS_SUM = 227 * MiB;
constexpr size_t WS_END = 230 * MiB;

constexpr int LDS_BYTES = 147456;
constexpr int MISC_OFF = LDS_BYTES - 256;
constexpr int NT = 512;

#define GAS __attribute__((address_space(1)))
#define LAS __attribute__((address_space(3)))
typedef unsigned short bf16;
typedef unsigned v4u __attribute__((ext_vector_type(4)));
typedef float f32x4 __attribute__((ext_vector_type(4)));
typedef unsigned v2u __attribute__((ext_vector_type(2)));
#define LDS_WAIT() asm volatile("s_waitcnt lgkmcnt(0)" ::: "memory")
#define VM_WAIT() asm volatile("s_waitcnt vmcnt(0)" ::: "memory")

__device__ __forceinline__ unsigned f2bf(float f) { unsigned u = __builtin_bit_cast(unsigned, f); return (u + 0x7fffu + ((u >> 16) & 1u)) >> 16; }
__device__ __forceinline__ unsigned pk2(float lo, float hi) { return f2bf(lo) | (f2bf(hi) << 16); }
__device__ __forceinline__ float bf2f(bf16 v) { return __builtin_bit_cast(float, (unsigned)v << 16); }
__device__ __forceinline__ float sigmoidf_(float v) { return 1.0f / (1.0f + expf(-v)); }
__device__ __forceinline__ float siluf_(float v) { return v / (1.0f + expf(-v)); }
__device__ __forceinline__ float wave_sum(float v) {
#pragma unroll
    for (int o = 1; o < 64; o <<= 1) v += __shfl_xor(v, o);
    return v;
}

struct Ptrs {
    const float *x, *c, *ctx, *c_ctx, *w_mod, *b_mod, *g_pre, *w_in, *lru_conv_w, *lru_conv_b, *lru_wa, *lru_ba, *lru_wx, *lru_bx, *lru_lambda,
        *pool_w, *pool_scale, *conf_dw, *conf_dw_b, *conf_ln_g, *conf_ln_b, *conf_pw, *w_out, *g_post;
};
struct Args { Ptrs p; float* out; unsigned char* ws; int ph_lo, ph_hi; };

__device__ __forceinline__ void row_info(int r, int& b, int& t, int& n, int& base) {
    if (r < MX) { b = r >> 11; t = r & 2047; n = SEQ; base = b << 11; }
    else { const int rc = r - MX; b = rc >> 8; t = rc & 255; n = CTXL; base = MX + (b << 8); }
}
__device__ __forceinline__ int chunk_row0(int b, int ck) { return ck < 4 ? MX + b * CTXL + 64 * ck : b * SEQ + 64 * (ck - 4); }

__device__ __forceinline__ void transpose_item(const float* W, int K, int N, bf16* WT, LAS float* scr, int item, int lane, float scale = 1.0f) {
    const int nblk = N / 32, kb = item / nblk, nb = item % nblk, k0 = 64 * kb, n0 = 32 * nb;
#pragma unroll 8
    for (int i = 0; i < 32; ++i) { const int kk = 2 * i + (lane >> 5); scr[kk * 33 + (lane & 31)] = W[(size_t)(k0 + kk) * N + n0 + (lane & 31)] * scale; }
    LDS_WAIT(); asm volatile("" ::: "memory");
    const int c = lane & 7;
#pragma unroll
    for (int j = 0; j < 4; ++j) { const int n = (lane >> 3) + 8 * j; const LAS float* s = scr + (8 * c) * 33 + n;
        v4u o; o.x = pk2(s[0 * 33], s[1 * 33]); o.y = pk2(s[2 * 33], s[3 * 33]); o.z = pk2(s[4 * 33], s[5 * 33]); o.w = pk2(s[6 * 33], s[7 * 33]);
        *(GAS v4u*)(WT + (size_t)(n0 + n) * K + k0 + 8 * c) = o; }
    LDS_WAIT(); asm volatile("" ::: "memory");
}

struct EpiF32 {
    static constexpr bool PERM = false, AFTER_DRAIN = false;
    float* O; int ldc;
    __device__ __forceinline__ void operator()(const pg8::f32x4 (&acc)[2][2][4][2], const pg8::Unit& u, int wr, int wc, int fr, int fq) const {
        const int row0 = u.pm * 256 + wr * 64 + fr, col0 = u.pn * 256 + wc * 32 + 4 * fq;
#pragma unroll
        for (int ai = 0; ai < 2; ++ai)
#pragma unroll
            for (int m = 0; m < 4; ++m) { float* rowp = O + (size_t)(row0 + ai * 128 + m * 16) * ldc + col0;
#pragma unroll
                for (int bj = 0; bj < 2; ++bj)
#pragma unroll
                    for (int n = 0; n < 2; ++n) *(pg8::f32x4*)(rowp + bj * 128 + n * 16) = acc[ai][bj][m][n]; }
    }
};

__device__ __forceinline__ void lru_ab(const Ptrs& P, int l, int d, const float* XC, int row, int c, float& a, float& bb) {
    const int h = c >> 6, j = c & 63;
    const float* wa = P.lru_wa + (size_t)((l * 2 + d) * 8 + h) * 4096 + j;
    const float* wx = P.lru_wx + (size_t)((l * 2 + d) * 8 + h) * 4096 + j;
    const float* xr = XC + (size_t)row * WL + h * 64;
    float rp = P.lru_ba[(l * 2 + d) * WL + c], ip = P.lru_bx[(l * 2 + d) * WL + c];
#pragma unroll 8
    for (int i = 0; i < 64; ++i) { const float xv = xr[i]; rp += xv * wa[i * 64]; ip += xv * wx[i * 64]; }
    const float r = sigmoidf_(rp), ig = sigmoidf_(ip);
    const float sp = log1pf(expf(-P.lru_lambda[(l * 2 + d) * WL + c]));
    const float la = -8.0f * r * sp;
    a = expf(la);
    bb = sqrtf(-expm1f(2.0f * la)) * (ig * xr[j]);
}


typedef short bf16x8 __attribute__((ext_vector_type(8)));
static_assert(133120 + 4096 <= MISC_OFF && 113664 + 32768 <= MISC_OFF, "LDS map");
constexpr int XCT_STRIDE = 1040;
constexpr int L_XCT = 0, L_GZ = 66560, L_CIN = 133120;
__device__ __forceinline__ float bflo(unsigned u) { return __builtin_bit_cast(float, u << 16); }
__device__ __forceinline__ float bfhi(unsigned u) { return __builtin_bit_cast(float, u & 0xffff0000u); }

__device__ __forceinline__ void strip_conv(LAS unsigned char* lds, const Ptrs& P, int l, const bf16* UX, int r0, int tpos0, int n, int tid) {
    const int o = tid & 63, tg = tid >> 6, c0 = 8 * o;
    float w[4][8], bias[8];
#pragma unroll
    for (int k = 0; k < 4; ++k) { const f32x4 a = *(const f32x4*)(P.lru_conv_w + (l * 4 + k) * WL + c0), b = *(const f32x4*)(P.lru_conv_w + (l * 4 + k) * WL + c0 + 4);
#pragma unroll
        for (int q = 0; q < 4; ++q) { w[k][q] = a[q]; w[k][4 + q] = b[q]; } }
    { const f32x4 a = *(const f32x4*)(P.lru_conv_b + l * WL + c0), b = *(const f32x4*)(P.lru_conv_b + l * WL + c0 + 4);
#pragma unroll
      for (int q = 0; q < 4; ++q) { bias[q] = a[q]; bias[4 + q] = b[q]; } }
    v4u v[11];
#pragma unroll
    for (int i = 0; i < 11; ++i) { const int tp = tpos0 + 8 * tg + i - 2;
        v[i] = (tp >= 0 && tp < n) ? *(const v4u*)(UX + (size_t)(r0 + 8 * tg + i - 2) * NIN + C_VL + c0) : (v4u){0u, 0u, 0u, 0u}; }
#pragma unroll
    for (int e = 0; e < 8; ++e) {
        float acc[8];
#pragma unroll
        for (int q = 0; q < 8; ++q) acc[q] = bias[q];
#pragma unroll
        for (int k = 0; k < 4; ++k) { const v4u x = v[e + k];
            acc[0] += w[k][0] * bflo(x.x); acc[1] += w[k][1] * bfhi(x.x); acc[2] += w[k][2] * bflo(x.y); acc[3] += w[k][3] * bfhi(x.y);
            acc[4] += w[k][4] * bflo(x.z); acc[5] += w[k][5] * bfhi(x.z); acc[6] += w[k][6] * bflo(x.w); acc[7] += w[k][7] * bfhi(x.w); }
        v4u ov; ov.x = pk2(acc[0], acc[1]); ov.y = pk2(acc[2], acc[3]); ov.z = pk2(acc[4], acc[5]); ov.w = pk2(acc[6], acc[7]);
        *(LAS v4u*)(lds + L_XCT + (8 * tg + e) * XCT_STRIDE + o * 16) = ov;
    }
}

struct GateW { bf16x8 Br[2][2], Bi[2][2]; float br[2], bi[2], kc[2]; };
struct LookB { float2 s[9]; };
__device__ __forceinline__ void gatew_load(GateW& w, int l, int h, int n, int fr, int fq, const bf16* GWS, const float* GB, const float* KC) {
    const int c = h * 64 + 16 * n + fr;
#pragma unroll
    for (int d = 0; d < 2; ++d) {
        const bf16* wr = GWS + ((size_t)(((l * 2 + d) * 2 + 0) * 8 + h) * 64 + 16 * n + fr) * 64 + fq * 8;
        const bf16* wi = GWS + ((size_t)(((l * 2 + d) * 2 + 1) * 8 + h) * 64 + 16 * n + fr) * 64 + fq * 8;
#pragma unroll
        for (int ks = 0; ks < 2; ++ks) { w.Br[d][ks] = *(const bf16x8*)(wr + ks * 32); w.Bi[d][ks] = *(const bf16x8*)(wi + ks * 32); }
        w.br[d] = GB[((l * 2 + d) * 2 + 0) * WL + c]; w.bi[d] = GB[((l * 2 + d) * 2 + 1) * WL + c]; w.kc[d] = KC[(l * 2 + d) * WL + c];
    }
}
__device__ __forceinline__ int lb_chunk(int d, int p) { return d ? (p < 4 ? 3 - p : 39 - p) : p; }
__device__ __forceinline__ void lookb_load(LookB& lb, int d, int h, int n, int fr, int fq, const float* sb  ) {
    const int c = h * 64 + 16 * n + fr;
#pragma unroll
    for (int i = 0; i < 9; ++i) { const int q = lb_chunk(d, 9 * fq + i); lb.s[i] = *(const float2*)(sb + ((size_t)(q * 2 + d) * WL + c) * 2); }
}
__device__ __forceinline__ float lookb_carry(const LookB& lb, int d, int ck, int fr, int fq) {
    float As = 1.f, Hs = 0.f;
#pragma unroll
    for (int i = 0; i < 9; ++i) { const int q = lb_chunk(d, 9 * fq + i);
        const bool sel = d ? (ck < 4 ? (q < 4 && q > ck) : (q < 4 || q > ck)) : (q < ck);
        const float a = sel ? lb.s[i].x : 1.f, hh = sel ? lb.s[i].y : 0.f; Hs = a * Hs + hh; As *= a; }
    float cin = 0.f;
#pragma unroll
    for (int sg = 0; sg < 4; ++sg) { const float a = __shfl(As, fr + 16 * sg), hh = __shfl(Hs, fr + 16 * sg); cin = a * cin + hh; }
    return cin;
}
template <int MODE>
__device__ __forceinline__ void lru_core(LAS unsigned char* lds, int l, int h, int lane, const bf16* GWS, const float* GB, const float* KC, float* sum_out, const float* sb, int ck, const GateW& w0, const LookB& lb0) {
    const int fr = lane & 15, fq = lane >> 4;
    GateW wn = w0; LookB ln = lb0;
    bf16x8 A[4][2];
#pragma unroll
    for (int m = 0; m < 4; ++m)
#pragma unroll
        for (int ks = 0; ks < 2; ++ks) { const int tau = (fr >> 2) * 16 + m * 4 + (fr & 3);
            A[m][ks] = *(const LAS bf16x8*)(lds + L_XCT + tau * XCT_STRIDE + (h * 64 + ks * 32 + fq * 8) * 2); }
#pragma unroll 1
    for (int n = 0; n < 4; ++n) {
        const int c = h * 64 + 16 * n + fr;
        const GateW w = wn;
        if (n < 3) gatew_load(wn, l, h, n + 1, fr, fq, GWS, GB, KC);
        float xv[16], y[16];
#pragma unroll
        for (int e = 0; e < 16; ++e) { xv[e] = bf2f(*(const LAS bf16*)(lds + L_XCT + (fq * 16 + e) * XCT_STRIDE + c * 2)); y[e] = 0.f; }
#pragma unroll
        for (int d = 0; d < 2; ++d) {
            float cin = 0.f;
            if constexpr (MODE == 1) {
                cin = lookb_carry(ln, d, ck, fr, fq);
                if (d == 0) lookb_load(ln, 1, h, n, fr, fq, sb); else if (n < 3) lookb_load(ln, 0, h, n + 1, fr, fq, sb);
            }
            f32x4 ar[4], ai[4];
#pragma unroll
            for (int m = 0; m < 4; ++m) { ar[m] = (f32x4){w.br[d], w.br[d], w.br[d], w.br[d]}; ai[m] = (f32x4){w.bi[d], w.bi[d], w.bi[d], w.bi[d]}; }
#pragma unroll
            for (int m = 0; m < 4; ++m)
#pragma unroll
                for (int ks = 0; ks < 2; ++ks) { ar[m] = __builtin_amdgcn_mfma_f32_16x16x32_bf16(A[m][ks], w.Br[d][ks], ar[m], 0, 0, 0); ai[m] = __builtin_amdgcn_mfma_f32_16x16x32_bf16(A[m][ks], w.Bi[d][ks], ai[m], 0, 0, 0); }
            const float kc = w.kc[d];
            float av[16], bv[16];
#pragma unroll
            for (int e = 0; e < 16; ++e) {
                const float er = __builtin_amdgcn_exp2f(ar[e >> 2][e & 3]), ei = __builtin_amdgcn_exp2f(ai[e >> 2][e & 3]);
                const float r = __builtin_amdgcn_rcpf(1.0f + er), ig = __builtin_amdgcn_rcpf(1.0f + ei);
                const float a = __builtin_amdgcn_exp2f(kc * r);
                av[e] = a; bv[e] = __builtin_amdgcn_sqrtf(fmaxf(1.0f - a * a, 0.0f)) * (ig * xv[e]);
            }
            float Pq = 1.f, Hq = 0.f;
#pragma unroll
            for (int s = 0; s < 16; ++s) { const int e = d ? 15 - s : s; Hq = av[e] * Hq + bv[e]; Pq *= av[e]; bv[e] = Hq; av[e] = Pq; }
            float Pg[4], Hg[4];
#pragma unroll
            for (int q = 0; q < 4; ++q) { Pg[q] = __shfl(Pq, fr + 16 * q); Hg[q] = __shfl(Hq, fr + 16 * q); }
            if constexpr (MODE == 0) {
                float At = 1.f, Ht = 0.f;
#pragma unroll
                for (int s = 0; s < 4; ++s) { const int q = d ? 3 - s : s; Ht = Pg[q] * Ht + Hg[q]; At *= Pg[q]; }
                if (fq == 0) { float2 o2; o2.x = At; o2.y = Ht; *(float2*)(sum_out + ((size_t)d * WL + c) * 2) = o2; }
            } else {
                float cq = cin;
#pragma unroll
                for (int s = 0; s < 4; ++s) { const int q = d ? 3 - s : s; const bool before = d ? (q > fq) : (q < fq); if (before) cq = Pg[q] * cq + Hg[q]; }
#pragma unroll
                for (int e = 0; e < 16; ++e) y[e] += bv[e] + av[e] * cq;
            }
        }
        if constexpr (MODE == 1) {
#pragma unroll
            for (int e = 0; e < 16; ++e) { LAS bf16* gp = (LAS bf16*)(lds + L_GZ + (fq * 16 + e) * XCT_STRIDE + c * 2); const float g = bf2f(*gp);
                *gp = (bf16)f2bf(y[e] * g * __builtin_amdgcn_rcpf(1.0f + __builtin_amdgcn_exp2f(-LOG2E * g))); }
        }
    }
}

constexpr int T_STRIDE = 528;
constexpr int L_DT = 0, L_ZP = 33792, L_VP = 67584;
constexpr int L_ZC = 0, L_CT = 48128, L_CLT = 0, L_CG = 113664;
__device__ __forceinline__ float silu_fast(float g) { return g * __builtin_amdgcn_rcpf(1.0f + __builtin_amdgcn_exp2f(-LOG2E * g)); }
__device__ __forceinline__ float sigm_fast(float g) { return __builtin_amdgcn_rcpf(1.0f + __builtin_amdgcn_exp2f(-LOG2E * g)); }

template <int NCH> __device__ __forceinline__ void tile_out(LAS unsigned char* lds, int off, int stride, bf16* Zg, int r0, int col0, int tid) {
    constexpr int RPI = NT / NCH;
    const int ch = tid % NCH, rr = tid / NCH;
#pragma unroll
    for (int it = 0; it < 64 / RPI; ++it) { const int row = it * RPI + rr;
        *(v4u*)(Zg + (size_t)(r0 + row) * DM + col0 + ch * 8) = *(const LAS v4u*)(lds + off + row * stride + ch * 16); }
}

__device__ __forceinline__ void pool_part(LAS unsigned char* lds, const Ptrs& P, int l, const bf16* UX, const bf16* PWt, bf16* Zg, int r0, int tpos0, int n, int tid, int wave, int lane) {
    asm volatile("" : "+v"(tid)); lane = tid & 63; wave = __builtin_amdgcn_readfirstlane(tid >> 6);
    const int fr = lane & 15, fq = lane >> 4, g = wave >> 1, nh = wave & 1;
    {
        v4u vp[5], gp[4];
#pragma unroll
        for (int it = 0; it < 5; ++it) { const int id = it * NT + tid, rho = id >> 5, ch = id & 31, tp = tpos0 + rho - 8;
            vp[it] = (tp >= 0 && tp < n) ? *(const v4u*)(UX + (size_t)(r0 + rho - 8) * NIN + C_VP + ch * 8) : (v4u){0u, 0u, 0u, 0u}; }
#pragma unroll
        for (int it = 0; it < 4; ++it) gp[it] = *(const v4u*)(UX + (size_t)(r0 + it * 16 + (tid >> 5)) * NIN + C_GP + (tid & 31) * 8);
#pragma unroll
        for (int it = 0; it < 5; ++it) { const int id = it * NT + tid; *(LAS v4u*)(lds + L_VP + (id >> 5) * 512 + (id & 31) * 16) = vp[it]; }
#pragma unroll
        for (int it = 0; it < 4; ++it) *(LAS v4u*)(lds + L_ZP + (it * 16 + (tid >> 5)) * T_STRIDE + (tid & 31) * 16) = gp[it];
    }
    bf16x8 Bw[2][2];
#pragma unroll
    for (int ni = 0; ni < 2; ++ni) { const bf16* wp = PWt + ((size_t)((l * 4 + g) * 64 + 16 * (2 * nh + ni) + fr)) * 64 + fq * 8; Bw[ni][0] = *(const bf16x8*)(wp); Bw[ni][1] = *(const bf16x8*)(wp + 32); }
    __syncthreads();
    {
        const int o = tid & 31, gg = o >> 3, w2 = 1 << gg;
#pragma unroll
        for (int it = 0; it < 4; ++it) { const int tok = it * 16 + (tid >> 5), t = tpos0 + tok;
            int lo = t - w2; lo = lo < 0 ? 0 : lo; int hi = t + w2; hi = hi > n ? n : hi;
            float sum[8];
#pragma unroll
            for (int q = 0; q < 8; ++q) sum[q] = 0.f;
#pragma unroll
            for (int k = 0; k < 16; ++k) { if (k < 2 * w2) { const v4u x = *(const LAS v4u*)(lds + L_VP + (tok + 8 - w2 + k) * 512 + o * 16);
                sum[0] += bflo(x.x); sum[1] += bfhi(x.x); sum[2] += bflo(x.y); sum[3] += bfhi(x.y); sum[4] += bflo(x.z); sum[5] += bfhi(x.z); sum[6] += bflo(x.w); sum[7] += bfhi(x.w); } }
            const v4u xc = *(const LAS v4u*)(lds + L_VP + (tok + 8) * 512 + o * 16); const float inv = 1.0f / (float)(hi - lo);
            v4u ov; ov.x = pk2(sum[0] * inv - bflo(xc.x), sum[1] * inv - bfhi(xc.x)); ov.y = pk2(sum[2] * inv - bflo(xc.y), sum[3] * inv - bfhi(xc.y));
            ov.z = pk2(sum[4] * inv - bflo(xc.z), sum[5] * inv - bfhi(xc.z)); ov.w = pk2(sum[6] * inv - bflo(xc.w), sum[7] * inv - bfhi(xc.w));
            *(LAS v4u*)(lds + L_DT + tok * T_STRIDE + o * 16) = ov; }
    }
    __syncthreads();
    {
        bf16x8 A[4][2];
#pragma unroll
        for (int m = 0; m < 4; ++m)
#pragma unroll
            for (int ks = 0; ks < 2; ++ks) A[m][ks] = *(const LAS bf16x8*)(lds + L_DT + (16 * m + fr) * T_STRIDE + (g * 64 + ks * 32 + fq * 8) * 2);
#pragma unroll
        for (int ni = 0; ni < 2; ++ni) { const int nn = 2 * nh + ni, cc = g * 64 + 16 * nn + fr;
            const float ps = P.pool_scale[l * WP + cc];
#pragma unroll
            for (int m = 0; m < 4; ++m) { f32x4 acc = (f32x4){0.f, 0.f, 0.f, 0.f};
                acc = __builtin_amdgcn_mfma_f32_16x16x32_bf16(A[m][0], Bw[ni][0], acc, 0, 0, 0); acc = __builtin_amdgcn_mfma_f32_16x16x32_bf16(A[m][1], Bw[ni][1], acc, 0, 0, 0);
#pragma unroll
                for (int j = 0; j < 4; ++j) { const int tok = 16 * m + 4 * fq + j; LAS bf16* gp = (LAS bf16*)(lds + L_ZP + tok * T_STRIDE + cc * 2); const float gt = bf2f(*gp);
                    *gp = (bf16)f2bf(acc[j] * ps * silu_fast(gt)); } }
        }
    }
    __syncthreads();
    tile_out<32>(lds, L_ZP, T_STRIDE, Zg, r0, 512, tid);
    __syncthreads();
}

__device__ __forceinline__ void conf_part(LAS unsigned char* lds, const Ptrs& P, int l, const bf16* UX, const bf16* CPWt, bf16* Zg, int r0, int tpos0, int n, int tid, int wave, int lane) {
    asm volatile("" : "+v"(tid)); lane = tid & 63; wave = __builtin_amdgcn_readfirstlane(tid >> 6);
    {
        const int o = tid & 31, rg = tid >> 5, c0 = 8 * o;
        v4u va[6], vb[6], gp[4];
#pragma unroll
        for (int it = 0; it < 6; ++it) { const int rho = it * 16 + rg, tp = tpos0 + rho - 15; const bool ok = rho < 94 && tp >= 0 && tp < n;
            const bf16* rp = UX + (size_t)(r0 + rho - 15) * NIN;
            va[it] = ok ? *(const v4u*)(rp + C_VC + c0) : (v4u){0u, 0u, 0u, 0u}; vb[it] = ok ? *(const v4u*)(rp + C_GG + c0) : (v4u){0u, 0u, 0u, 0u}; }
#pragma unroll
        for (int it = 0; it < 4; ++it) gp[it] = *(const v4u*)(UX + (size_t)(r0 + it * 16 + rg) * NIN + C_GC + c0);
#pragma unroll
        for (int it = 0; it < 6; ++it) { const int rho = it * 16 + rg; if (rho < 94) { const v4u a = va[it], b = vb[it]; v4u ov;
                ov.x = pk2(bflo(a.x) * sigm_fast(bflo(b.x)), bfhi(a.x) * sigm_fast(bfhi(b.x))); ov.y = pk2(bflo(a.y) * sigm_fast(bflo(b.y)), bfhi(a.y) * sigm_fast(bfhi(b.y)));
                ov.z = pk2(bflo(a.z) * sigm_fast(bflo(b.z)), bfhi(a.z) * sigm_fast(bfhi(b.z))); ov.w = pk2(bflo(a.w) * sigm_fast(bflo(b.w)), bfhi(a.w) * sigm_fast(bfhi(b.w)));
                *(LAS v4u*)(lds + L_ZC + rho * 512 + o * 16) = ov; } }
#pragma unroll
        for (int it = 0; it < 4; ++it) *(LAS v4u*)(lds + L_CG + (it * 16 + rg) * 512 + o * 16) = gp[it];
    }
    __syncthreads();
    bf16x8 Bw[8][2];
    {   const int fr = lane & 15, fq = lane >> 4; const bf16* wp0 = CPWt + ((size_t)(l * 256 + 16 * (2 * wave) + fr)) * 256 + fq * 8;
#pragma unroll
        for (int ks = 0; ks < 8; ++ks) { Bw[ks][0] = *(const bf16x8*)(wp0 + ks * 32); Bw[ks][1] = *(const bf16x8*)(wp0 + 16 * 256 + ks * 32); } }
    {
        const int c = tid & 255, hf = tid >> 8;
        float w[31];
#pragma unroll
        for (int k = 0; k < 31; ++k) w[k] = P.conf_dw[(size_t)(l * 31 + k) * WC + c];
        const float bias = P.conf_dw_b[l * WC + c];
#pragma unroll 1
        for (int sh = 0; sh < 2; ++sh) { const int t0 = 32 * hf + 16 * sh; float acc[16];
#pragma unroll
            for (int oo = 0; oo < 16; ++oo) acc[oo] = bias;
#pragma unroll
            for (int rr = 0; rr < 46; ++rr) { const float val = bf2f(*(const LAS bf16*)(lds + L_ZC + (t0 + rr) * 512 + c * 2));
#pragma unroll
                for (int oo = 0; oo < 16; ++oo) { if (rr - oo >= 0 && rr - oo <= 30) acc[oo] += val * w[rr - oo]; } }
#pragma unroll
            for (int oo = 0; oo < 16; ++oo) *(LAS float*)(lds + L_CT + (t0 + oo) * 1024 + c * 4) = acc[oo]; }
    }
    __syncthreads();
    {
        const f32x4 lg = *(const f32x4*)(P.conf_ln_g + l * WC + 4 * lane), lb = *(const f32x4*)(P.conf_ln_b + l * WC + 4 * lane);
#pragma unroll
        for (int i = 0; i < 8; ++i) { const int tok = 8 * wave + i; const f32x4 v = *(const LAS f32x4*)(lds + L_CT + tok * 1024 + lane * 16);
            const float mu = wave_sum((v[0] + v[1]) + (v[2] + v[3])) * (1.0f / 256.0f); const f32x4 dv = v - mu;
            const float var = wave_sum((dv[0] * dv[0] + dv[1] * dv[1]) + (dv[2] * dv[2] + dv[3] * dv[3])) * (1.0f / 256.0f);
            const float rstd = 1.0f / sqrtf(var + EPS_LN); float o4[4];
#pragma unroll
            for (int e = 0; e < 4; ++e) o4[e] = silu_fast(dv[e] * rstd * lg[e] + lb[e]);
            v2u ov; ov.x = pk2(o4[0], o4[1]); ov.y = pk2(o4[2], o4[3]);
            *(LAS v2u*)(lds + L_CLT + tok * T_STRIDE + lane * 8) = ov; }
    }
    __syncthreads();
    {
        const int fr = lane & 15, fq = lane >> 4;
        f32x4 acc[4][2];
#pragma unroll
        for (int m = 0; m < 4; ++m) { acc[m][0] = (f32x4){0.f, 0.f, 0.f, 0.f}; acc[m][1] = (f32x4){0.f, 0.f, 0.f, 0.f}; }
#pragma unroll
        for (int ks = 0; ks < 8; ++ks) {
#pragma unroll
            for (int m = 0; m < 4; ++m) { const bf16x8 A = *(const LAS bf16x8*)(lds + L_CLT + (16 * m + fr) * T_STRIDE + (ks * 32 + fq * 8) * 2);
                acc[m][0] = __builtin_amdgcn_mfma_f32_16x16x32_bf16(A, Bw[ks][0], acc[m][0], 0, 0, 0); acc[m][1] = __builtin_amdgcn_mfma_f32_16x16x32_bf16(A, Bw[ks][1], acc[m][1], 0, 0, 0); } }
#pragma unroll
        for (int ni = 0; ni < 2; ++ni) { const int ee = 16 * (2 * wave + ni) + fr;
#pragma unroll
            for (int m = 0; m < 4; ++m)
#pragma unroll
                for (int j = 0; j < 4; ++j) { const int tok = 16 * m + 4 * fq + j; LAS bf16* gp = (LAS bf16*)(lds + L_CG + tok * 512 + ee * 2); const float gt = bf2f(*gp);
                    *gp = (bf16)f2bf(acc[m][ni][j] * silu_fast(gt)); } }
    }
    __syncthreads();
    tile_out<32>(lds, L_CG, 512, Zg, r0, 768, tid);
    __syncthreads();
}

__device__ __forceinline__ void mixer_strip(LAS unsigned char* lds, const Ptrs& P, int l, int b, int ck, const bf16* UX, bf16* Zg, const bf16* GWS, const float* GB, const float* KC, const float* SUM,
                                            const bf16* PWt, const bf16* CPWt, int tid, int wave, int lane) {
    const int r0 = chunk_row0(b, ck), tpos0 = ck < 4 ? 64 * ck : 64 * (ck - 4), n = ck < 4 ? CTXL : SEQ;
    asm volatile("" : "+v"(tid)); lane = tid & 63; wave = __builtin_amdgcn_readfirstlane(tid >> 6);
    const float* sb = SUM + (size_t)b * NCHUNK * 2 * WL * 2;
    GateW w0; LookB lb0;
    gatew_load(w0, l, wave, 0, lane & 15, lane >> 4, GWS, GB, KC); lookb_load(lb0, 0, wave, 0, lane & 15, lane >> 4, sb);
    v4u gz[8];
#pragma unroll
    for (int i = 0; i < 8; ++i) gz[i] = *(const v4u*)(UX + (size_t)(r0 + 8 * (tid >> 6) + i) * NIN + C_GL + 8 * (tid & 63));
    strip_conv(lds, P, l, UX, r0, tpos0, n, tid);
#pragma unroll
    for (int i = 0; i < 8; ++i) *(LAS v4u*)(lds + L_GZ + (8 * (tid >> 6) + i) * XCT_STRIDE + (tid & 63) * 16) = gz[i];
    __syncthreads();
#ifndef NO_LRU
    lru_core<1>(lds, l, wave, lane, GWS, GB, KC, nullptr, sb, ck, w0, lb0);
#endif
    __syncthreads();
    tile_out<64>(lds, L_GZ, XCT_STRIDE, Zg, r0, 0, tid);
    __syncthreads();
#ifndef NO_POOL
    pool_part(lds, P, l, UX, PWt, Zg, r0, tpos0, n, tid, wave, lane);
#endif
#ifndef NO_CONF
    conf_part(lds, P, l, UX, CPWt, Zg, r0, tpos0, n, tid, wave, lane);
#endif
}

enum { K_PREP = 100, K_EMBED = 101 };
typedef const __attribute__((address_space(4))) Args* KArgs;
template <int KIND> __device__ __forceinline__ void run_phase(KArgs ap_in, LAS unsigned char* lds, const int l) {
    KArgs ap = ap_in; asm volatile("" : "+s"(ap));
    const Args args = *(const Args*)ap;
    const Ptrs& P = args.p;
    int tid_ = threadIdx.x; asm volatile("" : "+v"(tid_));
    const int tid = tid_, lane = tid & 63, wave = __builtin_amdgcn_readfirstlane(tid >> 6);
    const int G = gridDim.x, bx = blockIdx.x;
    const int gtid = bx * NT + tid, NTH = G * NT;
    const int gw = bx * 8 + wave, NGW = G * 8;
    unsigned char* ws = args.ws;
    float* MOD = (float*)(ws + WS_MOD);
    bf16* GW = (bf16*)(ws + WS_GW); bf16* PW = (bf16*)(ws + WS_PW); bf16* CPW = (bf16*)(ws + WS_CPW);
    bf16* WIN = (bf16*)(ws + WS_WIN); bf16* WOUT = (bf16*)(ws + WS_WOUT);
    bf16* HX = (bf16*)(ws + WS_HX); bf16* Z = HX; bf16* UX = (bf16*)(ws + WS_UX);
    float* XC = (float*)(ws + WS_R2); float* Y = (float*)(ws + WS_R2 + 36 * MiB);
    float* Dp = (float*)(ws + WS_R2); float* ZC = (float*)(ws + WS_R2 + 18 * MiB); float* CL = (float*)(ws + WS_R2 + 36 * MiB);
    float* O = (float*)(ws + WS_R2);
    float* CTXR = (float*)(ws + WS_CTXR); float* SUM = (float*)(ws + WS_SUM);
    float* out = args.out;

    {
        if constexpr (KIND == K_PREP) {
            LAS float* scr = (LAS float*)(lds + wave * 16384);
            constexpr int I_IN = 16 * 72, I_OUT = 16 * 32, I_CPW = 4 * 8, I_S = 2;
            constexpr int N_IN = 4 * I_IN, N_OUT = 4 * I_OUT, N_CPW = 4 * I_CPW, N_PW = 16 * I_S, N_GW = 64 * I_S;
            constexpr int NITEMS = N_IN + N_OUT + N_CPW + N_PW + 2 * N_GW;
            for (int it = gw; it < NITEMS; it += NGW) {
                int r = it;
                if (r < N_IN) { const int l = r / I_IN; transpose_item(P.w_in + (size_t)l * DM * NIN, DM, NIN, WIN + (size_t)l * NIN * DM, scr, r % I_IN, lane); continue; } r -= N_IN;
                if (r < N_OUT) { const int l = r / I_OUT; transpose_item(P.w_out + (size_t)l * DM * DM, DM, DM, WOUT + (size_t)l * DM * DM, scr, r % I_OUT, lane); continue; } r -= N_OUT;
                if (r < N_CPW) { const int l = r / I_CPW; transpose_item(P.conf_pw + (size_t)l * 65536, 256, 256, CPW + (size_t)l * 65536, scr, r % I_CPW, lane); continue; } r -= N_CPW;
                if (r < N_PW) { const int m = r / I_S; transpose_item(P.pool_w + (size_t)m * 4096, 64, 64, PW + (size_t)m * 4096, scr, r % I_S, lane); continue; } r -= N_PW;
                if (r < N_GW) { const int m = r / I_S; const int ld = m >> 3, h = m & 7;
                    transpose_item(P.lru_wa + (size_t)m * 4096, 64, 64, GW + (size_t)((ld * 2 + 0) * 8 + h) * 4096, scr, r % I_S, lane, -LOG2E); continue; } r -= N_GW;
                { const int m = r / I_S; const int ld = m >> 3, h = m & 7;
                    transpose_item(P.lru_wx + (size_t)m * 4096, 64, 64, GW + (size_t)((ld * 2 + 1) * 8 + h) * 4096, scr, r % I_S, lane, -LOG2E); }
            }
            for (int i = gtid; i < 4 * 2 * 2 * WL; i += NTH) { const int c = i & 511, gate = (i >> 9) & 1, ld = i >> 10;
                ((float*)(ws + WS_GB))[i] = -LOG2E * (gate ? P.lru_bx[ld * WL + c] : P.lru_ba[ld * WL + c]); }
            for (int i = gtid; i < 4 * 2 * WL; i += NTH) ((float*)(ws + WS_KC))[i] = -8.0f * LOG2E * log1pf(expf(-P.lru_lambda[i]));
            __syncthreads();
            LAS float* S = (LAS float*)lds;
            LAS float* RED = (LAS float*)(lds + 40960);
            for (int i = tid; i < 9 * 1024; i += NT) { const int r = i >> 10, k = i & 1023; const float v = r < 8 ? P.c[r * 1024 + k] : P.c_ctx[k]; S[i] = siluf_(v); }
            __syncthreads();
            for (int it = bx; it < 4 * 48; it += G) {
                const int l = it / 48, j0 = (it % 48) * 64, j = tid & 63, ks = tid >> 6;
                float acc[9];
#pragma unroll
                for (int r = 0; r < 9; ++r) acc[r] = 0.f;
                const float* wp = P.w_mod + (size_t)l * 1024 * 3072 + (size_t)(ks * 128) * 3072 + j0 + j;
#pragma unroll 4
                for (int k = 0; k < 128; ++k) { const float w = wp[(size_t)k * 3072];
#pragma unroll
                    for (int r = 0; r < 9; ++r) acc[r] += S[r * 1024 + ks * 128 + k] * w; }
#pragma unroll
                for (int r = 0; r < 9; ++r) RED[(ks * 9 + r) * 64 + j] = acc[r];
                __syncthreads();
                for (int i = tid; i < 9 * 64; i += NT) { const int r = i >> 6, jj = i & 63; float s = P.b_mod[l * 3072 + j0 + jj];
#pragma unroll
                    for (int q = 0; q < 8; ++q) s += RED[(q * 9 + r) * 64 + jj];
                    MOD[(size_t)(l * 9 + r) * 3072 + j0 + jj] = s; }
                __syncthreads();
            }
        } else if constexpr (KIND == K_EMBED) {
            for (int r = gw; r < MT; r += NGW) {
                int b, t, n, base; row_info(r, b, t, n, base);
                const bool isx = r < MX; const int mr = isx ? b : 8;
                const float* src = isx ? P.x + (size_t)r * DM : P.ctx + (size_t)(r - MX) * DM;
                float* dst = isx ? out + (size_t)r * DM : CTXR + (size_t)(r - MX) * DM;
                f32x4 v[4]; float ss = 0.f;
#pragma unroll
                for (int j = 0; j < 4; ++j) {
                    v[j] = *(const f32x4*)(src + 256 * j + 4 * lane);
                    if (isx) {
                        const float p = (j < 2) ? (float)(t >> 6) : (float)(t & 63);
#pragma unroll
                        for (int e = 0; e < 4; ++e) { const int i = 4 * lane + e; const float om = 1.0f / powf(10000.0f, (float)i / 256.0f); const float ang = p * om;
                            v[j][e] += (j & 1) ? cosf(ang) : sinf(ang); }
                    }
                    *(f32x4*)(dst + 256 * j + 4 * lane) = v[j];
                    ss += (v[j][0] * v[j][0] + v[j][1] * v[j][1]) + (v[j][2] * v[j][2] + v[j][3] * v[j][3]);
                }
                const float rstd = 1.0f / sqrtf(wave_sum(ss) * (1.0f / DM) + EPS_RMS);
                const float* sh = MOD + (size_t)(0 * 9 + mr) * 3072; const float* sc = sh + 1024;
#pragma unroll
                for (int j = 0; j < 4; ++j) { const int d0 = 256 * j + 4 * lane; float h[4];
#pragma unroll
                    for (int e = 0; e < 4; ++e) h[e] = v[j][e] * rstd * P.g_pre[d0 + e] * (1.0f + sc[d0 + e]) + sh[d0 + e];
                    uint2 w; w.x = pk2(h[0], h[1]); w.y = pk2(h[2], h[3]); *(uint2*)(HX + (size_t)r * DM + d0) = w; }
            }
        } else {
            constexpr int k = KIND;
            if constexpr (k == 0) {
                pg8::Gemm g{HX, WIN + (size_t)l * NIN * DM, MT, NIN, DM}; pg8::StaticOrder S; S.init(MT, NIN, G, bx);
                pg8::EpiBf16<0> E{UX, NIN, nullptr, 0, 0, 1.f};
                pg8::gemm_phase<pg8::EpiBf16<0>, pg8::StaticOrder, true, true>(lds, g, S, E);
            } else if constexpr (k == 2) {
                for (int sidx = bx; sidx < NB * NCHUNK; sidx += G) { const int b = sidx / NCHUNK, ck = sidx % NCHUNK;
                    const int r0 = chunk_row0(b, ck), tpos0 = ck < 4 ? 64 * ck : 64 * (ck - 4), n = ck < 4 ? CTXL : SEQ;
                    GateW w0; LookB lb0; gatew_load(w0, l, wave, 0, lane & 15, lane >> 4, GW, (const float*)(ws + WS_GB), (const float*)(ws + WS_KC));
                    strip_conv(lds, P, l, UX, r0, tpos0, n, tid);
                    __syncthreads();
                    lru_core<0>(lds, l, wave, lane, GW, (const float*)(ws + WS_GB), (const float*)(ws + WS_KC), SUM + (size_t)sidx * 2 * WL * 2, nullptr, 0, w0, lb0);
                    __syncthreads();
                }
            } else if constexpr (k == 3) {
                for (int sidx = bx; sidx < NB * NCHUNK; sidx += G) { const int b = sidx / NCHUNK, ck = sidx % NCHUNK;
                    if (l == DEPTH - 1 && ck < 4) continue;
                    mixer_strip(lds, P, l, b, ck, UX, Z, GW, (const float*)(ws + WS_GB), (const float*)(ws + WS_KC), SUM, PW, CPW, tid, wave, lane);
                }
            } else if constexpr (k == 7) {
                pg8::Gemm g{Z, WOUT + (size_t)l * DM * DM, MT, DM, DM}; pg8::StaticOrder S; S.init(MT, DM, G, bx);
                EpiF32 E{O, DM};
                pg8::gemm_phase<EpiF32, pg8::StaticOrder, true, true>(lds, g, S, E);
            } else {
                for (int r = gw; r < MT; r += NGW) {
                    const bool isx = r < MX; if (!isx && l == DEPTH - 1) continue;
                    const int b = isx ? (r >> 11) : ((r - MX) >> 8); const int mr = isx ? b : 8;
                    float* xr = isx ? out + (size_t)r * DM : CTXR + (size_t)(r - MX) * DM;
                    const float* orow = O + (size_t)r * DM; const float* gt = MOD + (size_t)(l * 9 + mr) * 3072 + 2048;
                    f32x4 o[4]; float ss = 0.f;
#pragma unroll
                    for (int j = 0; j < 4; ++j) { o[j] = *(const f32x4*)(orow + 256 * j + 4 * lane); ss += (o[j][0] * o[j][0] + o[j][1] * o[j][1]) + (o[j][2] * o[j][2] + o[j][3] * o[j][3]); }
                    const float rstd = 1.0f / sqrtf(wave_sum(ss) * (1.0f / DM) + EPS_RMS);
                    f32x4 v[4]; float s2 = 0.f;
#pragma unroll
                    for (int j = 0; j < 4; ++j) { const int d0 = 256 * j + 4 * lane; v[j] = *(const f32x4*)(xr + d0);
#pragma unroll
                        for (int e = 0; e < 4; ++e) v[j][e] += gt[d0 + e] * (o[j][e] * rstd * P.g_post[l * DM + d0 + e]);
                        *(f32x4*)(xr + d0) = v[j];
                        s2 += (v[j][0] * v[j][0] + v[j][1] * v[j][1]) + (v[j][2] * v[j][2] + v[j][3] * v[j][3]); }
                    if (l < DEPTH - 1) {
                        const float rs2 = 1.0f / sqrtf(wave_sum(s2) * (1.0f / DM) + EPS_RMS);
                        const float* sh = MOD + (size_t)((l + 1) * 9 + mr) * 3072; const float* sc = sh + 1024;
#pragma unroll
                        for (int j = 0; j < 4; ++j) { const int d0 = 256 * j + 4 * lane; float h[4];
#pragma unroll
                            for (int e = 0; e < 4; ++e) h[e] = v[j][e] * rs2 * P.g_pre[(l + 1) * DM + d0 + e] * (1.0f + sc[d0 + e]) + sh[d0 + e];
                            uint2 w; w.x = pk2(h[0], h[1]); w.y = pk2(h[2], h[3]); *(uint2*)(HX + (size_t)r * DM + d0) = w; }
                    }
                }
            }
        }
    }
}


#define XB_TMO      128
#define XB_XCNT(j)  (256  + 64 * (j))
#define XB_XSUB(j)  (1280 + 64 * (j))
#define XB_XGEN(j)  (2304 + 64 * (j))
#define XB_TOP      3328
#define XB_TOPGEN   3392
#define XCD_BAR_WORDS 3456
#define XB_SPIN_CAP (1u << 18)
constexpr int CW_BAR = 4096;
__device__ __forceinline__ unsigned xb_ld(unsigned* p)              { return __hip_atomic_load(p, __ATOMIC_RELAXED, __HIP_MEMORY_SCOPE_AGENT); }
__device__ __forceinline__ unsigned xb_add(unsigned* p, unsigned v) { return __hip_atomic_fetch_add(p, v, __ATOMIC_RELAXED, __HIP_MEMORY_SCOPE_AGENT); }
__device__ __forceinline__ unsigned xb_xcc_id() { return (unsigned)__builtin_amdgcn_s_getreg((3 << 11) | 20) & 0xFu; }
#define XB_SPIN(cond, bar) do { unsigned _sp = 0; while (cond) { __builtin_amdgcn_s_sleep(1); \
    if ((++_sp & 255u) == 0u) { if (xb_ld(&(bar)[XB_TMO])) break; if (_sp > XB_SPIN_CAP) { atomicAdd(&(bar)[XB_TMO], 1u); break; } } } } while (0)
struct XcdBarrier { unsigned* bar; unsigned x; volatile LAS unsigned* st; };
__device__ __forceinline__ XcdBarrier xcd_barrier_post(unsigned* bar, volatile LAS unsigned* st) {
    XcdBarrier b; b.bar = bar; b.x = xb_xcc_id(); b.st = st;
    if (threadIdx.x == 0) (void)xb_add(&bar[XB_XCNT(b.x)], 1u);
    return b;
}
__device__ __forceinline__ void xcd_barrier_complete(unsigned* bar, unsigned x, unsigned& nloc, unsigned& nx) {
    const unsigned G = gridDim.x * gridDim.y * gridDim.z;
    unsigned sum, cnt, mine, sp = 0u;
    for (;;) {
        sum = 0u; cnt = 0u; mine = 0u;
#pragma unroll
        for (unsigned j = 0; j < 16; ++j) { const unsigned c = xb_ld(&bar[XB_XCNT(j)]); sum += c; cnt += (c > 0u) ? 1u : 0u; mine = (j == x) ? c : mine; }
        if (sum == G) break;
        __builtin_amdgcn_s_sleep(1);
        if ((++sp & 255u) == 0u) { if (xb_ld(&bar[XB_TMO])) break; if (sp > XB_SPIN_CAP) { atomicAdd(&bar[XB_TMO], 1u); break; } }
    }
    nloc = mine > 0u ? mine : 1u; nx = cnt > 0u ? cnt : 1u;
}
__device__ __forceinline__ void xcd_barrier(const XcdBarrier& b) {
    asm volatile("s_waitcnt vmcnt(0)" ::: "memory");
    __syncthreads();
    if (threadIdx.x == 0) {
        unsigned* bar = b.bar;
        __builtin_amdgcn_s_waitcnt(0);
        unsigned nloc = b.st[0], nx = b.st[1];
        if (nloc == 0u) { xcd_barrier_complete(bar, b.x, nloc, nx); b.st[0] = nloc; b.st[1] = nx; }
        const unsigned old = xb_add(&bar[XB_XSUB(b.x)], 1u);
        const unsigned gen = old / nloc;
        if (old + 1u == (gen + 1u) * nloc) {
            __builtin_amdgcn_fence(__ATOMIC_RELEASE, "agent");
            asm volatile("s_waitcnt vmcnt(0)" ::: "memory");
            const unsigned og = xb_add(&bar[XB_TOP], 1u);
            const unsigned tg = og / nx;
            if (og + 1u == (tg + 1u) * nx) xb_add(&bar[XB_TOPGEN], 1u);
            else XB_SPIN(xb_ld(&bar[XB_TOPGEN]) == tg, bar);
            __builtin_amdgcn_fence(__ATOMIC_ACQUIRE, "agent");
            xb_add(&bar[XB_XGEN(b.x)], 1u);
            asm volatile("s_waitcnt vmcnt(0)" ::: "memory");
        } else {
            XB_SPIN(xb_ld(&bar[XB_XGEN(b.x)]) == gen, bar);
            __builtin_amdgcn_fence(__ATOMIC_ACQUIRE, "agent");
            asm volatile("s_waitcnt vmcnt(0)" ::: "memory");
        }
    }
    __syncthreads();
}

template <int KIND> __global__ void __launch_bounds__(NT, 2) fwd(Args args) {
    extern __shared__ __attribute__((aligned(16))) unsigned char lds_raw[];
    KArgs ap = (KArgs)__builtin_amdgcn_kernarg_segment_ptr();
    run_phase<KIND>(ap, (LAS unsigned char*)lds_raw, args.ph_lo);
}
#ifndef REP_BAR
#define REP_BAR 1
#endif
#ifndef REP_G1
#define REP_G1 1
#endif
#ifndef REP_S
#define REP_S 1
#endif
#ifndef REP_M
#define REP_M 1
#endif
#ifndef REP_G2
#define REP_G2 1
#endif
#define GRID_BAR() do { for (int rb_ = 0; rb_ < REP_BAR; ++rb_) xcd_barrier(bar); } while (0)
__global__ void __launch_bounds__(NT, 2) fwd_all(Args args) {
    extern __shared__ __attribute__((aligned(16))) unsigned char lds_raw[];
    LAS unsigned char* lds = (LAS unsigned char*)lds_raw;
    volatile LAS unsigned* MISC = (volatile LAS unsigned*)(lds + MISC_OFF);
    if (threadIdx.x < 32) MISC[threadIdx.x] = 0u;
    __syncthreads();
    KArgs ap = (KArgs)__builtin_amdgcn_kernarg_segment_ptr();
    XcdBarrier bar = xcd_barrier_post((unsigned*)(args.ws + WS_CTL) + CW_BAR, MISC + 8);
    run_phase<K_PREP>(ap, lds, 0); GRID_BAR();
    run_phase<K_EMBED>(ap, lds, 0); GRID_BAR();
#pragma unroll 1
    for (int l = 0; l < DEPTH; ++l) {
        for (int r_ = 0; r_ < REP_G1; ++r_) run_phase<0>(ap, lds, l); GRID_BAR();
        for (int r_ = 0; r_ < REP_S; ++r_) run_phase<2>(ap, lds, l); GRID_BAR();
        for (int r_ = 0; r_ < REP_M; ++r_) run_phase<3>(ap, lds, l); GRID_BAR();
        for (int r_ = 0; r_ < REP_G2; ++r_) run_phase<7>(ap, lds, l); GRID_BAR();
        run_phase<8>(ap, lds, l); if (l < DEPTH - 1) GRID_BAR();
    }
}

#ifndef N_LAUNCH_MODE
#define N_LAUNCH_MODE 1
#endif

extern "C" void kernel_launch(void* const* d_in, const int* in_sizes, int n_in, void* d_out, int out_size, void* d_ws, size_t ws_size, hipStream_t stream) {
    static int grid = 0, fused = 0;
    if (grid == 0) {
        if (n_in != 24 || in_sizes[0] != MX * DM || out_size != MX * DM || ws_size < WS_END) { fprintf(stderr, "kernel_launch: unexpected shapes (n_in %d, in0 %d, out %d, ws %zu)\n", n_in, n_in > 0 ? in_sizes[0] : -1, out_size, ws_size); grid = -1; return; }
        int dev = 0, cus = 0, per_cu = 0;
        if (hipGetDevice(&dev) != hipSuccess || hipDeviceGetAttribute(&cus, hipDeviceAttributeMultiprocessorCount, dev) != hipSuccess) { grid = -1; return; }
        bool ok = true;
#define SETA(F) ok = ok && (hipFuncSetAttribute((const void*)F, hipFuncAttributeMaxDynamicSharedMemorySize, LDS_BYTES) == hipSuccess)
        SETA(fwd<K_PREP>); SETA(fwd<K_EMBED>); SETA(fwd<0>); SETA(fwd<2>); SETA(fwd<3>); SETA(fwd<7>); SETA(fwd<8>); SETA(fwd_all);
        if (!ok) { fprintf(stderr, "kernel_launch: hipFuncSetAttribute failed\n"); grid = -1; return; }
        grid = cus;
        if (hipOccupancyMaxActiveBlocksPerMultiprocessor(&per_cu, (const void*)fwd_all, NT, LDS_BYTES) != hipSuccess) per_cu = 0;
        (void)hipGetLastError();
        fused = (N_LAUNCH_MODE == 1 && per_cu >= 1) ? 1 : 0;
        if (!fused) fprintf(stderr, "kernel_launch: falling back to one launch per phase (occupancy query: %d per CU)\n", per_cu);
    }
    if (grid < 0) return;
    (void)hipMemsetAsync((char*)d_ws + WS_CTL, 0, CTL_ZERO_BYTES, stream);
    Args a{};
    const float** pp = (const float**)&a.p;
    for (int i = 0; i < 24; ++i) pp[i] = (const float*)d_in[i];
    a.out = (float*)d_out; a.ws = (unsigned char*)d_ws;
    a.ph_lo = 0; a.ph_hi = 0;
    if (fused) { hipLaunchKernelGGL(fwd_all, dim3(grid), dim3(NT), LDS_BYTES, stream, a); return; }
#define LAUNCH(K) hipLaunchKernelGGL(fwd<K>, dim3(grid), dim3(NT), LDS_BYTES, stream, a)
    LAUNCH(K_PREP); LAUNCH(K_EMBED);
    for (int l = 0; l < DEPTH; ++l) { a.ph_lo = l; LAUNCH(0); LAUNCH(2); LAUNCH(3); LAUNCH(7); LAUNCH(8); }
}
```

```cpp
#include <hip/hip_runtime.h>
#include <cstdio>
#include <cstdint>
namespace pg8 {
#define PG8_LAS __attribute__((address_space(3)))
typedef unsigned short bf16_t;
typedef short bf16x8 __attribute__((ext_vector_type(8)));
typedef float f32x4 __attribute__((ext_vector_type(4)));
typedef unsigned u32x4 __attribute__((ext_vector_type(4)));
constexpr int BM = 256, BK = 64, HALF = 128, HTB = HALF * BK * 2  , STAGE_BYTES = 8 * HTB, NXCD = 8, WGM = 8;

__host__ __device__ __forceinline__ int lds_byte(int r, int c) { const int st = (r >> 4) * 2 + (c >> 5), rr = r & 15, cc = c & 31, ob = rr * 64 + cc * 2; return st * 1024 + (ob ^ (((ob >> 9) & 1) << 5)); }
__host__ __device__ __forceinline__ void stage_rc(int b, int& R, int& C) { const int st = b / 1024, sb = b % 1024, swz = sb ^ (((sb >> 9) & 1) << 5); R = (st >> 1) * 16 + swz / 64; C = (st & 1) * 32 + (swz % 64) / 2; }
__host__ __device__ __forceinline__ int perm32(int rho) { const int n = rho >> 4, i = rho & 15; return 8 * (i >> 2) + 4 * n + (i & 3); }

struct Unit { int pm, pn; };
struct Gemm { const bf16_t* A; const bf16_t* Bt; int M, N, K; };

struct StaticOrder {
    int nM, nN, nwg, G, c;
    __host__ __device__ void init(int M, int N, int G_, int c_) { nM = M / BM; nN = N / BM; nwg = nM * nN; G = G_; c = c_; }
    __host__ __device__ bool next(int i, Unit& u) const {
        const long L = (long)i * G + c; if (L >= nwg) return false;
        int wgid = (int)L; { const int q = nwg / NXCD, r = nwg % NXCD, xcd = wgid % NXCD, off = wgid / NXCD; wgid = (xcd < r ? xcd * (q + 1) : r * (q + 1) + (xcd - r) * q) + off; }
        const int nig = WGM * nN, gid = wgid / nig, fm = gid * WGM, gsz = (nM - fm) < WGM ? (nM - fm) : WGM;
        u.pm = fm + ((wgid % nig) % gsz); u.pn = (wgid % nig) / gsz; return true;
    }
    __device__ __forceinline__ void a_ready(const Unit&) const {}
    __device__ __forceinline__ void done(const Unit&) const {}
};

__device__ __forceinline__ unsigned cvt_pk_bf16(float lo, float hi) { unsigned r; asm volatile("v_cvt_pk_bf16_f32 %0, %1, %2" : "=v"(r) : "v"(lo), "v"(hi)); return r; }
typedef float f32x2 __attribute__((ext_vector_type(2)));
__device__ __forceinline__ f32x2 gelu_pk(f32x2 v) {
    const f32x2 av = __builtin_elementwise_abs(v), d = av * 0.2316418882f + 1.0f;
    f32x2 t; t.x = __builtin_amdgcn_rcpf(d.x); t.y = __builtin_amdgcn_rcpf(d.y);
    f32x2 q = t * 0.5307027145f + (-0.7265760135f); q = q * t + 0.7107068705f; q = q * t + (-0.142248368f); q = q * t + 0.127414796f; q = q * t;
    const f32x2 s = (v * v) * (-0.72134752044f);
    f32x2 e; e.x = __builtin_amdgcn_exp2f(s.x); e.y = __builtin_amdgcn_exp2f(s.y);
    const f32x2 m = v * (q * e), r = v - m;
    f32x2 o; o.x = v.x < 0.f ? m.x : r.x; o.y = v.y < 0.f ? m.y : r.y; return o;
}

template <int ACT  > struct EpiBf16 {
    static constexpr bool PERM = true, AFTER_DRAIN = false; static_assert(ACT == 0 || ACT == 1, "EpiBf16: ACT is 0 (none) or 1 (gelu_pk)");
    bf16_t* O; int ldc; const float* bias; int split_cols; size_t split_stride; float scale0;
    __device__ __forceinline__ void operator()(const f32x4 (&acc)[2][2][4][2], const Unit& u, int wr, int wc, int fr, int fq) const {
        const int row0 = u.pm * BM + wr * 64 + fr; int colt = u.pn * BM; bf16_t* base = O;
        float sc = 1.f; if (split_cols) { const int t = colt / split_cols; base += (size_t)t * split_stride; colt -= t * split_cols; if (t == 0) sc = scale0; }
        const int col0 = colt + wc * 32 + 8 * fq, bcol0 = u.pn * BM + wc * 32 + 8 * fq;
        f32x4 bv[2][2];
#pragma unroll
        for (int bj = 0; bj < 2; ++bj)
#pragma unroll
            for (int n = 0; n < 2; ++n) bv[bj][n] = bias ? *(const f32x4*)(bias + bcol0 + bj * HALF + 4 * n) : (f32x4){0.f, 0.f, 0.f, 0.f};
#pragma unroll
        for (int ai = 0; ai < 2; ++ai)
#pragma unroll
            for (int m = 0; m < 4; ++m) { bf16_t* rowp = base + (size_t)(row0 + ai * HALF + m * 16) * ldc + col0;
#pragma unroll
                for (int bj = 0; bj < 2; ++bj) { f32x4 v0 = acc[ai][bj][m][0] + bv[bj][0], v1 = acc[ai][bj][m][1] + bv[bj][1];
                    if (ACT == 1) { f32x2 a = gelu_pk((f32x2){v0[0], v0[1]}), b = gelu_pk((f32x2){v0[2], v0[3]}), c = gelu_pk((f32x2){v1[0], v1[1]}), d = gelu_pk((f32x2){v1[2], v1[3]});
                        v0 = (f32x4){a.x, a.y, b.x, b.y}; v1 = (f32x4){c.x, c.y, d.x, d.y}; }
                    v0 = v0 * sc; v1 = v1 * sc; u32x4 w; w.x = cvt_pk_bf16(v0[0], v0[1]); w.y = cvt_pk_bf16(v0[2], v0[3]); w.z = cvt_pk_bf16(v1[0], v1[1]); w.w = cvt_pk_bf16(v1[2], v1[3]);
                    *(u32x4*)(rowp + bj * HALF) = w; } }
    }
};

struct PanelStats {
    unsigned* xbuf;
    unsigned* cnt;
    unsigned* tmo;
    int ntn; float eps;
    unsigned code;
    __device__ __forceinline__ bool run(const f32x4 (&v)[2][2][4][2], const Unit& u, int wr, int wc, int fr, int fq, PG8_LAS unsigned char* lds, int wid, int lane) const {
        typedef float f32x2v __attribute__((ext_vector_type(2)));
        PG8_LAS f32x2v* P = (PG8_LAS f32x2v*)lds;
        PG8_LAS f32x2v* S = (PG8_LAS f32x2v*)(lds + 8192);
        PG8_LAS unsigned* flag = (PG8_LAS unsigned*)(lds + 8192 + 2048);
#pragma unroll
        for (int ai = 0; ai < 2; ++ai)
#pragma unroll
            for (int m = 0; m < 4; ++m) {
                float s = 0.f;
#pragma unroll
                for (int bj = 0; bj < 2; ++bj)
#pragma unroll
                    for (int n = 0; n < 2; ++n) { const f32x4 x = v[ai][bj][m][n]; s += (x[0] + x[1]) + (x[2] + x[3]); }
                s += __shfl_xor(s, 16); s += __shfl_xor(s, 32);
                const float mw = s * (1.0f / 64.0f); float q = 0.f;
#pragma unroll
                for (int bj = 0; bj < 2; ++bj)
#pragma unroll
                    for (int n = 0; n < 2; ++n) { const f32x4 d = v[ai][bj][m][n] - mw; q += (d[0] * d[0] + d[1] * d[1]) + (d[2] * d[2] + d[3] * d[3]); }
                q += __shfl_xor(q, 16); q += __shfl_xor(q, 32);
                if (fq == 0) P[(ai * HALF + wr * 64 + m * 16 + fr) * 4 + wc] = (f32x2v){mw, q};
            }
        asm volatile("s_waitcnt lgkmcnt(0)" ::: "memory"); __builtin_amdgcn_s_barrier(); asm volatile("" ::: "memory");
#if defined(BROKEN_EXCHANGE_NO_WAIT)
#warning BROKEN CONTROL BUILD: the row-statistics exchange does not wait; results are wrong by design
        if (blockIdx.x >= 64) { const long long t0_ = clock64(); while (clock64() - t0_ < 60000) __builtin_amdgcn_s_sleep(8); }
#endif
        const int row = wid * 32 + (lane & 31);
        if (lane < 32) {
            const f32x2v a = P[row * 4 + 0], b = P[row * 4 + 1], c = P[row * 4 + 2], d = P[row * 4 + 3];
            const float mt = (a.x + b.x + c.x + d.x) * 0.25f;
            const float da = a.x - mt, db = b.x - mt, dc = c.x - mt, dd = d.x - mt;
            const float m2 = (a.y + b.y) + (c.y + d.y) + 64.0f * ((da * da + db * db) + (dc * dc + dd * dd));
            unsigned long long* slot = (unsigned long long*)xbuf + ((size_t)(u.pm * BM + row) * 4 + u.pn);
            __hip_atomic_store(slot, ((unsigned long long)__float_as_uint(m2) << 32) | __float_as_uint(mt), __ATOMIC_RELAXED, __HIP_MEMORY_SCOPE_AGENT);
        }
        asm volatile("s_waitcnt vmcnt(0)" ::: "memory");
        if (lane == 0) __hip_atomic_fetch_add(cnt + 64 * u.pm, 1u, __ATOMIC_RELAXED, __HIP_MEMORY_SCOPE_AGENT);
        if (wid == 0) {
            bool dead = false; const unsigned long long t0 = __builtin_amdgcn_s_memrealtime(); const unsigned want = 8u * (unsigned)ntn;
            for (;;) {
#if defined(BROKEN_EXCHANGE_NO_WAIT)
                break;
#endif
                if ((unsigned)__builtin_amdgcn_readfirstlane(__hip_atomic_load(cnt + 64 * u.pm, __ATOMIC_RELAXED, __HIP_MEMORY_SCOPE_AGENT)) >= want) break;
                if (__builtin_amdgcn_s_memrealtime() - t0 > 2000000ull) {
                    if (lane == 0) { unsigned expect = 0u; __hip_atomic_compare_exchange_strong(tmo + 1, &expect, code | (unsigned)(u.pm & 0xff), __ATOMIC_RELAXED, __ATOMIC_RELAXED, __HIP_MEMORY_SCOPE_AGENT);
                                     __hip_atomic_store(tmo, 1u, __ATOMIC_RELAXED, __HIP_MEMORY_SCOPE_AGENT); }
                    dead = true; break; }
                __builtin_amdgcn_s_sleep(2);
            }
            __builtin_amdgcn_fence(__ATOMIC_ACQUIRE, "agent");
            if (lane == 0) flag[0] = dead ? 1u : 0u;
        }
        asm volatile("s_waitcnt vmcnt(0) lgkmcnt(0)" ::: "memory"); __builtin_amdgcn_s_barrier(); asm volatile("" ::: "memory");
        const bool bad = flag[0] != 0u;
        if (lane < 32) {
            const unsigned long long* slot = (const unsigned long long*)xbuf + (size_t)(u.pm * BM + row) * 4; float mt[4], m2[4]; float ms = 0.f;
#pragma unroll
            for (int t = 0; t < 4; ++t) { if (t < ntn) { const unsigned long long w = __hip_atomic_load(slot + t, __ATOMIC_RELAXED, __HIP_MEMORY_SCOPE_AGENT); mt[t] = __uint_as_float((unsigned)w); m2[t] = __uint_as_float((unsigned)(w >> 32)); } else { mt[t] = 0.f; m2[t] = 0.f; } ms += mt[t]; }
            const float mean = ms / (float)ntn; float q = 0.f;
#pragma unroll
            for (int t = 0; t < 4; ++t) if (t < ntn) { const float dm = mt[t] - mean; q += m2[t] + 256.0f * dm * dm; }
            S[row] = (f32x2v){mean, 1.0f / sqrtf(q / (256.0f * (float)ntn) + eps)};
        }
        asm volatile("s_waitcnt lgkmcnt(0)" ::: "memory"); __builtin_amdgcn_s_barrier(); asm volatile("" ::: "memory");
        return bad;
    }
};
struct EpiLnRes {
    static constexpr bool PERM = false, AFTER_DRAIN = true;
    const float* base; float* out; int ldc; const float* bias; PanelStats st; unsigned poison;
    __device__ __forceinline__ void fused(f32x4 (&acc)[2][2][4][2], const Unit& u, int wr, int wc, int fr, int fq, PG8_LAS unsigned char* lds, int wid, int lane) const {
        typedef float f32x2v __attribute__((ext_vector_type(2)));
        const PG8_LAS f32x2v* S = (const PG8_LAS f32x2v*)(lds + 8192);
        const int col0 = u.pn * BM + wc * 32 + 4 * fq;
#pragma unroll
        for (int bj = 0; bj < 2; ++bj)
#pragma unroll
            for (int n = 0; n < 2; ++n) { const f32x4 bv = bias ? *(const f32x4*)(bias + col0 + bj * HALF + n * 16) : (f32x4){0.f, 0.f, 0.f, 0.f};
#pragma unroll
                for (int ai = 0; ai < 2; ++ai)
#pragma unroll
                    for (int m = 0; m < 4; ++m) acc[ai][bj][m][n] += bv; }
        f32x4 pre[4][2][2];
#pragma unroll
        for (int m = 0; m < 4; ++m) { const size_t off = (size_t)(u.pm * BM + wr * 64 + m * 16 + fr) * ldc + col0;
#pragma unroll
            for (int bj = 0; bj < 2; ++bj)
#pragma unroll
                for (int n = 0; n < 2; ++n) pre[m][bj][n] = *(const f32x4*)(base + off + bj * HALF + n * 16); }
        const bool bad = st.run(acc, u, wr, wc, fr, fq, lds, wid, lane) || poison != 0u;
        const float qnan = __builtin_nanf("");
#pragma unroll
        for (int ai = 0; ai < 2; ++ai)
#pragma unroll
            for (int m = 0; m < 4; ++m) { const int r = ai * HALF + wr * 64 + m * 16 + fr; const f32x2v sr = S[r]; const size_t off = (size_t)(u.pm * BM + r) * ldc + col0;
#pragma unroll
                for (int bj = 0; bj < 2; ++bj)
#pragma unroll
                    for (int n = 0; n < 2; ++n) { const f32x4 bs = ai == 0 ? pre[m][bj][n] : *(const f32x4*)(base + off + bj * HALF + n * 16); f32x4 o = bs + (acc[ai][bj][m][n] - sr.x) * sr.y;
                        if (bad) o = (f32x4){qnan, qnan, qnan, qnan}; *(f32x4*)(out + off + bj * HALF + n * 16) = o; }
                if (m & 1) asm volatile("" ::: "memory"); }
    }
};
struct EpiLnResLn {
    static constexpr bool PERM = false, AFTER_DRAIN = true;
    const float* base; float* out; bf16_t* xn; int ldc; const float* bias; PanelStats st1, st2; unsigned poison;
    __device__ __forceinline__ void fused(f32x4 (&acc)[2][2][4][2], const Unit& u, int wr, int wc, int fr, int fq, PG8_LAS unsigned char* lds, int wid, int lane) const {
        typedef float f32x2v __attribute__((ext_vector_type(2))); typedef unsigned u32x2v __attribute__((ext_vector_type(2)));
        const PG8_LAS f32x2v* S = (const PG8_LAS f32x2v*)(lds + 8192);
        const int col0 = u.pn * BM + wc * 32 + 4 * fq;
#pragma unroll
        for (int bj = 0; bj < 2; ++bj)
#pragma unroll
            for (int n = 0; n < 2; ++n) { const f32x4 bv = bias ? *(const f32x4*)(bias + col0 + bj * HALF + n * 16) : (f32x4){0.f, 0.f, 0.f, 0.f};
#pragma unroll
                for (int ai = 0; ai < 2; ++ai)
#pragma unroll
                    for (int m = 0; m < 4; ++m) acc[ai][bj][m][n] += bv; }
        bool bad = st1.run(acc, u, wr, wc, fr, fq, lds, wid, lane) || poison != 0u;
        const float qnan = __builtin_nanf("");
#pragma unroll
        for (int ai = 0; ai < 2; ++ai)
#pragma unroll
            for (int m = 0; m < 4; ++m) { const int r = ai * HALF + wr * 64 + m * 16 + fr; const f32x2v sr = S[r]; const size_t off = (size_t)(u.pm * BM + r) * ldc + col0;
#pragma unroll
                for (int bj = 0; bj < 2; ++bj)
#pragma unroll
                    for (int n = 0; n < 2; ++n) { const f32x4 bs = *(const f32x4*)(base + off + bj * HALF + n * 16); acc[ai][bj][m][n] = bs + (acc[ai][bj][m][n] - sr.x) * sr.y; }
                asm volatile("" : "+v"(acc[ai][0][m][0]), "+v"(acc[ai][0][m][1]), "+v"(acc[ai][1][m][0]), "+v"(acc[ai][1][m][1]));
                if (m & 1) asm volatile("" ::: "memory"); }
        const bool bad1 = bad;
        bad = st2.run(acc, u, wr, wc, fr, fq, lds, wid, lane) || bad;
#pragma unroll
        for (int ai = 0; ai < 2; ++ai)
#pragma unroll
            for (int m = 0; m < 4; ++m) { const int r = ai * HALF + wr * 64 + m * 16 + fr; const f32x2v sr = S[r]; const size_t off = (size_t)(u.pm * BM + r) * ldc + col0;
#pragma unroll
                for (int bj = 0; bj < 2; ++bj)
#pragma unroll
                    for (int n = 0; n < 2; ++n) { const f32x4 x1 = acc[ai][bj][m][n]; *(f32x4*)(out + off + bj * HALF + n * 16) = bad1 ? (f32x4){qnan, qnan, qnan, qnan} : x1;
                        const f32x4 o = (x1 - sr.x) * sr.y; u32x2v w; w.x = cvt_pk_bf16(o[0], o[1]); w.y = cvt_pk_bf16(o[2], o[3]);
                        if (bad) { w.x = 0x7fc07fc0u; w.y = 0x7fc07fc0u; } *(u32x2v*)(xn + off + bj * HALF + n * 16) = w; }
                asm volatile("" ::: "memory"); }
    }
};

template <class Epi, class Sched, bool ALIGN_EPI = false, bool SP2 = false>
__device__ __forceinline__ void gemm_phase(PG8_LAS unsigned char* lds, const Gemm g, const Sched& S, const Epi& E) {
    int tid_ = threadIdx.x; asm volatile("" : "+v"(tid_));
    const int tid = tid_, wid = __builtin_amdgcn_readfirstlane(tid >> 6), lane = tid & 63, wr = wid >> 2, wc = wid & 3, fr = lane & 15, fq = lane >> 4;
    const int K = g.K, nt = K / BK;
    unsigned voffA[2], voffB[2];
#pragma unroll
    for (int i = 0; i < 2; ++i) { int R, C; stage_rc(tid * 16 + i * 8192, R, C); const int Rb = Epi::PERM ? ((R & ~31) + perm32(R & 31)) : R;
        voffA[i] = (unsigned)(R * K + C) * 2u; voffB[i] = (unsigned)(Rb * K + C) * 2u; }
    const size_t kstep = (size_t)(BK * 2);
    const size_t hstep = (size_t)HALF * K * 2;
    const size_t tstep = 2 * hstep;
    const unsigned ldsw = (unsigned)wid * 1024u;
    const int aoff = lds_byte(wr * 64 + fr, fq * 8), boff = lds_byte(wc * 32 + fr, fq * 8);
#define PG8_SA(b, h) (((b) * 2 + (h)) * HTB)
#define PG8_SB(b, h) ((4 + (b) * 2 + (h)) * HTB)
#define PG8_STAGE(bufoff, gbase, voff) do { _Pragma("unroll") for (int _i = 0; _i < 2; ++_i) \
        __builtin_amdgcn_global_load_lds((const unsigned*)((const char*)(gbase) + (voff)[_i]), (PG8_LAS unsigned*)(lds + (bufoff) + ldsw + _i * 8192), 16, 0, 0); } while (0)
#define PG8_LDA(dst, b, h) do { _Pragma("unroll") for (int m = 0; m < 4; ++m) _Pragma("unroll") for (int k = 0; k < 2; ++k) dst[m][k] = *(const PG8_LAS bf16x8*)(lds + PG8_SA(b, h) + aoff + m * 2048 + k * 1024); } while (0)
#define PG8_LDB(dst, b, h) do { _Pragma("unroll") for (int n = 0; n < 2; ++n) _Pragma("unroll") for (int k = 0; k < 2; ++k) dst[n][k] = *(const PG8_LAS bf16x8*)(lds + PG8_SB(b, h) + boff + n * 2048 + k * 1024); } while (0)
#define PG8_MMA(ai, bj, At, Bt) do { __builtin_amdgcn_s_setprio(1); _Pragma("unroll") for (int m = 0; m < 4; ++m) _Pragma("unroll") for (int n = 0; n < 2; ++n) _Pragma("unroll") for (int k = 0; k < 2; ++k) \
        acc[ai][bj][m][n] = __builtin_amdgcn_mfma_f32_16x16x32_bf16(Bt[n][k], At[m][k], acc[ai][bj][m][n], 0, 0, 0); __builtin_amdgcn_s_setprio(0); } while (0)
#define PG8_WAIT_V(n) asm volatile("s_waitcnt vmcnt(" #n ")" ::: "memory")
#define PG8_WAIT_L(n) asm volatile("s_waitcnt lgkmcnt(" #n ")" ::: "memory")
#define PG8_BAR __builtin_amdgcn_s_barrier()
#define PG8_SCHED __builtin_amdgcn_sched_barrier(0)
    Unit cur, nxt; int ui = 0;
    if (!S.next(0, cur)) return;
    f32x4 acc[2][2][4][2];
#pragma unroll
    for (int a = 0; a < 2; ++a)
#pragma unroll
        for (int b = 0; b < 2; ++b)
#pragma unroll
            for (int m = 0; m < 4; ++m)
#pragma unroll
                for (int n = 0; n < 2; ++n) acc[a][b][m][n] = (f32x4){0.f, 0.f, 0.f, 0.f};
    bf16x8 At[4][2], B0[2][2], B1[2][2];
    const char* cA = (const char*)g.A + (size_t)cur.pm * tstep; const char* cB = (const char*)g.Bt + (size_t)cur.pn * tstep;
    S.a_ready(cur);
    if constexpr (SP2) {
        PG8_STAGE(PG8_SB(0, 0), cB, voffB); PG8_STAGE(PG8_SB(0, 1), cB + hstep, voffB); PG8_STAGE(PG8_SA(0, 0), cA, voffA); PG8_STAGE(PG8_SA(0, 1), cA + hstep, voffA);
        if (wr == 1) PG8_BAR;
        PG8_WAIT_V(2); PG8_BAR;
        PG8_STAGE(PG8_SB(1, 0), cB + kstep, voffB); PG8_STAGE(PG8_SA(1, 0), cA + kstep, voffA); PG8_STAGE(PG8_SB(1, 1), cB + hstep + kstep, voffB);
        PG8_WAIT_V(6); PG8_BAR;
    } else {
        PG8_STAGE(PG8_SB(0, 0), cB, voffB); PG8_STAGE(PG8_SA(0, 0), cA, voffA); PG8_STAGE(PG8_SB(0, 1), cB + hstep, voffB); PG8_STAGE(PG8_SA(0, 1), cA + hstep, voffA);
        if (wr == 1) PG8_BAR;
        PG8_WAIT_V(4); PG8_BAR;
        PG8_STAGE(PG8_SB(1, 0), cB + kstep, voffB); PG8_STAGE(PG8_SA(1, 0), cA + kstep, voffA); PG8_STAGE(PG8_SB(1, 1), cB + hstep + kstep, voffB);
        PG8_WAIT_V(6); PG8_BAR;
    }
    for (;;) {
        const bool has_next = S.next(ui + 1, nxt);
        const char* nA = has_next ? (const char*)g.A + (size_t)nxt.pm * tstep : cA; const char* nB = has_next ? (const char*)g.Bt + (size_t)nxt.pn * tstep : cB;
        for (int t = 0; t < nt; t += 2) {
            const bool last = (t == nt - 2);
            const char* a1 = cA + (size_t)(t + 1) * kstep;
            const char* a2 = last ? nA : cA + (size_t)(t + 2) * kstep; const char* b2 = last ? nB : cB + (size_t)(t + 2) * kstep;
            const char* a3 = a2 + kstep; const char* b3 = b2 + kstep;
            if (last && has_next) S.a_ready(nxt);
            if constexpr (SP2) {
            PG8_LDB(B0, 0, 0); PG8_LDB(B1, 0, 1); PG8_SCHED; PG8_LDA(At, 0, 0); PG8_STAGE(PG8_SA(1, 1), a1 + hstep, voffA);
            PG8_WAIT_V(8); PG8_WAIT_L(0); PG8_BAR; PG8_MMA(0, 0, At, B0); PG8_MMA(0, 1, At, B1); PG8_BAR; PG8_SCHED;
            PG8_LDA(At, 0, 1); PG8_STAGE(PG8_SB(0, 0), b2, voffB); PG8_STAGE(PG8_SB(0, 1), b2 + hstep, voffB); PG8_STAGE(PG8_SA(0, 0), a2, voffA);
            PG8_WAIT_V(8); PG8_WAIT_L(0); PG8_BAR; PG8_MMA(1, 0, At, B0); PG8_MMA(1, 1, At, B1); PG8_BAR; PG8_SCHED;
            PG8_LDB(B0, 1, 0); PG8_LDB(B1, 1, 1); PG8_SCHED; PG8_LDA(At, 1, 0); PG8_STAGE(PG8_SA(0, 1), a2 + hstep, voffA);
            PG8_WAIT_V(8); PG8_WAIT_L(0); PG8_BAR; PG8_MMA(0, 0, At, B0); PG8_MMA(0, 1, At, B1); PG8_BAR; PG8_SCHED;
            PG8_LDA(At, 1, 1); PG8_STAGE(PG8_SB(1, 0), b3, voffB); PG8_STAGE(PG8_SB(1, 1), b3 + hstep, voffB); PG8_STAGE(PG8_SA(1, 0), a3, voffA);
            PG8_WAIT_V(8); PG8_WAIT_L(0); PG8_BAR; PG8_MMA(1, 0, At, B0); PG8_MMA(1, 1, At, B1); PG8_BAR; PG8_SCHED;
            } else {
            PG8_LDB(B0, 0, 0); PG8_SCHED; PG8_LDA(At, 0, 0); PG8_STAGE(PG8_SA(1, 1), a1 + hstep, voffA);
            PG8_WAIT_L(8); PG8_BAR; PG8_WAIT_L(0); PG8_MMA(0, 0, At, B0); PG8_BAR; PG8_SCHED;
            PG8_LDB(B1, 0, 1); PG8_STAGE(PG8_SB(0, 0), b2, voffB);
            PG8_BAR; PG8_WAIT_L(0); PG8_MMA(0, 1, At, B1); PG8_BAR;
            PG8_LDA(At, 0, 1); PG8_STAGE(PG8_SA(0, 0), a2, voffA);
            PG8_BAR; PG8_WAIT_L(0); PG8_MMA(1, 0, At, B0); PG8_BAR; PG8_SCHED;
            PG8_STAGE(PG8_SB(0, 1), b2 + hstep, voffB);
            PG8_WAIT_V(6); PG8_BAR; PG8_MMA(1, 1, At, B1); PG8_BAR;
            PG8_LDB(B0, 1, 0); PG8_SCHED; PG8_LDA(At, 1, 0); PG8_STAGE(PG8_SA(0, 1), a2 + hstep, voffA);
            PG8_WAIT_L(8); PG8_BAR; PG8_WAIT_L(0); PG8_MMA(0, 0, At, B0); PG8_BAR; PG8_SCHED;
            PG8_LDB(B1, 1, 1); PG8_STAGE(PG8_SB(1, 0), b3, voffB);
            PG8_BAR; PG8_WAIT_L(0); PG8_MMA(0, 1, At, B1); PG8_BAR;
            PG8_LDA(At, 1, 1); PG8_STAGE(PG8_SA(1, 0), a3, voffA);
            PG8_BAR; PG8_WAIT_L(0); PG8_MMA(1, 0, At, B0); PG8_BAR; PG8_SCHED;
            PG8_STAGE(PG8_SB(1, 1), b3 + hstep, voffB);
            PG8_WAIT_V(6); PG8_BAR; PG8_MMA(1, 1, At, B1); PG8_BAR;
            }
        }
        if constexpr (ALIGN_EPI) { if (wr == 0) PG8_BAR; }
        if constexpr (!Epi::AFTER_DRAIN) { E(acc, cur, wr, wc, fr, fq); S.done(cur); }
        if (!has_next) break;
#pragma unroll
        for (int a = 0; a < 2; ++a)
#pragma unroll
            for (int b = 0; b < 2; ++b)
#pragma unroll
                for (int m = 0; m < 4; ++m)
#pragma unroll
                    for (int n = 0; n < 2; ++n) acc[a][b][m][n] = (f32x4){0.f, 0.f, 0.f, 0.f};
        cur = nxt; cA = nA; cB = nB; ++ui;
        if constexpr (ALIGN_EPI) { if (wr == 1) PG8_BAR; }
    }
    PG8_WAIT_V(0);
    if constexpr (!ALIGN_EPI) { if (wr == 0) PG8_BAR; }
    PG8_BAR;
    if constexpr (Epi::AFTER_DRAIN) { E.fused(acc, cur, wr, wc, fr, fq, lds, wid, lane); S.done(cur); }
#undef PG8_SA
#undef PG8_SB
#undef PG8_STAGE
#undef PG8_LDA
#undef PG8_LDB
#undef PG8_MMA
#undef PG8_WAIT_V
#undef PG8_WAIT_L
#undef PG8_BAR
#undef PG8_SCHED
}
}

constexpr int DM = 1024, NB = 8, SEQ = 2048, DEPTH = 4, CTXL = 256, NIN = 2304;
constexpr int MX = NB * SEQ, MC = NB * CTXL, MT = MX + MC;
constexpr int WL = 512, WP = 256, WC = 256;
constexpr int C_VL = 0, C_GL = 512, C_VP = 1024, C_GP = 1280, C_VC = 1536, C_GG = 1792, C_GC = 2048;
constexpr int NCHUNK = 36;
constexpr float EPS_RMS = 1e-6f, EPS_LN = 1e-5f;

constexpr size_t MiB = 1u << 20;
constexpr size_t WS_CTL = 0, CTL_ZERO_BYTES = 1 * MiB;
constexpr size_t WS_MOD = 1 * MiB;
constexpr size_t WS_GB = 1 * MiB + 512 * 1024;
constexpr size_t WS_KC = WS_GB + 32768;
constexpr float LOG2E = 1.4426950408889634f;
constexpr size_t WS_GW = 2 * MiB;
constexpr size_t WS_PW = 3 * MiB;
constexpr size_t WS_CPW = 3 * MiB + 512 * 1024;
constexpr size_t WS_WIN = 4 * MiB;
constexpr size_t WS_WOUT = 22 * MiB;
constexpr size_t WS_HX = 30 * MiB;
constexpr size_t WS_UX = 66 * MiB;
constexpr size_t WS_R2 = 147 * MiB;
constexpr size_t WS_CTXR = 219 * MiB;
constexpr size_t WS_SUM = 227 * MiB;
constexpr size_t WS_END = 230 * MiB;

constexpr int LDS_BYTES = 147456;
constexpr int MISC_OFF = LDS_BYTES - 256;
constexpr int NT = 512;

#define GAS __attribute__((address_space(1)))
#define LAS __attribute__((address_space(3)))
typedef unsigned short bf16;
typedef unsigned v4u __attribute__((ext_vector_type(4)));
typedef float f32x4 __attribute__((ext_vector_type(4)));
typedef unsigned v2u __attribute__((ext_vector_type(2)));
#define LDS_WAIT() asm volatile("s_waitcnt lgkmcnt(0)" ::: "memory")
#define VM_WAIT() asm volatile("s_waitcnt vmcnt(0)" ::: "memory")

__device__ __forceinline__ unsigned f2bf(float f) { unsigned u = __builtin_bit_cast(unsigned, f); return (u + 0x7fffu + ((u >> 16) & 1u)) >> 16; }
__device__ __forceinline__ unsigned pk2(float lo, float hi) { return f2bf(lo) | (f2bf(hi) << 16); }
__device__ __forceinline__ float bf2f(bf16 v) { return __builtin_bit_cast(float, (unsigned)v << 16); }
__device__ __forceinline__ float sigmoidf_(float v) { return 1.0f / (1.0f + expf(-v)); }
__device__ __forceinline__ float siluf_(float v) { return v / (1.0f + expf(-v)); }
__device__ __forceinline__ float wave_sum(float v) {
#pragma unroll
    for (int o = 1; o < 64; o <<= 1) v += __shfl_xor(v, o);
    return v;
}

struct Ptrs {
    const float *x, *c, *ctx, *c_ctx, *w_mod, *b_mod, *g_pre, *w_in, *lru_conv_w, *lru_conv_b, *lru_wa, *lru_ba, *lru_wx, *lru_bx, *lru_lambda,
        *pool_w, *pool_scale, *conf_dw, *conf_dw_b, *conf_ln_g, *conf_ln_b, *conf_pw, *w_out, *g_post;
};
struct Args { Ptrs p; float* out; unsigned char* ws; int ph_lo, ph_hi; };

__device__ __forceinline__ void row_info(int r, int& b, int& t, int& n, int& base) {
    if (r < MX) { b = r >> 11; t = r & 2047; n = SEQ; base = b << 11; }
    else { const int rc = r - MX; b = rc >> 8; t = rc & 255; n = CTXL; base = MX + (b << 8); }
}
__device__ __forceinline__ int chunk_row0(int b, int ck) { return ck < 4 ? MX + b * CTXL + 64 * ck : b * SEQ + 64 * (ck - 4); }

__device__ __forceinline__ void transpose_item(const float* W, int K, int N, bf16* WT, LAS float* scr, int item, int lane, float scale = 1.0f) {
    const int nblk = N / 32, kb = item / nblk, nb = item % nblk, k0 = 64 * kb, n0 = 32 * nb;
#pragma unroll 8
    for (int i = 0; i < 32; ++i) { const int kk = 2 * i + (lane >> 5); scr[kk * 33 + (lane & 31)] = W[(size_t)(k0 + kk) * N + n0 + (lane & 31)] * scale; }
    LDS_WAIT(); asm volatile("" ::: "memory");
    const int c = lane & 7;
#pragma unroll
    for (int j = 0; j < 4; ++j) { const int n = (lane >> 3) + 8 * j; const LAS float* s = scr + (8 * c) * 33 + n;
        v4u o; o.x = pk2(s[0 * 33], s[1 * 33]); o.y = pk2(s[2 * 33], s[3 * 33]); o.z = pk2(s[4 * 33], s[5 * 33]); o.w = pk2(s[6 * 33], s[7 * 33]);
        *(GAS v4u*)(WT + (size_t)(n0 + n) * K + k0 + 8 * c) = o; }
    LDS_WAIT(); asm volatile("" ::: "memory");
}

struct EpiF32 {
    static constexpr bool PERM = false, AFTER_DRAIN = false;
    float* O; int ldc;
    __device__ __forceinline__ void operator()(const pg8::f32x4 (&acc)[2][2][4][2], const pg8::Unit& u, int wr, int wc, int fr, int fq) const {
        const int row0 = u.pm * 256 + wr * 64 + fr, col0 = u.pn * 256 + wc * 32 + 4 * fq;
#pragma unroll
        for (int ai = 0; ai < 2; ++ai)
#pragma unroll
            for (int m = 0; m < 4; ++m) { float* rowp = O + (size_t)(row0 + ai * 128 + m * 16) * ldc + col0;
#pragma unroll
                for (int bj = 0; bj < 2; ++bj)
#pragma unroll
                    for (int n = 0; n < 2; ++n) *(pg8::f32x4*)(rowp + bj * 128 + n * 16) = acc[ai][bj][m][n]; }
    }
};

__device__ __forceinline__ void lru_ab(const Ptrs& P, int l, int d, const float* XC, int row, int c, float& a, float& bb) {
    const int h = c >> 6, j = c & 63;
    const float* wa = P.lru_wa + (size_t)((l * 2 + d) * 8 + h) * 4096 + j;
    const float* wx = P.lru_wx + (size_t)((l * 2 + d) * 8 + h) * 4096 + j;
    const float* xr = XC + (size_t)row * WL + h * 64;
    float rp = P.lru_ba[(l * 2 + d) * WL + c], ip = P.lru_bx[(l * 2 + d) * WL + c];
#pragma unroll 8
    for (int i = 0; i < 64; ++i) { const float xv = xr[i]; rp += xv * wa[i * 64]; ip += xv * wx[i * 64]; }
    const float r = sigmoidf_(rp), ig = sigmoidf_(ip);
    const float sp = log1pf(expf(-P.lru_lambda[(l * 2 + d) * WL + c]));
    const float la = -8.0f * r * sp;
    a = expf(la);
    bb = sqrtf(-expm1f(2.0f * la)) * (ig * xr[j]);
}


typedef short bf16x8 __attribute__((ext_vector_type(8)));
static_assert(133120 + 4096 <= MISC_OFF && 113664 + 32768 <= MISC_OFF, "LDS map");
constexpr int XCT_STRIDE = 1040;
constexpr int L_XCT = 0, L_GZ = 66560, L_CIN = 133120;
__device__ __forceinline__ float bflo(unsigned u) { return __builtin_bit_cast(float, u << 16); }
__device__ __forceinline__ float bfhi(unsigned u) { return __builtin_bit_cast(float, u & 0xffff0000u); }

__device__ __forceinline__ void strip_conv(LAS unsigned char* lds, const Ptrs& P, int l, const bf16* UX, int r0, int tpos0, int n, int tid) {
    const int o = tid & 63, tg = tid >> 6, c0 = 8 * o;
    float w[4][8], bias[8];
#pragma unroll
    for (int k = 0; k < 4; ++k) { const f32x4 a = *(const f32x4*)(P.lru_conv_w + (l * 4 + k) * WL + c0), b = *(const f32x4*)(P.lru_conv_w + (l * 4 + k) * WL + c0 + 4);
#pragma unroll
        for (int q = 0; q < 4; ++q) { w[k][q] = a[q]; w[k][4 + q] = b[q]; } }
    { const f32x4 a = *(const f32x4*)(P.lru_conv_b + l * WL + c0), b = *(const f32x4*)(P.lru_conv_b + l * WL + c0 + 4);
#pragma unroll
      for (int q = 0; q < 4; ++q) { bias[q] = a[q]; bias[4 + q] = b[q]; } }
    v4u v[11];
#pragma unroll
    for (int i = 0; i < 11; ++i) { const int tp = tpos0 + 8 * tg + i - 2;
        v[i] = (tp >= 0 && tp < n) ? *(const v4u*)(UX + (size_t)(r0 + 8 * tg + i - 2) * NIN + C_VL + c0) : (v4u){0u, 0u, 0u, 0u}; }
#pragma unroll
    for (int e = 0; e < 8; ++e) {
        float acc[8];
#pragma unroll
        for (int q = 0; q < 8; ++q) acc[q] = bias[q];
#pragma unroll
        for (int k = 0; k < 4; ++k) { const v4u x = v[e + k];
            acc[0] += w[k][0] * bflo(x.x); acc[1] += w[k][1] * bfhi(x.x); acc[2] += w[k][2] * bflo(x.y); acc[3] += w[k][3] * bfhi(x.y);
            acc[4] += w[k][4] * bflo(x.z); acc[5] += w[k][5] * bfhi(x.z); acc[6] += w[k][6] * bflo(x.w); acc[7] += w[k][7] * bfhi(x.w); }
        v4u ov; ov.x = pk2(acc[0], acc[1]); ov.y = pk2(acc[2], acc[3]); ov.z = pk2(acc[4], acc[5]); ov.w = pk2(acc[6], acc[7]);
        *(LAS v4u*)(lds + L_XCT + (8 * tg + e) * XCT_STRIDE + o * 16) = ov;
    }
}

struct GateW { bf16x8 Br[2][2], Bi[2][2]; float br[2], bi[2], kc[2]; };
struct LookB { float2 s[9]; };
__device__ __forceinline__ void gatew_load(GateW& w, int l, int h, int n, int fr, int fq, const bf16* GWS, const float* GB, const float* KC) {
    const int c = h * 64 + 16 * n + fr;
#pragma unroll
    for (int d = 0; d < 2; ++d) {
        const bf16* wr = GWS + ((size_t)(((l * 2 + d) * 2 + 0) * 8 + h) * 64 + 16 * n + fr) * 64 + fq * 8;
        const bf16* wi = GWS + ((size_t)(((l * 2 + d) * 2 + 1) * 8 + h) * 64 + 16 * n + fr) * 64 + fq * 8;
#pragma unroll
        for (int ks = 0; ks < 2; ++ks) { w.Br[d][ks] = *(const bf16x8*)(wr + ks * 32); w.Bi[d][ks] = *(const bf16x8*)(wi + ks * 32); }
        w.br[d] = GB[((l * 2 + d) * 2 + 0) * WL + c]; w.bi[d] = GB[((l * 2 + d) * 2 + 1) * WL + c]; w.kc[d] = KC[(l * 2 + d) * WL + c];
    }
}
__device__ __forceinline__ int lb_chunk(int d, int p) { return d ? (p < 4 ? 3 - p : 39 - p) : p; }
__device__ __forceinline__ void lookb_load(LookB& lb, int d, int h, int n, int fr, int fq, const float* sb  ) {
    const int c = h * 64 + 16 * n + fr;
#pragma unroll
    for (int i = 0; i < 9; ++i) { const int q = lb_chunk(d, 9 * fq + i); lb.s[i] = *(const float2*)(sb + ((size_t)(q * 2 + d) * WL + c) * 2); }
}
__device__ __forceinline__ float lookb_carry(const LookB& lb, int d, int ck, int fr, int fq) {
    float As = 1.f, Hs = 0.f;
#pragma unroll
    for (int i = 0; i < 9; ++i) { const int q = lb_chunk(d, 9 * fq + i);
        const bool sel = d ? (ck < 4 ? (q < 4 && q > ck) : (q < 4 || q > ck)) : (q < ck);
        const float a = sel ? lb.s[i].x : 1.f, hh = sel ? lb.s[i].y : 0.f; Hs = a * Hs + hh; As *= a; }
    float cin = 0.f;
#pragma unroll
    for (int sg = 0; sg < 4; ++sg) { const float a = __shfl(As, fr + 16 * sg), hh = __shfl(Hs, fr + 16 * sg); cin = a * cin + hh; }
    return cin;
}
template <int MODE>
__device__ __forceinline__ void lru_core(LAS unsigned char* lds, int l, int h, int lane, const bf16* GWS, const float* GB, const float* KC, float* sum_out, const float* sb, int ck, const GateW& w0, const LookB& lb0) {
    const int fr = lane & 15, fq = lane >> 4;
    GateW wn = w0; LookB ln = lb0;
    bf16x8 A[4][2];
#pragma unroll
    for (int m = 0; m < 4; ++m)
#pragma unroll
        for (int ks = 0; ks < 2; ++ks) { const int tau = (fr >> 2) * 16 + m * 4 + (fr & 3);
            A[m][ks] = *(const LAS bf16x8*)(lds + L_XCT + tau * XCT_STRIDE + (h * 64 + ks * 32 + fq * 8) * 2); }
#pragma unroll 1
    for (int n = 0; n < 4; ++n) {
        const int c = h * 64 + 16 * n + fr;
        const GateW w = wn;
        if (n < 3) gatew_load(wn, l, h, n + 1, fr, fq, GWS, GB, KC);
        float xv[16], y[16];
#pragma unroll
        for (int e = 0; e < 16; ++e) { xv[e] = bf2f(*(const LAS bf16*)(lds + L_XCT + (fq * 16 + e) * XCT_STRIDE + c * 2)); y[e] = 0.f; }
#pragma unroll
        for (int d = 0; d < 2; ++d) {
            float cin = 0.f;
            if constexpr (MODE == 1) {
                cin = lookb_carry(ln, d, ck, fr, fq);
                if (d == 0) lookb_load(ln, 1, h, n, fr, fq, sb); else if (n < 3) lookb_load(ln, 0, h, n + 1, fr, fq, sb);
            }
            f32x4 ar[4], ai[4];
#pragma unroll
            for (int m = 0; m < 4; ++m) { ar[m] = (f32x4){w.br[d], w.br[d], w.br[d], w.br[d]}; ai[m] = (f32x4){w.bi[d], w.bi[d], w.bi[d], w.bi[d]}; }
#pragma unroll
            for (int m = 0; m < 4; ++m)
#pragma unroll
                for (int ks = 0; ks < 2; ++ks) { ar[m] = __builtin_amdgcn_mfma_f32_16x16x32_bf16(A[m][ks], w.Br[d][ks], ar[m], 0, 0, 0); ai[m] = __builtin_amdgcn_mfma_f32_16x16x32_bf16(A[m][ks], w.Bi[d][ks], ai[m], 0, 0, 0); }
            const float kc = w.kc[d];
            float av[16], bv[16];
#pragma unroll
            for (int e = 0; e < 16; ++e) {
                const float er = __builtin_amdgcn_exp2f(ar[e >> 2][e & 3]), ei = __builtin_amdgcn_exp2f(ai[e >> 2][e & 3]);
                const float r = __builtin_amdgcn_rcpf(1.0f + er), ig = __builtin_amdgcn_rcpf(1.0f + ei);
                const float a = __builtin_amdgcn_exp2f(kc * r);
                av[e] = a; bv[e] = __builtin_amdgcn_sqrtf(fmaxf(1.0f - a * a, 0.0f)) * (ig * xv[e]);
            }
            float Pq = 1.f, Hq = 0.f;
#pragma unroll
            for (int s = 0; s < 16; ++s) { const int e = d ? 15 - s : s; Hq = av[e] * Hq + bv[e]; Pq *= av[e]; bv[e] = Hq; av[e] = Pq; }
            float Pg[4], Hg[4];
#pragma unroll
            for (int q = 0; q < 4; ++q) { Pg[q] = __shfl(Pq, fr + 16 * q); Hg[q] = __shfl(Hq, fr + 16 * q); }
            if constexpr (MODE == 0) {
                float At = 1.f, Ht = 0.f;
#pragma unroll
                for (int s = 0; s < 4; ++s) { const int q = d ? 3 - s : s; Ht = Pg[q] * Ht + Hg[q]; At *= Pg[q]; }
                if (fq == 0) { float2 o2; o2.x = At; o2.y = Ht; *(float2*)(sum_out + ((size_t)d * WL + c) * 2) = o2; }
            } else {
                float cq = cin;
#pragma unroll
                for (int s = 0; s < 4; ++s) { const int q = d ? 3 - s : s; const bool before = d ? (q > fq) : (q < fq); if (before) cq = Pg[q] * cq + Hg[q]; }
#pragma unroll
                for (int e = 0; e < 16; ++e) y[e] += bv[e] + av[e] * cq;
            }
        }
        if constexpr (MODE == 1) {
#pragma unroll
            for (int e = 0; e < 16; ++e) { LAS bf16* gp = (LAS bf16*)(lds + L_GZ + (fq * 16 + e) * XCT_STRIDE + c * 2); const float g = bf2f(*gp);
                *gp = (bf16)f2bf(y[e] * g * __builtin_amdgcn_rcpf(1.0f + __builtin_amdgcn_exp2f(-LOG2E * g))); }
        }
    }
}

constexpr int T_STRIDE = 528;
constexpr int L_DT = 0, L_ZP = 33792, L_VP = 67584;
constexpr int L_ZC = 0, L_CT = 48128, L_CLT = 0, L_CG = 113664;
__device__ __forceinline__ float silu_fast(float g) { return g * __builtin_amdgcn_rcpf(1.0f + __builtin_amdgcn_exp2f(-LOG2E * g)); }
__device__ __forceinline__ float sigm_fast(float g) { return __builtin_amdgcn_rcpf(1.0f + __builtin_amdgcn_exp2f(-LOG2E * g)); }

template <int NCH> __device__ __forceinline__ void tile_out(LAS unsigned char* lds, int off, int stride, bf16* Zg, int r0, int col0, int tid) {
    constexpr int RPI = NT / NCH;
    const int ch = tid % NCH, rr = tid / NCH;
#pragma unroll
    for (int it = 0; it < 64 / RPI; ++it) { const int row = it * RPI + rr;
        *(v4u*)(Zg + (size_t)(r0 + row) * DM + col0 + ch * 8) = *(const LAS v4u*)(lds + off + row * stride + ch * 16); }
}

__device__ __forceinline__ void pool_part(LAS unsigned char* lds, const Ptrs& P, int l, const bf16* UX, const bf16* PWt, bf16* Zg, int r0, int tpos0, int n, int tid, int wave, int lane) {
    asm volatile("" : "+v"(tid)); lane = tid & 63; wave = __builtin_amdgcn_readfirstlane(tid >> 6);
    const int fr = lane & 15, fq = lane >> 4, g = wave >> 1, nh = wave & 1;
    {
        v4u vp[5], gp[4];
#pragma unroll
        for (int it = 0; it < 5; ++it) { const int id = it * NT + tid, rho = id >> 5, ch = id & 31, tp = tpos0 + rho - 8;
            vp[it] = (tp >= 0 && tp < n) ? *(const v4u*)(UX + (size_t)(r0 + rho - 8) * NIN + C_VP + ch * 8) : (v4u){0u, 0u, 0u, 0u}; }
#pragma unroll
        for (int it = 0; it < 4; ++it) gp[it] = *(const v4u*)(UX + (size_t)(r0 + it * 16 + (tid >> 5)) * NIN + C_GP + (tid & 31) * 8);
#pragma unroll
        for (int it = 0; it < 5; ++it) { const int id = it * NT + tid; *(LAS v4u*)(lds + L_VP + (id >> 5) * 512 + (id & 31) * 16) = vp[it]; }
#pragma unroll
        for (int it = 0; it < 4; ++it) *(LAS v4u*)(lds + L_ZP + (it * 16 + (tid >> 5)) * T_STRIDE + (tid & 31) * 16) = gp[it];
    }
    bf16x8 Bw[2][2];
#pragma unroll
    for (int ni = 0; ni < 2; ++ni) { const bf16* wp = PWt + ((size_t)((l * 4 + g) * 64 + 16 * (2 * nh + ni) + fr)) * 64 + fq * 8; Bw[ni][0] = *(const bf16x8*)(wp); Bw[ni][1] = *(const bf16x8*)(wp + 32); }
    __syncthreads();
    {
        const int o = tid & 31, gg = o >> 3, w2 = 1 << gg;
#pragma unroll
        for (int it = 0; it < 4; ++it) { const int tok = it * 16 + (tid >> 5), t = tpos0 + tok;
            int lo = t - w2; lo = lo < 0 ? 0 : lo; int hi = t + w2; hi = hi > n ? n : hi;
            float sum[8];
#pragma unroll
            for (int q = 0; q < 8; ++q) sum[q] = 0.f;
#pragma unroll
            for (int k = 0; k < 16; ++k) { if (k < 2 * w2) { const v4u x = *(const LAS v4u*)(lds + L_VP + (tok + 8 - w2 + k) * 512 + o * 16);
                sum[0] += bflo(x.x); sum[1] += bfhi(x.x); sum[2] += bflo(x.y); sum[3] += bfhi(x.y); sum[4] += bflo(x.z); sum[5] += bfhi(x.z); sum[6] += bflo(x.w); sum[7] += bfhi(x.w); } }
            const v4u xc = *(const LAS v4u*)(lds + L_VP + (tok + 8) * 512 + o * 16); const float inv = 1.0f / (float)(hi - lo);
            v4u ov; ov.x = pk2(sum[0] * inv - bflo(xc.x), sum[1] * inv - bfhi(xc.x)); ov.y = pk2(sum[2] * inv - bflo(xc.y), sum[3] * inv - bfhi(xc.y));
            ov.z = pk2(sum[4] * inv - bflo(xc.z), sum[5] * inv - bfhi(xc.z)); ov.w = pk2(sum[6] * inv - bflo(xc.w), sum[7] * inv - bfhi(xc.w));
            *(LAS v4u*)(lds + L_DT + tok * T_STRIDE + o * 16) = ov; }
    }
    __syncthreads();
    {
        bf16x8 A[4][2];
#pragma unroll
        for (int m = 0; m < 4; ++m)
#pragma unroll
            for (int ks = 0; ks < 2; ++ks) A[m][ks] = *(const LAS bf16x8*)(lds + L_DT + (16 * m + fr) * T_STRIDE + (g * 64 + ks * 32 + fq * 8) * 2);
#pragma unroll
        for (int ni = 0; ni < 2; ++ni) { const int nn = 2 * nh + ni, cc = g * 64 + 16 * nn + fr;
            const float ps = P.pool_scale[l * WP + cc];
#pragma unroll
            for (int m = 0; m < 4; ++m) { f32x4 acc = (f32x4){0.f, 0.f, 0.f, 0.f};
                acc = __builtin_amdgcn_mfma_f32_16x16x32_bf16(A[m][0], Bw[ni][0], acc, 0, 0, 0); acc = __builtin_amdgcn_mfma_f32_16x16x32_bf16(A[m][1], Bw[ni][1], acc, 0, 0, 0);
#pragma unroll
                for (int j = 0; j < 4; ++j) { const int tok = 16 * m + 4 * fq + j; LAS bf16* gp = (LAS bf16*)(lds + L_ZP + tok * T_STRIDE + cc * 2); const float gt = bf2f(*gp);
                    *gp = (bf16)f2bf(acc[j] * ps * silu_fast(gt)); } }
        }
    }
    __syncthreads();
    tile_out<32>(lds, L_ZP, T_STRIDE, Zg, r0, 512, tid);
    __syncthreads();
}

__device__ __forceinline__ void conf_part(LAS unsigned char* lds, const Ptrs& P, int l, const bf16* UX, const bf16* CPWt, bf16* Zg, int r0, int tpos0, int n, int tid, int wave, int lane) {
    asm volatile("" : "+v"(tid)); lane = tid & 63; wave = __builtin_amdgcn_readfirstlane(tid >> 6);
    {
        const int o = tid & 31, rg = tid >> 5, c0 = 8 * o;
        v4u va[6], vb[6], gp[4];
#pragma unroll
        for (int it = 0; it < 6; ++it) { const int rho = it * 16 + rg, tp = tpos0 + rho - 15; const bool ok = rho < 94 && tp >= 0 && tp < n;
            const bf16* rp = UX + (size_t)(r0 + rho - 15) * NIN;
            va[it] = ok ? *(const v4u*)(rp + C_VC + c0) : (v4u){0u, 0u, 0u, 0u}; vb[it] = ok ? *(const v4u*)(rp + C_GG + c0) : (v4u){0u, 0u, 0u, 0u}; }
#pragma unroll
        for (int it = 0; it < 4; ++it) gp[it] = *(const v4u*)(UX + (size_t)(r0 + it * 16 + rg) * NIN + C_GC + c0);
#pragma unroll
        for (int it = 0; it < 6; ++it) { const int rho = it * 16 + rg; if (rho < 94) { const v4u a = va[it], b = vb[it]; v4u ov;
                ov.x = pk2(bflo(a.x) * sigm_fast(bflo(b.x)), bfhi(a.x) * sigm_fast(bfhi(b.x))); ov.y = pk2(bflo(a.y) * sigm_fast(bflo(b.y)), bfhi(a.y) * sigm_fast(bfhi(b.y)));
                ov.z = pk2(bflo(a.z) * sigm_fast(bflo(b.z)), bfhi(a.z) * sigm_fast(bfhi(b.z))); ov.w = pk2(bflo(a.w) * sigm_fast(bflo(b.w)), bfhi(a.w) * sigm_fast(bfhi(b.w)));
                *(LAS v4u*)(lds + L_ZC + rho * 512 + o * 16) = ov; } }
#pragma unroll
        for (int it = 0; it < 4; ++it) *(LAS v4u*)(lds + L_CG + (it * 16 + rg) * 512 + o * 16) = gp[it];
    }
    __syncthreads();
    bf16x8 Bw[8][2];
    {   const int fr = lane & 15, fq = lane >> 4; const bf16* wp0 = CPWt + ((size_t)(l * 256 + 16 * (2 * wave) + fr)) * 256 + fq * 8;
#pragma unroll
        for (int ks = 0; ks < 8; ++ks) { Bw[ks][0] = *(const bf16x8*)(wp0 + ks * 32); Bw[ks][1] = *(const bf16x8*)(wp0 + 16 * 256 + ks * 32); } }
    {
        const int c = tid & 255, hf = tid >> 8;
        float w[31];
#pragma unroll
        for (int k = 0; k < 31; ++k) w[k] = P.conf_dw[(size_t)(l * 31 + k) * WC + c];
        const float bias = P.conf_dw_b[l * WC + c];
#pragma unroll 1
        for (int sh = 0; sh < 2; ++sh) { const int t0 = 32 * hf + 16 * sh; float acc[16];
#pragma unroll
            for (int oo = 0; oo < 16; ++oo) acc[oo] = bias;
#pragma unroll
            for (int rr = 0; rr < 46; ++rr) { const float val = bf2f(*(const LAS bf16*)(lds + L_ZC + (t0 + rr) * 512 + c * 2));
#pragma unroll
                for (int oo = 0; oo < 16; ++oo) { if (rr - oo >= 0 && rr - oo <= 30) acc[oo] += val * w[rr - oo]; } }
#pragma unroll
            for (int oo = 0; oo < 16; ++oo) *(LAS float*)(lds + L_CT + (t0 + oo) * 1024 + c * 4) = acc[oo]; }
    }
    __syncthreads();
    {
        const f32x4 lg = *(const f32x4*)(P.conf_ln_g + l * WC + 4 * lane), lb = *(const f32x4*)(P.conf_ln_b + l * WC + 4 * lane);
#pragma unroll
        for (int i = 0; i < 8; ++i) { const int tok = 8 * wave + i; const f32x4 v = *(const LAS f32x4*)(lds + L_CT + tok * 1024 + lane * 16);
            const float mu = wave_sum((v[0] + v[1]) + (v[2] + v[3])) * (1.0f / 256.0f); const f32x4 dv = v - mu;
            const float var = wave_sum((dv[0] * dv[0] + dv[1] * dv[1]) + (dv[2] * dv[2] + dv[3] * dv[3])) * (1.0f / 256.0f);
            const float rstd = 1.0f / sqrtf(var + EPS_LN); float o4[4];
#pragma unroll
            for (int e = 0; e < 4; ++e) o4[e] = silu_fast(dv[e] * rstd * lg[e] + lb[e]);
            v2u ov; ov.x = pk2(o4[0], o4[1]); ov.y = pk2(o4[2], o4[3]);
            *(LAS v2u*)(lds + L_CLT + tok * T_STRIDE + lane * 8) = ov; }
    }
    __syncthreads();
    {
        const int fr = lane & 15, fq = lane >> 4;
        f32x4 acc[4][2];
#pragma unroll
        for (int m = 0; m < 4; ++m) { acc[m][0] = (f32x4){0.f, 0.f, 0.f, 0.f}; acc[m][1] = (f32x4){0.f, 0.f, 0.f, 0.f}; }
#pragma unroll
        for (int ks = 0; ks < 8; ++ks) {
#pragma unroll
            for (int m = 0; m < 4; ++m) { const bf16x8 A = *(const LAS bf16x8*)(lds + L_CLT + (16 * m + fr) * T_STRIDE + (ks * 32 + fq * 8) * 2);
                acc[m][0] = __builtin_amdgcn_mfma_f32_16x16x32_bf16(A, Bw[ks][0], acc[m][0], 0, 0, 0); acc[m][1] = __builtin_amdgcn_mfma_f32_16x16x32_bf16(A, Bw[ks][1], acc[m][1], 0, 0, 0); } }
#pragma unroll
        for (int ni = 0; ni < 2; ++ni) { const int ee = 16 * (2 * wave + ni) + fr;
#pragma unroll
            for (int m = 0; m < 4; ++m)
#pragma unroll
                for (int j = 0; j < 4; ++j) { const int tok = 16 * m + 4 * fq + j; LAS bf16* gp = (LAS bf16*)(lds + L_CG + tok * 512 + ee * 2); const float gt = bf2f(*gp);
                    *gp = (bf16)f2bf(acc[m][ni][j] * silu_fast(gt)); } }
    }
    __syncthreads();
    tile_out<32>(lds, L_CG, 512, Zg, r0, 768, tid);
    __syncthreads();
}

struct MixCtx { const bf16* UX; bf16* Zg; const bf16* GWS; const float* GB; const float* KC; const float* SUM; const bf16* PWt; const bf16* CPWt; };
__device__ __forceinline__ void mix_lru_part(LAS unsigned char* lds, const Ptrs& P, int l, int sidx, const MixCtx& M, int tid) {
    const int b = sidx / NCHUNK, ck = sidx % NCHUNK;
    const int r0 = chunk_row0(b, ck), tpos0 = ck < 4 ? 64 * ck : 64 * (ck - 4), n = ck < 4 ? CTXL : SEQ;
    asm volatile("" : "+v"(tid)); const int lane = tid & 63, wave = __builtin_amdgcn_readfirstlane(tid >> 6);
    const float* sb = M.SUM + (size_t)b * NCHUNK * 2 * WL * 2;
    GateW w0; LookB lb0;
    gatew_load(w0, l, wave, 0, lane & 15, lane >> 4, M.GWS, M.GB, M.KC); lookb_load(lb0, 0, wave, 0, lane & 15, lane >> 4, sb);
    v4u gz[8];
#pragma unroll
    for (int i = 0; i < 8; ++i) gz[i] = *(const v4u*)(M.UX + (size_t)(r0 + 8 * (tid >> 6) + i) * NIN + C_GL + 8 * (tid & 63));
    strip_conv(lds, P, l, M.UX, r0, tpos0, n, tid);
#pragma unroll
    for (int i = 0; i < 8; ++i) *(LAS v4u*)(lds + L_GZ + (8 * (tid >> 6) + i) * XCT_STRIDE + (tid & 63) * 16) = gz[i];
    __syncthreads();
    lru_core<1>(lds, l, wave, lane, M.GWS, M.GB, M.KC, nullptr, sb, ck, w0, lb0);
    __syncthreads();
    tile_out<64>(lds, L_GZ, XCT_STRIDE, M.Zg, r0, 0, tid);
    __syncthreads();
}
__device__ __forceinline__ void mix_pool_part(LAS unsigned char* lds, const Ptrs& P, int l, int sidx, const MixCtx& M, int tid) {
    const int b = sidx / NCHUNK, ck = sidx % NCHUNK;
    const int r0 = chunk_row0(b, ck), tpos0 = ck < 4 ? 64 * ck : 64 * (ck - 4), n = ck < 4 ? CTXL : SEQ;
    pool_part(lds, P, l, M.UX, M.PWt, M.Zg, r0, tpos0, n, tid, 0, 0);
}
__device__ __forceinline__ void mix_conf_part(LAS unsigned char* lds, const Ptrs& P, int l, int sidx, const MixCtx& M, int tid) {
    const int b = sidx / NCHUNK, ck = sidx % NCHUNK;
    const int r0 = chunk_row0(b, ck), tpos0 = ck < 4 ? 64 * ck : 64 * (ck - 4), n = ck < 4 ? CTXL : SEQ;
    conf_part(lds, P, l, M.UX, M.CPWt, M.Zg, r0, tpos0, n, tid, 0, 0);
}
__device__ __forceinline__ int strip_of(int j) { return j < 256 ? (j >> 5) * NCHUNK + 4 + (j & 31) : ((j - 256) >> 2) * NCHUNK + ((j - 256) & 3); }

enum { K_PREP = 100, K_EMBED = 101 };
typedef const __attribute__((address_space(4))) Args* KArgs;
template <int KIND> __device__ __forceinline__ void run_phase(KArgs ap_in, LAS unsigned char* lds, const int l) {
    KArgs ap = ap_in; asm volatile("" : "+s"(ap));
    const Args args = *(const Args*)ap;
    const Ptrs& P = args.p;
    int tid_ = threadIdx.x; asm volatile("" : "+v"(tid_));
    const int tid = tid_, lane = tid & 63, wave = __builtin_amdgcn_readfirstlane(tid >> 6);
    const int G = gridDim.x, bx = blockIdx.x;
    const int gtid = bx * NT + tid, NTH = G * NT;
    const int gw = bx * 8 + wave, NGW = G * 8;
    unsigned char* ws = args.ws;
    float* MOD = (float*)(ws + WS_MOD);
    bf16* GW = (bf16*)(ws + WS_GW); bf16* PW = (bf16*)(ws + WS_PW); bf16* CPW = (bf16*)(ws + WS_CPW);
    bf16* WIN = (bf16*)(ws + WS_WIN); bf16* WOUT = (bf16*)(ws + WS_WOUT);
    bf16* HX = (bf16*)(ws + WS_HX); bf16* Z = HX; bf16* UX = (bf16*)(ws + WS_UX);
    float* XC = (float*)(ws + WS_R2); float* Y = (float*)(ws + WS_R2 + 36 * MiB);
    float* Dp = (float*)(ws + WS_R2); float* ZC = (float*)(ws + WS_R2 + 18 * MiB); float* CL = (float*)(ws + WS_R2 + 36 * MiB);
    float* O = (float*)(ws + WS_R2);
    float* CTXR = (float*)(ws + WS_CTXR); float* SUM = (float*)(ws + WS_SUM);
    float* out = args.out;

    {
        if constexpr (KIND == K_PREP) {
            LAS float* scr = (LAS float*)(lds + wave * 16384);
            constexpr int I_IN = 16 * 72, I_OUT = 16 * 32, I_CPW = 4 * 8, I_S = 2;
            constexpr int N_IN = 4 * I_IN, N_OUT = 4 * I_OUT, N_CPW = 4 * I_CPW, N_PW = 16 * I_S, N_GW = 64 * I_S;
            constexpr int NITEMS = N_IN + N_OUT + N_CPW + N_PW + 2 * N_GW;
            for (int it = gw; it < NITEMS; it += NGW) {
                int r = it;
                if (r < N_IN) { const int l = r / I_IN; transpose_item(P.w_in + (size_t)l * DM * NIN, DM, NIN, WIN + (size_t)l * NIN * DM, scr, r % I_IN, lane); continue; } r -= N_IN;
                if (r < N_OUT) { const int l = r / I_OUT; transpose_item(P.w_out + (size_t)l * DM * DM, DM, DM, WOUT + (size_t)l * DM * DM, scr, r % I_OUT, lane); continue; } r -= N_OUT;
                if (r < N_CPW) { const int l = r / I_CPW; transpose_item(P.conf_pw + (size_t)l * 65536, 256, 256, CPW + (size_t)l * 65536, scr, r % I_CPW, lane); continue; } r -= N_CPW;
                if (r < N_PW) { const int m = r / I_S; transpose_item(P.pool_w + (size_t)m * 4096, 64, 64, PW + (size_t)m * 4096, scr, r % I_S, lane); continue; } r -= N_PW;
                if (r < N_GW) { const int m = r / I_S; const int ld = m >> 3, h = m & 7;
                    transpose_item(P.lru_wa + (size_t)m * 4096, 64, 64, GW + (size_t)((ld * 2 + 0) * 8 + h) * 4096, scr, r % I_S, lane, -LOG2E); continue; } r -= N_GW;
                { const int m = r / I_S; const int ld = m >> 3, h = m & 7;
                    transpose_item(P.lru_wx + (size_t)m * 4096, 64, 64, GW + (size_t)((ld * 2 + 1) * 8 + h) * 4096, scr, r % I_S, lane, -LOG2E); }
            }
            for (int i = gtid; i < 4 * 2 * 2 * WL; i += NTH) { const int c = i & 511, gate = (i >> 9) & 1, ld = i >> 10;
                ((float*)(ws + WS_GB))[i] = -LOG2E * (gate ? P.lru_bx[ld * WL + c] : P.lru_ba[ld * WL + c]); }
            for (int i = gtid; i < 4 * 2 * WL; i += NTH) ((float*)(ws + WS_KC))[i] = -8.0f * LOG2E * log1pf(expf(-P.lru_lambda[i]));
            __syncthreads();
            LAS float* S = (LAS float*)lds;
            LAS float* RED = (LAS float*)(lds + 40960);
            for (int i = tid; i < 9 * 1024; i += NT) { const int r = i >> 10, k = i & 1023; const float v = r < 8 ? P.c[r * 1024 + k] : P.c_ctx[k]; S[i] = siluf_(v); }
            __syncthreads();
            for (int it = bx; it < 4 * 48; it += G) {
                const int l = it / 48, j0 = (it % 48) * 64, j = tid & 63, ks = tid >> 6;
                float acc[9];
#pragma unroll
                for (int r = 0; r < 9; ++r) acc[r] = 0.f;
                const float* wp = P.w_mod + (size_t)l * 1024 * 3072 + (size_t)(ks * 128) * 3072 + j0 + j;
#pragma unroll 4
                for (int k = 0; k < 128; ++k) { const float w = wp[(size_t)k * 3072];
#pragma unroll
                    for (int r = 0; r < 9; ++r) acc[r] += S[r * 1024 + ks * 128 + k] * w; }
#pragma unroll
                for (int r = 0; r < 9; ++r) RED[(ks * 9 + r) * 64 + j] = acc[r];
                __syncthreads();
                for (int i = tid; i < 9 * 64; i += NT) { const int r = i >> 6, jj = i & 63; float s = P.b_mod[l * 3072 + j0 + jj];
#pragma unroll
                    for (int q = 0; q < 8; ++q) s += RED[(q * 9 + r) * 64 + jj];
                    MOD[(size_t)(l * 9 + r) * 3072 + j0 + jj] = s; }
                __syncthreads();
            }
        } else if constexpr (KIND == K_EMBED) {
            for (int r = gw; r < MT; r += NGW) {
                int b, t, n, base; row_info(r, b, t, n, base);
                const bool isx = r < MX; const int mr = isx ? b : 8;
                const float* src = isx ? P.x + (size_t)r * DM : P.ctx + (size_t)(r - MX) * DM;
                float* dst = isx ? out + (size_t)r * DM : CTXR + (size_t)(r - MX) * DM;
                f32x4 v[4]; float ss = 0.f;
#pragma unroll
                for (int j = 0; j < 4; ++j) {
                    v[j] = *(const f32x4*)(src + 256 * j + 4 * lane);
                    if (isx) {
                        const float p = (j < 2) ? (float)(t >> 6) : (float)(t & 63);
#pragma unroll
                        for (int e = 0; e < 4; ++e) { const int i = 4 * lane + e; const float om = 1.0f / powf(10000.0f, (float)i / 256.0f); const float ang = p * om;
                            v[j][e] += (j & 1) ? cosf(ang) : sinf(ang); }
                    }
                    *(f32x4*)(dst + 256 * j + 4 * lane) = v[j];
                    ss += (v[j][0] * v[j][0] + v[j][1] * v[j][1]) + (v[j][2] * v[j][2] + v[j][3] * v[j][3]);
                }
                const float rstd = 1.0f / sqrtf(wave_sum(ss) * (1.0f / DM) + EPS_RMS);
                const float* sh = MOD + (size_t)(0 * 9 + mr) * 3072; const float* sc = sh + 1024;
#pragma unroll
                for (int j = 0; j < 4; ++j) { const int d0 = 256 * j + 4 * lane; float h[4];
#pragma unroll
                    for (int e = 0; e < 4; ++e) h[e] = v[j][e] * rstd * P.g_pre[d0 + e] * (1.0f + sc[d0 + e]) + sh[d0 + e];
                    uint2 w; w.x = pk2(h[0], h[1]); w.y = pk2(h[2], h[3]); *(uint2*)(HX + (size_t)r * DM + d0) = w; }
            }
        } else {
            constexpr int k = KIND;
            if constexpr (k == 0) {
                pg8::Gemm g{HX, WIN + (size_t)l * NIN * DM, MT, NIN, DM}; pg8::StaticOrder S; S.init(MT, NIN, G, bx);
                pg8::EpiBf16<0> E{UX, NIN, nullptr, 0, 0, 1.f};
                pg8::gemm_phase<pg8::EpiBf16<0>, pg8::StaticOrder, true, true>(lds, g, S, E);
            } else if constexpr (k == 2) {
                for (int sidx = bx; sidx < NB * NCHUNK; sidx += G) { const int b = sidx / NCHUNK, ck = sidx % NCHUNK;
                    const int r0 = chunk_row0(b, ck), tpos0 = ck < 4 ? 64 * ck : 64 * (ck - 4), n = ck < 4 ? CTXL : SEQ;
                    GateW w0; LookB lb0; gatew_load(w0, l, wave, 0, lane & 15, lane >> 4, GW, (const float*)(ws + WS_GB), (const float*)(ws + WS_KC));
                    strip_conv(lds, P, l, UX, r0, tpos0, n, tid);
                    __syncthreads();
                    lru_core<0>(lds, l, wave, lane, GW, (const float*)(ws + WS_GB), (const float*)(ws + WS_KC), SUM + (size_t)sidx * 2 * WL * 2, nullptr, 0, w0, lb0);
                    __syncthreads();
                }
            } else if constexpr (k == 3) {
                MixCtx M{UX, Z, GW, (const float*)(ws + WS_GB), (const float*)(ws + WS_KC), SUM, PW, CPW};
                const bool packed = (G == 256 && l < DEPTH - 1);
                const int ns = (l < DEPTH - 1) ? 288 : 256;
                const int nslot = packed ? 4 : 3 * ((ns - bx + G - 1) / G);
#pragma unroll 1
                for (int slot = 0; slot < nslot; ++slot) {
                    int kind, j;
                    if (packed) {
                        if (bx < 96) { kind = slot < 2 ? 0 : (slot == 2 ? 2 : 3); j = slot < 2 ? 2 * bx + slot : bx; }
                        else if (bx < 160) { kind = slot < 3 ? 1 : 3; j = 3 * (bx - 96) + slot; }
                        else { const int jj = bx - 160; kind = slot == 0 ? 0 : (slot == 1 ? 1 : 2); j = slot < 2 ? 192 + jj : 96 + 2 * jj + (slot - 2); }
                    } else { kind = slot % 3; j = bx + (slot / 3) * G; }
                    if (kind == 3) continue;
                    const int sidx = strip_of(j);
                    if (kind == 0) mix_lru_part(lds, P, l, sidx, M, tid);
                    else if (kind == 1) mix_conf_part(lds, P, l, sidx, M, tid);
                    else mix_pool_part(lds, P, l, sidx, M, tid);
                }
            } else if constexpr (k == 7) {
                pg8::Gemm g{Z, WOUT + (size_t)l * DM * DM, MT, DM, DM}; pg8::StaticOrder S; S.init(MT, DM, G, bx);
                EpiF32 E{O, DM};
                pg8::gemm_phase<EpiF32, pg8::StaticOrder, true, true>(lds, g, S, E);
            } else {
                for (int r = gw; r < MT; r += NGW) {
                    const bool isx = r < MX; if (!isx && l == DEPTH - 1) continue;
                    const int b = isx ? (r >> 11) : ((r - MX) >> 8); const int mr = isx ? b : 8;
                    float* xr = isx ? out + (size_t)r * DM : CTXR + (size_t)(r - MX) * DM;
                    const float* orow = O + (size_t)r * DM; const float* gt = MOD + (size_t)(l * 9 + mr) * 3072 + 2048;
                    f32x4 o[4]; float ss = 0.f;
#pragma unroll
                    for (int j = 0; j < 4; ++j) { o[j] = *(const f32x4*)(orow + 256 * j + 4 * lane); ss += (o[j][0] * o[j][0] + o[j][1] * o[j][1]) + (o[j][2] * o[j][2] + o[j][3] * o[j][3]); }
                    const float rstd = 1.0f / sqrtf(wave_sum(ss) * (1.0f / DM) + EPS_RMS);
                    f32x4 v[4]; float s2 = 0.f;
#pragma unroll
                    for (int j = 0; j < 4; ++j) { const int d0 = 256 * j + 4 * lane; v[j] = *(const f32x4*)(xr + d0);
#pragma unroll
                        for (int e = 0; e < 4; ++e) v[j][e] += gt[d0 + e] * (o[j][e] * rstd * P.g_post[l * DM + d0 + e]);
                        *(f32x4*)(xr + d0) = v[j];
                        s2 += (v[j][0] * v[j][0] + v[j][1] * v[j][1]) + (v[j][2] * v[j][2] + v[j][3] * v[j][3]); }
                    if (l < DEPTH - 1) {
                        const float rs2 = 1.0f / sqrtf(wave_sum(s2) * (1.0f / DM) + EPS_RMS);
                        const float* sh = MOD + (size_t)((l + 1) * 9 + mr) * 3072; const float* sc = sh + 1024;
#pragma unroll
                        for (int j = 0; j < 4; ++j) { const int d0 = 256 * j + 4 * lane; float h[4];
#pragma unroll
                            for (int e = 0; e < 4; ++e) h[e] = v[j][e] * rs2 * P.g_pre[(l + 1) * DM + d0 + e] * (1.0f + sc[d0 + e]) + sh[d0 + e];
                            uint2 w; w.x = pk2(h[0], h[1]); w.y = pk2(h[2], h[3]); *(uint2*)(HX + (size_t)r * DM + d0) = w; }
                    }
                }
            }
        }
    }
}


#define XB_TMO      128
#define XB_XCNT(j)  (256  + 64 * (j))
#define XB_XSUB(j)  (1280 + 64 * (j))
#define XB_XGEN(j)  (2304 + 64 * (j))
#define XB_TOP      3328
#define XB_TOPGEN   3392
#define XCD_BAR_WORDS 3456
#define XB_SPIN_CAP (1u << 18)
constexpr int CW_BAR = 4096;
__device__ __forceinline__ unsigned xb_ld(unsigned* p)              { return __hip_atomic_load(p, __ATOMIC_RELAXED, __HIP_MEMORY_SCOPE_AGENT); }
__device__ __forceinline__ unsigned xb_add(unsigned* p, unsigned v) { return __hip_atomic_fetch_add(p, v, __ATOMIC_RELAXED, __HIP_MEMORY_SCOPE_AGENT); }
__device__ __forceinline__ unsigned xb_xcc_id() { return (unsigned)__builtin_amdgcn_s_getreg((3 << 11) | 20) & 0xFu; }
#define XB_SPIN(cond, bar) do { unsigned _sp = 0; while (cond) { __builtin_amdgcn_s_sleep(1); \
    if ((++_sp & 255u) == 0u) { if (xb_ld(&(bar)[XB_TMO])) break; if (_sp > XB_SPIN_CAP) { atomicAdd(&(bar)[XB_TMO], 1u); break; } } } } while (0)
struct XcdBarrier { unsigned* bar; unsigned x; volatile LAS unsigned* st; };
__device__ __forceinline__ XcdBarrier xcd_barrier_post(unsigned* bar, volatile LAS unsigned* st) {
    XcdBarrier b; b.bar = bar; b.x = xb_xcc_id(); b.st = st;
    if (threadIdx.x == 0) (void)xb_add(&bar[XB_XCNT(b.x)], 1u);
    return b;
}
__device__ __forceinline__ void xcd_barrier_complete(unsigned* bar, unsigned x, unsigned& nloc, unsigned& nx) {
    const unsigned G = gridDim.x * gridDim.y * gridDim.z;
    unsigned sum, cnt, mine, sp = 0u;
    for (;;) {
        sum = 0u; cnt = 0u; mine = 0u;
#pragma unroll
        for (unsigned j = 0; j < 16; ++j) { const unsigned c = xb_ld(&bar[XB_XCNT(j)]); sum += c; cnt += (c > 0u) ? 1u : 0u; mine = (j == x) ? c : mine; }
        if (sum == G) break;
        __builtin_amdgcn_s_sleep(1);
        if ((++sp & 255u) == 0u) { if (xb_ld(&bar[XB_TMO])) break; if (sp > XB_SPIN_CAP) { atomicAdd(&bar[XB_TMO], 1u); break; } }
    }
    nloc = mine > 0u ? mine : 1u; nx = cnt > 0u ? cnt : 1u;
}
__device__ __forceinline__ void xcd_barrier(const XcdBarrier& b) {
    asm volatile("s_waitcnt vmcnt(0)" ::: "memory");
    __syncthreads();
    if (threadIdx.x == 0) {
        unsigned* bar = b.bar;
        __builtin_amdgcn_s_waitcnt(0);
        unsigned nloc = b.st[0], nx = b.st[1];
        if (nloc == 0u) { xcd_barrier_complete(bar, b.x, nloc, nx); b.st[0] = nloc; b.st[1] = nx; }
        const unsigned old = xb_add(&bar[XB_XSUB(b.x)], 1u);
        const unsigned gen = old / nloc;
        if (old + 1u == (gen + 1u) * nloc) {
            __builtin_amdgcn_fence(__ATOMIC_RELEASE, "agent");
            asm volatile("s_waitcnt vmcnt(0)" ::: "memory");
            const unsigned og = xb_add(&bar[XB_TOP], 1u);
            const unsigned tg = og / nx;
            if (og + 1u == (tg + 1u) * nx) xb_add(&bar[XB_TOPGEN], 1u);
            else XB_SPIN(xb_ld(&bar[XB_TOPGEN]) == tg, bar);
            __builtin_amdgcn_fence(__ATOMIC_ACQUIRE, "agent");
            xb_add(&bar[XB_XGEN(b.x)], 1u);
            asm volatile("s_waitcnt vmcnt(0)" ::: "memory");
        } else {
            XB_SPIN(xb_ld(&bar[XB_XGEN(b.x)]) == gen, bar);
            __builtin_amdgcn_fence(__ATOMIC_ACQUIRE, "agent");
            asm volatile("s_waitcnt vmcnt(0)" ::: "memory");
        }
    }
    __syncthreads();
}

template <int KIND> __global__ void __launch_bounds__(NT, 2) fwd(Args args) {
    extern __shared__ __attribute__((aligned(16))) unsigned char lds_raw[];
    KArgs ap = (KArgs)__builtin_amdgcn_kernarg_segment_ptr();
    run_phase<KIND>(ap, (LAS unsigned char*)lds_raw, args.ph_lo);
}
#ifndef REP_BAR
#define REP_BAR 1
#endif
#ifndef REP_G1
#define REP_G1 1
#endif
#ifndef REP_S
#define REP_S 1
#endif
#ifndef REP_M
#define REP_M 1
#endif
#ifndef REP_G2
#define REP_G2 1
#endif
#define GRID_BAR() do { for (int rb_ = 0; rb_ < REP_BAR; ++rb_) xcd_barrier(bar); } while (0)
__global__ void __launch_bounds__(NT, 2) fwd_all(Args args) {
    extern __shared__ __attribute__((aligned(16))) unsigned char lds_raw[];
    LAS unsigned char* lds = (LAS unsigned char*)lds_raw;
    volatile LAS unsigned* MISC = (volatile LAS unsigned*)(lds + MISC_OFF);
    if (threadIdx.x < 32) MISC[threadIdx.x] = 0u;
    __syncthreads();
    KArgs ap = (KArgs)__builtin_amdgcn_kernarg_segment_ptr();
    XcdBarrier bar = xcd_barrier_post((unsigned*)(args.ws + WS_CTL) + CW_BAR, MISC + 8);
    run_phase<K_PREP>(ap, lds, 0); GRID_BAR();
    run_phase<K_EMBED>(ap, lds, 0); GRID_BAR();
#pragma unroll 1
    for (int l = 0; l < DEPTH; ++l) {
        for (int r_ = 0; r_ < REP_G1; ++r_) run_phase<0>(ap, lds, l); GRID_BAR();
        for (int r_ = 0; r_ < REP_S; ++r_) run_phase<2>(ap, lds, l); GRID_BAR();
        for (int r_ = 0; r_ < REP_M; ++r_) run_phase<3>(ap, lds, l); GRID_BAR();
        for (int r_ = 0; r_ < REP_G2; ++r_) run_phase<7>(ap, lds, l); GRID_BAR();
        run_phase<8>(ap, lds, l); if (l < DEPTH - 1) GRID_BAR();
    }
}

#ifndef N_LAUNCH_MODE
#define N_LAUNCH_MODE 1
#endif

extern "C" void kernel_launch(void* const* d_in, const int* in_sizes, int n_in, void* d_out, int out_size, void* d_ws, size_t ws_size, hipStream_t stream) {
    static int grid = 0, fused = 0;
    if (grid == 0) {
        if (n_in != 24 || in_sizes[0] != MX * DM || out_size != MX * DM || ws_size < WS_END) { fprintf(stderr, "kernel_launch: unexpected shapes (n_in %d, in0 %d, out %d, ws %zu)\n", n_in, n_in > 0 ? in_sizes[0] : -1, out_size, ws_size); grid = -1; return; }
        int dev = 0, cus = 0, per_cu = 0;
        if (hipGetDevice(&dev) != hipSuccess || hipDeviceGetAttribute(&cus, hipDeviceAttributeMultiprocessorCount, dev) != hipSuccess) { grid = -1; return; }
        bool ok = true;
#define SETA(F) ok = ok && (hipFuncSetAttribute((const void*)F, hipFuncAttributeMaxDynamicSharedMemorySize, LDS_BYTES) == hipSuccess)
        SETA(fwd<K_PREP>); SETA(fwd<K_EMBED>); SETA(fwd<0>); SETA(fwd<2>); SETA(fwd<3>); SETA(fwd<7>); SETA(fwd<8>); SETA(fwd_all);
        if (!ok) { fprintf(stderr, "kernel_launch: hipFuncSetAttribute failed\n"); grid = -1; return; }
        grid = cus;
        if (hipOccupancyMaxActiveBlocksPerMultiprocessor(&per_cu, (const void*)fwd_all, NT, LDS_BYTES) != hipSuccess) per_cu = 0;
        (void)hipGetLastError();
        fused = (N_LAUNCH_MODE == 1 && per_cu >= 1) ? 1 : 0;
        if (!fused) fprintf(stderr, "kernel_launch: falling back to one launch per phase (occupancy query: %d per CU)\n", per_cu);
    }
    if (grid < 0) return;
    (void)hipMemsetAsync((char*)d_ws + WS_CTL, 0, CTL_ZERO_BYTES, stream);
    Args a{};
    const float** pp = (const float**)&a.p;
    for (int i = 0; i < 24; ++i) pp[i] = (const float*)d_in[i];
    a.out = (float*)d_out; a.ws = (unsigned char*)d_ws;
    a.ph_lo = 0; a.ph_hi = 0;
    if (fused) { hipLaunchKernelGGL(fwd_all, dim3(grid), dim3(NT), LDS_BYTES, stream, a); return; }
#define LAUNCH(K) hipLaunchKernelGGL(fwd<K>, dim3(grid), dim3(NT), LDS_BYTES, stream, a)
    LAUNCH(K_PREP); LAUNCH(K_EMBED);
    for (int l = 0; l < DEPTH; ++l) { a.ph_lo = l; LAUNCH(0); LAUNCH(2); LAUNCH(3); LAUNCH(7); LAUNCH(8); }
}
```
